# Optimizing an MI355X kernel written in HIP

```python
import math
import jax
import jax.numpy as jnp
from jax import lax
import numpy as np

D_MODEL = 1024
BATCH = 4
SEQ = 8192
DEPTH = 4

GRID_W = 64
CTX_LEN = 256
N_MIXERS = 3
MLP_HIDDEN = 4 * D_MODEL
NORM_EPS = 1e-6

HY_ORDER = 2
HY_EMB = 33
HY_FILTER_WIDTH = 64
HY_SHORT = 3
HY_FAST_DECAY = 0.3
HY_SLOW_DECAY = 1.5
HY_TARGET = 1e-2

GLA_HEADS = 4
GLA_DK = D_MODEL // 2
GLA_DV = D_MODEL
GLA_HK = GLA_DK // GLA_HEADS
GLA_HV = GLA_DV // GLA_HEADS
GLA_GATE_RANK = 16
GLA_GATE_NORM = 16.0
GLA_CHUNK = 64

MLA_HEADS = 8
MLA_Q_RANK = 384
MLA_KV_RANK = 256
MLA_NOPE = 128
MLA_ROPE = 64
MLA_V = 128
ROPE_THETA = 10000.0
Q_BLOCK = 128

N_HYENA = (DEPTH + 2) // 3
N_GLA = (DEPTH + 1) // 3
N_MLA = DEPTH // 3

kernel_name = 'hybrid_hyena_gla_mla_diffusion_trunk'

F32 = jnp.float32


def rmsnorm(x, g):
    xf = x.astype(F32)
    y = xf * lax.rsqrt(jnp.mean(xf * xf, axis=-1, keepdims=True) + NORM_EPS)
    return (y * g.astype(F32)).astype(x.dtype)


def modulate(h, shift, scale):
    return h * (1 + scale) + shift


def sq_relu_mlp(h, w1, w2):
    return jnp.square(jax.nn.relu(h @ w1)) @ w2


def short_conv(u, w, b):
    L = u.shape[1]
    pad = HY_SHORT // 2
    up = jnp.pad(u, ((0, 0), (pad, HY_SHORT - 1 - pad), (0, 0)))
    out = up[:, 0:L] * w[0]
    for j in range(1, HY_SHORT):
        out = out + up[:, j:j + L] * w[j]
    return out + b


def hyena_filter_spectra(L, f_w1, f_b1, f_w2, f_b2, f_w3, f_b3, f_w4, freq):
    t = jnp.linspace(0.0, 1.0, L, dtype=F32)[:, None]
    bands = (HY_EMB - 1) // 2
    w = 2.0 * math.pi * jnp.arange(L, dtype=F32)[:, None] / L
    f = jnp.linspace(1e-4, bands - 1, bands, dtype=F32)[None, :]
    z = jnp.concatenate([t, jnp.cos(f * w), -jnp.sin(f * w)], axis=-1)
    fr = freq.astype(F32)
    h = jnp.sin(fr * (z @ f_w1.astype(F32) + f_b1.astype(F32)))
    h = jnp.sin(fr * (h @ f_w2.astype(F32) + f_b2.astype(F32)))
    h = jnp.sin(fr * (h @ f_w3.astype(F32) + f_b3.astype(F32)))
    h = (h @ f_w4.astype(F32)).reshape(L, HY_ORDER, 2, D_MODEL)
    max_decay = math.log(HY_TARGET) / HY_FAST_DECAY
    min_decay = math.log(HY_TARGET) / HY_SLOW_DECAY
    deltas = jnp.linspace(min_decay, max_decay, D_MODEL, dtype=F32)
    h = h * jnp.exp(-t * jnp.abs(deltas))[:, None, None, :]
    fwd, bwd = h[:, :, 0], h[:, :, 1]
    two_sided = jnp.concatenate(
        [fwd, jnp.zeros((1, HY_ORDER, D_MODEL), F32), jnp.flip(bwd[1:], axis=0)], axis=0)
    two_sided = two_sided / jnp.sum(jnp.abs(two_sided), axis=0, keepdims=True)
    return jnp.fft.rfft(two_sided, axis=0)


def fft_long_conv(u, spec, skip):
    L = u.shape[1]
    y = jnp.fft.irfft(jnp.fft.rfft(u, n=2 * L, axis=1) * spec[None], n=2 * L, axis=1)[:, :L]
    return y + u * skip


def hyena_mixer(u, w_in, b_in, conv_w, conv_b, f_w1, f_b1, f_w2, f_b2, f_w3, f_b3, f_w4,
                freq, bias, w_out, b_out):
    L = u.shape[1]
    z = short_conv(u @ w_in + b_in, conv_w, conv_b).astype(F32)
    parts = jnp.split(z, HY_ORDER + 1, axis=-1)
    y, gates = parts[0], parts[1:]
    spec = hyena_filter_spectra(L, f_w1, f_b1, f_w2, f_b2, f_w3, f_b3, f_w4, freq)
    skip = bias.astype(F32)
    for n in range(HY_ORDER):
        y = gates[n] * fft_long_conv(y, spec[:, n], skip[n])
    return y.astype(u.dtype) @ w_out + b_out


def gla_inputs(u, w_in, gk_w2, gk_b):
    B, L, _ = u.shape
    z = u @ w_in
    q, k, v, og, r = jnp.split(
        z, [GLA_DK, 2 * GLA_DK, 2 * GLA_DK + GLA_DV, 2 * GLA_DK + 2 * GLA_DV], axis=-1)
    r = r.reshape(B, L, 2, GLA_GATE_RANK)
    gk = jnp.einsum('blzr,zrd->blzd', r, gk_w2) + gk_b
    g = (jax.nn.log_sigmoid(gk.astype(F32)) / GLA_GATE_NORM).reshape(B, L, 2, GLA_HEADS, GLA_HK)
    q = q.astype(F32).reshape(B, L, GLA_HEADS, GLA_HK) * (GLA_HK ** -0.5)
    k = k.astype(F32).reshape(B, L, GLA_HEADS, GLA_HK)
    v = v.astype(F32).reshape(B, L, GLA_HEADS, GLA_HV)
    return q, k, v, g[:, :, 0], g[:, :, 1], og


def gla_chunk_scan(q, k, v, g, s0):
    B, L, H, dk = q.shape
    dv = v.shape[-1]
    n_chunks = L // GLA_CHUNK

    def to_chunks(a):
        return a.reshape(B, n_chunks, GLA_CHUNK, H, a.shape[-1]).transpose(1, 0, 3, 2, 4)

    q, k, v, g = to_chunks(q), to_chunks(k), to_chunks(v), to_chunks(g)
    b = jnp.cumsum(g, axis=3)
    b_last = b[..., -1:, :]
    q_t = q * jnp.exp(b)
    k_t = k * jnp.exp(-b)
    k_end = k * jnp.exp(b_last - b)
    mask = jnp.tril(jnp.ones((GLA_CHUNK, GLA_CHUNK), dtype=bool))
    att = jnp.where(mask, jnp.einsum('nbhcd,nbhsd->nbhcs', q_t, k_t), 0.0)
    o_intra = jnp.einsum('nbhcs,nbhsv->nbhcv', att, v)
    chunk_decay = jnp.exp(b_last[..., 0, :])

    def step(S, inp):
        qn, kn, vn, dn = inp
        o = jnp.einsum('bhcd,bhdv->bhcv', qn, S)
        S = S * dn[..., None] + jnp.einsum('bhcd,bhcv->bhdv', kn, vn)
        return S, o

    s_fin, o_inter = lax.scan(step, s0, (q_t, k_end, v, chunk_decay))
    o = (o_intra + o_inter).transpose(1, 0, 3, 2, 4).reshape(B, L, H, dv)
    return o, s_fin


def gla_direction(q, k, v, g, s0, reverse):
    if reverse:
        q, k, v, g = (jnp.flip(a, axis=1) for a in (q, k, v, g))
    o, s_fin = gla_chunk_scan(q, k, v, g, s0)
    if reverse:
        o = jnp.flip(o, axis=1)
    return o, s_fin


def gla_out(o, og, onorm, wo):
    B, L = o.shape[:2]
    o = rmsnorm(o, onorm).reshape(B, L, GLA_DV).astype(og.dtype)
    return (o * jax.nn.silu(og)) @ wo


def gla_mixer(h_lat, h_ctx, w_in, gk_w2, gk_b, onorm, wo, ctx_out):
    ql, kl, vl, gfl, gbl, ogl = gla_inputs(h_lat, w_in, gk_w2, gk_b)
    qc, kc, vc, gfc, gbc, ogc = gla_inputs(h_ctx, w_in, gk_w2, gk_b)
    s0 = jnp.zeros((h_lat.shape[0], GLA_HEADS, GLA_HK, GLA_HV), F32)
    oc_f, s_f = gla_direction(qc, kc, vc, gfc, s0, False)
    oc_b, s_b = gla_direction(qc, kc, vc, gbc, s0, True)
    ol_f, _ = gla_direction(ql, kl, vl, gfl, s_f, False)
    ol_b, _ = gla_direction(ql, kl, vl, gbl, s_b, True)
    y_lat = gla_out(ol_f + ol_b, ogl, onorm, wo)
    y_ctx = gla_out(oc_f + oc_b, ogc, onorm, wo) if ctx_out else None
    return y_lat, y_ctx


def rotate_half_axis(xh, ang):
    cos = jnp.cos(ang)[None, :, None, :]
    sin = jnp.sin(ang)[None, :, None, :]
    x1, x2 = jnp.split(xh, 2, axis=-1)
    return jnp.concatenate([x1 * cos - x2 * sin, x1 * sin + x2 * cos], axis=-1)


def axial_rope(x, ang_row, ang_col):
    xf = x.astype(F32)
    half = x.shape[-1] // 2
    out = jnp.concatenate([rotate_half_axis(xf[..., :half], ang_row),
                           rotate_half_axis(xf[..., half:], ang_col)], axis=-1)
    return out.astype(x.dtype)


def mla_qkv(u, angles, w_down, qnorm, w_uq, kvnorm, w_ukv):
    B, L, _ = u.shape
    cq, ckv, k_rope = jnp.split(u @ w_down, [MLA_Q_RANK, MLA_Q_RANK + MLA_KV_RANK], axis=-1)
    q = (rmsnorm(cq, qnorm) @ w_uq).reshape(B, L, MLA_HEADS, MLA_NOPE + MLA_ROPE)
    kv = (rmsnorm(ckv, kvnorm) @ w_ukv).reshape(B, L, MLA_HEADS, MLA_NOPE + MLA_V)
    q_nope, q_rope = q[..., :MLA_NOPE], q[..., MLA_NOPE:]
    k_nope, v = kv[..., :MLA_NOPE], kv[..., MLA_NOPE:]
    k_rope = k_rope[:, :, None, :]
    if angles is not None:
        q_rope = axial_rope(q_rope, angles[0], angles[1])
        k_rope = axial_rope(k_rope, angles[0], angles[1])
    q = jnp.concatenate([q_nope, q_rope], axis=-1)
    k = jnp.concatenate([k_nope, jnp.broadcast_to(k_rope, (B, L, MLA_HEADS, MLA_ROPE))], axis=-1)
    return q, k, v


def block_attention(q, k, v):
    B, S, H, dq = q.shape
    scale = (MLA_NOPE + MLA_ROPE) ** -0.5
    n_blocks = S // Q_BLOCK
    qb = q.reshape(B, n_blocks, Q_BLOCK, H, dq).transpose(1, 0, 2, 3, 4)

    def one_block(qi):
        s = jnp.einsum('bqhd,bkhd->bhqk', qi, k, preferred_element_type=F32) * scale
        p = jax.nn.softmax(s, axis=-1)
        return jnp.einsum('bhqk,bkhv->bqhv', p.astype(v.dtype), v)

    o = lax.map(one_block, qb)
    return o.transpose(1, 0, 2, 3, 4).reshape(B, S, H * v.shape[-1])


def mla_mixer(h_lat, h_ctx, w_down, qnorm, w_uq, kvnorm, w_ukv, wo, ctx_out):
    L = h_lat.shape[1]
    rows = L // GRID_W
    r_idx, c_idx = jnp.meshgrid(jnp.arange(rows), jnp.arange(GRID_W), indexing='ij')
    half = MLA_ROPE // 2
    inv_freq = ROPE_THETA ** (-jnp.arange(0, half, 2, dtype=F32) / half)
    ang_row = r_idx.reshape(-1).astype(F32)[:, None] * inv_freq[None, :]
    ang_col = c_idx.reshape(-1).astype(F32)[:, None] * inv_freq[None, :]
    ql, kl, vl = mla_qkv(h_lat, (ang_row, ang_col), w_down, qnorm, w_uq, kvnorm, w_ukv)
    qc, kc, vc = mla_qkv(h_ctx, None, w_down, qnorm, w_uq, kvnorm, w_ukv)
    k_all = jnp.concatenate([kc, kl], axis=1)
    v_all = jnp.concatenate([vc, vl], axis=1)
    y_lat = block_attention(ql, k_all, v_all) @ wo
    y_ctx = block_attention(qc, kc, vc) @ wo if ctx_out else None
    return y_lat, y_ctx


def setup_inputs(seed: int = 0) -> dict:
    key = jax.random.key(seed)
    ks = iter(jax.random.split(key, 64))
    D = D_MODEL

    def nrm(shape, scale):
        return jax.random.normal(next(ks), shape, F32) * scale

    def gain(shape):
        return 1.0 + nrm(shape, 0.05)

    gla_in_cols = 2 * GLA_DK + 2 * GLA_DV + 2 * GLA_GATE_RANK
    fw = HY_FILTER_WIDTH
    return {
        'x': nrm((BATCH, SEQ, D), 1.0),
        'c': nrm((BATCH, D), 1.0),
        'ctx': nrm((BATCH, CTX_LEN, D), 1.0),
        'c_ctx': nrm((D,), 1.0),
        'ada_w': nrm((DEPTH, D, 6 * D), 0.5 * D ** -0.5),
        'ada_b': nrm((DEPTH, 6 * D), 0.01),
        'norm1_g': gain((DEPTH, D)),
        'norm2_g': gain((DEPTH, D)),
        'mlp_w1': nrm((DEPTH, D, MLP_HIDDEN), D ** -0.5),
        'mlp_w2': nrm((DEPTH, MLP_HIDDEN, D), MLP_HIDDEN ** -0.5),
        'final_g': gain((D,)),
        'hy_w_in': nrm((N_HYENA, D, (HY_ORDER + 1) * D), D ** -0.5),
        'hy_b_in': nrm((N_HYENA, (HY_ORDER + 1) * D), 0.01),
        'hy_conv_w': nrm((N_HYENA, HY_SHORT, (HY_ORDER + 1) * D), HY_SHORT ** -0.5),
        'hy_conv_b': nrm((N_HYENA, (HY_ORDER + 1) * D), 0.01),
        'hy_f_w1': nrm((N_HYENA, HY_EMB, fw), HY_EMB ** -0.5),
        'hy_f_b1': nrm((N_HYENA, fw), 0.1),
        'hy_f_w2': nrm((N_HYENA, fw, fw), fw ** -0.5),
        'hy_f_b2': nrm((N_HYENA, fw), 0.1),
        'hy_f_w3': nrm((N_HYENA, fw, fw), fw ** -0.5),
        'hy_f_b3': nrm((N_HYENA, fw), 0.1),
        'hy_f_w4': nrm((N_HYENA, fw, HY_ORDER * 2 * D), fw ** -0.5),
        'hy_freq': 1.0 + nrm((N_HYENA, fw), 0.1),
        'hy_bias': nrm((N_HYENA, HY_ORDER, D), 0.5),
        'hy_w_out': nrm((N_HYENA, D, D), D ** -0.5),
        'hy_b_out': nrm((N_HYENA, D), 0.01),
        'gla_w_in': nrm((N_GLA, D, gla_in_cols), D ** -0.5),
        'gla_gk_w2': nrm((N_GLA, 2, GLA_GATE_RANK, GLA_DK), GLA_GATE_RANK ** -0.5),
        'gla_gk_b': nrm((N_GLA, 2, GLA_DK), 0.1),
        'gla_onorm': gain((N_GLA, GLA_HV)),
        'gla_wo': nrm((N_GLA, GLA_DV, D), GLA_DV ** -0.5),
        'mla_w_down': nrm((N_MLA, D, MLA_Q_RANK + MLA_KV_RANK + MLA_ROPE), D ** -0.5),
        'mla_qnorm': gain((N_MLA, MLA_Q_RANK)),
        'mla_w_uq': nrm((N_MLA, MLA_Q_RANK, MLA_HEADS * (MLA_NOPE + MLA_ROPE)), MLA_Q_RANK ** -0.5),
        'mla_kvnorm': gain((N_MLA, MLA_KV_RANK)),
        'mla_w_ukv': nrm((N_MLA, MLA_KV_RANK, MLA_HEADS * (MLA_NOPE + MLA_V)), MLA_KV_RANK ** -0.5),
        'mla_wo': nrm((N_MLA, MLA_HEADS * MLA_V, D), (MLA_HEADS * MLA_V) ** -0.5),
    }


def reference(x, c, ctx, c_ctx, ada_w, ada_b, norm1_g, norm2_g, mlp_w1, mlp_w2, final_g,
              hy_w_in, hy_b_in, hy_conv_w, hy_conv_b, hy_f_w1, hy_f_b1, hy_f_w2, hy_f_b2,
              hy_f_w3, hy_f_b3, hy_f_w4, hy_freq, hy_bias, hy_w_out, hy_b_out,
              gla_w_in, gla_gk_w2, gla_gk_b, gla_onorm, gla_wo,
              mla_w_down, mla_qnorm, mla_w_uq, mla_kvnorm, mla_w_ukv, mla_wo):
    x_lat = x
    x_ctx = ctx
    silu_c = jax.nn.silu(c)
    silu_cc = jax.nn.silu(c_ctx)
    for i in range(DEPTH):
        kind = i % N_MIXERS
        j = i // N_MIXERS
        ctx_read = kind != 0
        ctx_live = any(l % N_MIXERS != 0 for l in range(i + 1, DEPTH))
        mod_l = jnp.split((silu_c @ ada_w[i] + ada_b[i])[:, None, :], 6, axis=-1)
        h_lat = modulate(rmsnorm(x_lat, norm1_g[i]), mod_l[0], mod_l[1])
        if ctx_read or ctx_live:
            mod_c = jnp.split(silu_cc @ ada_w[i] + ada_b[i], 6, axis=-1)
            h_ctx = modulate(rmsnorm(x_ctx, norm1_g[i]), mod_c[0], mod_c[1])
        if kind == 0:
            hp = (hy_w_in[j], hy_b_in[j], hy_conv_w[j], hy_conv_b[j], hy_f_w1[j], hy_f_b1[j],
                  hy_f_w2[j], hy_f_b2[j], hy_f_w3[j], hy_f_b3[j], hy_f_w4[j], hy_freq[j],
                  hy_bias[j], hy_w_out[j], hy_b_out[j])
            y_lat = hyena_mixer(h_lat, *hp)
            y_ctx = hyena_mixer(h_ctx, *hp) if ctx_live else None
        elif kind == 1:
            y_lat, y_ctx = gla_mixer(h_lat, h_ctx, gla_w_in[j], gla_gk_w2[j], gla_gk_b[j],
                                     gla_onorm[j], gla_wo[j], ctx_live)
        else:
            y_lat, y_ctx = mla_mixer(h_lat, h_ctx, mla_w_down[j], mla_qnorm[j], mla_w_uq[j],
                                     mla_kvnorm[j], mla_w_ukv[j], mla_wo[j], ctx_live)
        x_lat = x_lat + mod_l[2] * y_lat
        x_lat = x_lat + mod_l[5] * sq_relu_mlp(
            modulate(rmsnorm(x_lat, norm2_g[i]), mod_l[3], mod_l[4]), mlp_w1[i], mlp_w2[i])
        if ctx_live:
            x_ctx = x_ctx + mod_c[2] * y_ctx
            x_ctx = x_ctx + mod_c[5] * sq_relu_mlp(
                modulate(rmsnorm(x_ctx, norm2_g[i]), mod_c[3], mod_c[4]), mlp_w1[i], mlp_w2[i])
    return rmsnorm(x_lat, final_g)
```

```cpp
#include <hip/hip_runtime.h>
#include <hip/hip_cooperative_groups.h>
#include <cstdio>
#include <cstdint>
namespace cg = cooperative_groups;

#ifndef MULTI
#define MULTI 1
#endif
#ifndef CHECKS
#define CHECKS 0
#endif

typedef unsigned short u16;
using bf16x8 = __attribute__((ext_vector_type(8))) short;
using u16x4  = __attribute__((ext_vector_type(4))) unsigned short;
using u16x8  = __attribute__((ext_vector_type(8))) unsigned short;
using f32x16 = __attribute__((ext_vector_type(16))) float;
#define DI __device__ __forceinline__
#define MFMA32(a, b, c) __builtin_amdgcn_mfma_f32_32x32x16_bf16((a), (b), (c), 0, 0, 0)

constexpr int DM = 1024, NB = 4, SEQ = 8192, NCTX = 256;
constexpr int NL = NB * SEQ;
constexpr int NTOK = NL + NB * NCTX;
constexpr int HID = 4096;
constexpr int NT = 512;
constexpr int GLA_N = 3104, GLA_NP = 3200;
constexpr int MLA_DN = 704, MLA_DNP = 768;
constexpr int KTL = SEQ + NCTX;
constexpr int NKEY = SEQ + NCTX;
constexpr float EPS = 1e-6f;

constexpr size_t MiB = 1048576;
constexpr size_t OFF_MOD = 0;
constexpr size_t OFF_ERR = 512 * 1024;
constexpr size_t OFF_XC  = 1 * MiB;
constexpr size_t OFF_H3  = 5 * MiB;
constexpr size_t OFF_WT  = 8 * MiB;
constexpr size_t OFF_A   = 104 * MiB;
constexpr size_t OFF_BIG = 170 * MiB;
constexpr size_t WS_NEED = 500 * MiB;
constexpr size_t W_MLP1(int i) { return (size_t)i * 8388608; }
constexpr size_t W_MLP2(int i) { return (size_t)i * 8388608 + 4194304; }
constexpr size_t W_HY0 = 33554432;
constexpr size_t W_HYIN(int j)  { return W_HY0 + (size_t)j * 4456448; }
constexpr size_t W_HYOUT(int j) { return W_HYIN(j) + 3145728; }
constexpr size_t W_HYF4(int j)  { return W_HYOUT(j) + 1048576; }
constexpr size_t W_GLAIN = W_HY0 + 2 * 4456448;
constexpr size_t W_GLAWO = W_GLAIN + (size_t)GLA_NP * 1024;
constexpr size_t W_MLADN = W_GLAWO + 1048576;
constexpr size_t W_MLAUQ = W_MLADN + (size_t)MLA_DNP * 1024;
constexpr size_t W_MLAUKV = W_MLAUQ + 1536 * 384;
constexpr size_t W_MLAWO = W_MLAUKV + 2048 * 256;
constexpr size_t W_END = W_MLAWO + 1048576;
static_assert(W_END * 2 <= 96 * MiB, "wt");
constexpr size_t B_ZT = 0;
constexpr size_t B_YT = (size_t)3072 * NTOK * 2;
constexpr size_t B_KT = B_YT + (size_t)1024 * NTOK * 2;
constexpr size_t B_HID = 0;
constexpr size_t B_GZ = 0;
constexpr size_t B_GOB = (size_t)NTOK * GLA_N * 2;
constexpr size_t B_Q = 0;
constexpr size_t B_KN = (size_t)NL * 1536 * 2;
constexpr size_t B_VT = B_KN + (size_t)NTOK * 1024 * 2;
constexpr size_t B_KR = B_VT + (size_t)NTOK * 1024 * 2;
constexpr size_t B_CD = B_KR + (size_t)NTOK * 64 * 2;
static_assert(B_KT + (size_t)4096 * KTL * 2 <= 330 * MiB, "big");
static_assert(B_CD + (size_t)NTOK * 768 * 2 <= 330 * MiB, "big2");
static_assert(B_GOB + (size_t)NTOK * 1024 * 2 <= 330 * MiB, "big3");
constexpr size_t A_CQN = 0;
constexpr size_t A_CKVN = (size_t)NL * 384 * 2;

constexpr int LDS_BYTES = 136 * 1024;

struct MatDesc { const float* src; unsigned long long dst; int K, N, Np, tiles; };
constexpr int NMAT = 22;

struct Params {
  const float *x, *c, *ctx, *c_ctx, *ada_w, *ada_b, *norm1_g, *norm2_g, *mlp_w1, *mlp_w2, *final_g;
  const float *hy_w_in, *hy_b_in, *hy_conv_w, *hy_conv_b, *hy_f_w1, *hy_f_b1, *hy_f_w2, *hy_f_b2, *hy_f_w3, *hy_f_b3, *hy_f_w4,
      *hy_freq, *hy_bias, *hy_w_out, *hy_b_out;
  const float *gla_w_in, *gla_gk_w2, *gla_gk_b, *gla_onorm, *gla_wo;
  const float *mla_w_down, *mla_qnorm, *mla_w_uq, *mla_kvnorm, *mla_w_ukv, *mla_wo;
  float* out;
  unsigned char* ws;
  MatDesc mats[NMAT];
  int total_mat_tiles;
  int ph_lo, ph_hi;
  int pad0;
};

DI u16 f2bf(float x) { unsigned u = __float_as_uint(x); u += 0x7fffu + ((u >> 16) & 1u); return (u16)(u >> 16); }
DI float bf2f(u16 v) { return __uint_as_float(((unsigned)v) << 16); }
DI float shx(float v, int mask, int lane) { return __int_as_float(__builtin_amdgcn_ds_bpermute((lane ^ mask) << 2, __float_as_int(v))); }
DI float wave_sum(float v, int lane) {
#pragma unroll
  for (int o = 32; o > 0; o >>= 1) v += shx(v, o, lane);
  return v;
}
DI int ltid() { int t = threadIdx.x; asm volatile("" : "+v"(t)); return t; }
DI int crow(int reg, int h) { return (reg & 3) + 8 * (reg >> 2) + 4 * h; }
DI float silu(float x) { return x / (1.f + __expf(-x)); }
DI int mod_index(int row) { return row < NL ? (row >> 13) : 4; }

DI void pro_weights(const Params& P, unsigned char* smem, int bid, int nblk) {
  float* t = (float*)smem;
  const int tid = ltid();
  for (int tile = bid; tile < P.total_mat_tiles; tile += nblk) {
    int mi = 0, rem = tile;
    while (rem >= P.mats[mi].tiles) { rem -= P.mats[mi].tiles; ++mi; }
    const MatDesc md = P.mats[mi];
    const int ntn = md.Np / 64;
    const int k0 = (rem / ntn) * 64, n0 = (rem % ntn) * 64;
    u16* dst = (u16*)(P.ws + OFF_WT) + md.dst;
#pragma unroll
    for (int pass = 0; pass < 2; ++pass) {
      const int kr = (tid >> 4) + pass * 32, nc = (tid & 15) * 4;
      float4 v = make_float4(0.f, 0.f, 0.f, 0.f);
      if (n0 + nc < md.N) v = *(const float4*)(md.src + (size_t)(k0 + kr) * md.N + n0 + nc);
      t[kr * 65 + nc + 0] = v.x; t[kr * 65 + nc + 1] = v.y; t[kr * 65 + nc + 2] = v.z; t[kr * 65 + nc + 3] = v.w;
    }
    __syncthreads();
    {
      const int n = tid >> 3, kc = (tid & 7) * 8;
      u16x8 o;
#pragma unroll
      for (int j = 0; j < 8; ++j) o[j] = f2bf(t[(kc + j) * 65 + n]);
      *(u16x8*)(dst + (size_t)(n0 + n) * md.K + k0 + kc) = o;
    }
    __syncthreads();
  }
}

DI void pro_adaln(const Params& P, unsigned char* smem, int bid, int nblk) {
  float* sc = (float*)smem;
  float* red = sc + 5 * 1024;
  float* modw = (float*)(P.ws + OFF_MOD);
  const int tid = ltid();
  for (int u = bid; u < 4 * 48; u += nblk) {
    const int li = u / 48, n0 = (u % 48) * 128;
    for (int e = tid; e < 5 * 1024; e += NT) {
      const int mi = e >> 10, k = e & 1023;
      const float v = mi < 4 ? P.c[mi * 1024 + k] : P.c_ctx[k];
      sc[e] = silu(v);
    }
    __syncthreads();
    const int nq = tid & 31, kg = tid >> 5;
    float acc[5][4];
#pragma unroll
    for (int a = 0; a < 5; ++a)
#pragma unroll
      for (int b = 0; b < 4; ++b) acc[a][b] = 0.f;
    const float* w = P.ada_w + (size_t)li * 1024 * 6144 + n0 + nq * 4;
    for (int kk = 0; kk < 64; ++kk) {
      const int k = kg * 64 + kk;
      const float4 wv = *(const float4*)(w + (size_t)k * 6144);
#pragma unroll
      for (int a = 0; a < 5; ++a) {
        const float s = sc[a * 1024 + k];
        acc[a][0] += s * wv.x; acc[a][1] += s * wv.y; acc[a][2] += s * wv.z; acc[a][3] += s * wv.w;
      }
    }
#pragma unroll
    for (int a = 0; a < 5; ++a)
#pragma unroll
      for (int b = 0; b < 4; ++b) red[(kg * 5 + a) * 128 + nq * 4 + b] = acc[a][b];
    __syncthreads();
    for (int e = tid; e < 5 * 128; e += NT) {
      const int a = e >> 7, n = e & 127;
      float s = P.ada_b[li * 6144 + n0 + n];
#pragma unroll
      for (int g = 0; g < 16; ++g) s += red[(g * 5 + a) * 128 + n];
      modw[(size_t)(li * 5 + a) * 6144 + n0 + n] = s;
    }
    __syncthreads();
  }
}

DI void pro_filter_mlp(const Params& P, int bid, int nblk) {
  const int lane = ltid() & 63, wv = ltid() >> 6;
  u16* h3 = (u16*)(P.ws + OFF_H3);
  for (int task = bid * 8 + wv; task < 2 * KTL; task += nblk * 8) {
    const int j = task / KTL, row = task % KTL;
    const int L = row < SEQ ? SEQ : NCTX;
    const int l = row < SEQ ? row : row - SEQ;
    const float* w1 = P.hy_f_w1 + j * 33 * 64; const float* b1 = P.hy_f_b1 + j * 64;
    const float* w2 = P.hy_f_w2 + j * 64 * 64; const float* b2 = P.hy_f_b2 + j * 64;
    const float* w3 = P.hy_f_w3 + j * 64 * 64; const float* b3 = P.hy_f_b3 + j * 64;
    const float fr = P.hy_freq[j * 64 + lane];
    const float tl = (float)l / (float)(L - 1);
    const float w = 6.283185307179586f * (float)l / (float)L;
    float zf = 0.f;
    if (lane == 0) zf = tl;
    else if (lane <= 32) {
      const int bi = (lane - 1) & 15;
      const float f = 1e-4f + (float)bi * ((15.f - 1e-4f) / 15.f);
      const float a = f * w;
      zf = lane <= 16 ? cosf(a) : -sinf(a);
    }
    float acc = b1[lane];
#pragma unroll
    for (int k = 0; k < 33; ++k) acc += __int_as_float(__builtin_amdgcn_readlane(__float_as_int(zf), k)) * w1[k * 64 + lane];
    float h = sinf(fr * acc);
    acc = b2[lane];
#pragma unroll
    for (int k = 0; k < 64; ++k) acc += __int_as_float(__builtin_amdgcn_readlane(__float_as_int(h), k)) * w2[k * 64 + lane];
    h = sinf(fr * acc);
    acc = b3[lane];
#pragma unroll
    for (int k = 0; k < 64; ++k) acc += __int_as_float(__builtin_amdgcn_readlane(__float_as_int(h), k)) * w3[k * 64 + lane];
    h = sinf(fr * acc);
    h3[((size_t)j * KTL + row) * 64 + lane] = f2bf(h);
  }
}

DI void normmod_phase(const Params& P, int li, int which, int nrows, const float* xl, const float* xc, int bid, int nblk) {
  const int lane = ltid() & 63, wv = ltid() >> 6;
  u16* A = (u16*)(P.ws + OFF_A);
  const float* g = (which ? P.norm2_g : P.norm1_g) + li * 1024;
  const float* modw = (const float*)(P.ws + OFF_MOD) + (size_t)li * 5 * 6144;
  for (int row = bid * 8 + wv; row < nrows; row += nblk * 8) {
    const float* xr = row < NL ? xl + (size_t)row * 1024 : xc + (size_t)(row - NL) * 1024;
    const float* md = modw + mod_index(row) * 6144 + (which ? 3 * 1024 : 0);
    float4 v[4];
    float ss = 0.f;
#pragma unroll
    for (int j = 0; j < 4; ++j) {
      v[j] = *(const float4*)(xr + j * 256 + lane * 4);
      ss += v[j].x * v[j].x + v[j].y * v[j].y + v[j].z * v[j].z + v[j].w * v[j].w;
    }
    ss = wave_sum(ss, lane);
    const float rstd = rsqrtf(ss * (1.f / 1024.f) + EPS);
#pragma unroll
    for (int j = 0; j < 4; ++j) {
      const int k = j * 256 + lane * 4;
      const float4 gg = *(const float4*)(g + k);
      const float4 sh = *(const float4*)(md + k);
      const float4 sc = *(const float4*)(md + 1024 + k);
      u16x4 o;
      o[0] = f2bf(v[j].x * rstd * gg.x * (1.f + sc.x) + sh.x);
      o[1] = f2bf(v[j].y * rstd * gg.y * (1.f + sc.y) + sh.y);
      o[2] = f2bf(v[j].z * rstd * gg.z * (1.f + sc.z) + sh.z);
      o[3] = f2bf(v[j].w * rstd * gg.w * (1.f + sc.w) + sh.w);
      *(u16x4*)(A + (size_t)row * 1024 + k) = o;
    }
  }
}

DI void final_norm_phase(const Params& P, int bid, int nblk) {
  const int lane = ltid() & 63, wv = ltid() >> 6;
  for (int row = bid * 8 + wv; row < NL; row += nblk * 8) {
    float* xr = P.out + (size_t)row * 1024;
    float4 v[4];
    float ss = 0.f;
#pragma unroll
    for (int j = 0; j < 4; ++j) {
      v[j] = *(const float4*)(xr + j * 256 + lane * 4);
      ss += v[j].x * v[j].x + v[j].y * v[j].y + v[j].z * v[j].z + v[j].w * v[j].w;
    }
    ss = wave_sum(ss, lane);
    const float rstd = rsqrtf(ss * (1.f / 1024.f) + EPS);
#pragma unroll
    for (int j = 0; j < 4; ++j) {
      const int k = j * 256 + lane * 4;
      const float4 gg = *(const float4*)(P.final_g + k);
      float4 o;
      o.x = v[j].x * rstd * gg.x; o.y = v[j].y * rstd * gg.y; o.z = v[j].z * rstd * gg.z; o.w = v[j].w * rstd * gg.w;
      *(float4*)(xr + k) = o;
    }
  }
}

enum { EPI_HYIN = 0, EPI_FILT, EPI_RES, EPI_MLP1, EPI_GLAIN, EPI_MLADN, EPI_MLAQ, EPI_MLAKV };
struct EpiArgs {
  const float* bias;
  const float* gate;
  int gofs;
  const float* xsl; const float* xsc;
  float* xdl; float* xdc;
  u16* o0; u16* o1;
  int mrow0;
  int L;
};

constexpr int GS = 72;

template <int EPI>
DI void epi_tile(const EpiArgs& ea, const f32x16& acc, int mb, int nb, int lane) {
  const int r = lane & 31, h = lane >> 5;
  if constexpr (EPI == EPI_HYIN) {
    const int m = mb + r;
#pragma unroll
    for (int i = 0; i < 16; ++i) {
      const int n = nb + crow(i, h);
      ea.o0[(size_t)n * NTOK + m] = f2bf(acc[i] + ea.bias[n]);
    }
  } else if constexpr (EPI == EPI_FILT) {
    const int l = mb + r;
    const float t = (float)l / (float)(ea.L - 1);
#pragma unroll
    for (int i = 0; i < 16; ++i) {
      const int n = nb + crow(i, h);
      const int d = n & 1023;
      const float mind = -3.0701134573253945f, maxd = -15.350567286626972f;
      const float delta = mind + (float)d * ((maxd - mind) / 1023.f);
      ea.o0[(size_t)n * KTL + ea.mrow0 + l] = f2bf(acc[i] * __expf(-t * fabsf(delta)));
    }
  } else if constexpr (EPI == EPI_RES) {
    const int n = nb + r;
    const float bz = ea.bias ? ea.bias[n] : 0.f;
#pragma unroll
    for (int i = 0; i < 16; ++i) {
      const int m = mb + crow(i, h);
      const float gt = ea.gate[mod_index(m) * 6144 + ea.gofs + n];
      if (m < NL) { const size_t o = (size_t)m * 1024 + n; ea.xdl[o] = ea.xsl[o] + gt * (acc[i] + bz); }
      else { const size_t o = (size_t)(m - NL) * 1024 + n; ea.xdc[o] = ea.xsc[o] + gt * (acc[i] + bz); }
    }
  } else if constexpr (EPI == EPI_MLP1) {
    const int n = nb + r;
#pragma unroll
    for (int i = 0; i < 16; ++i) {
      const int m = mb + crow(i, h);
      const float v = fmaxf(acc[i], 0.f);
      ea.o0[(size_t)m * HID + n] = f2bf(v * v);
    }
  } else if constexpr (EPI == EPI_GLAIN) {
    const int n = nb + r;
    if (n < GLA_N) {
#pragma unroll
      for (int i = 0; i < 16; ++i) {
        const int m = mb + crow(i, h);
        ea.o0[(size_t)m * GLA_N + n] = f2bf(acc[i]);
      }
    }
  } else if constexpr (EPI == EPI_MLADN) {
    const int n = nb + r;
#pragma unroll
    for (int i = 0; i < 16; ++i) {
      const int m = mb + crow(i, h);
      ea.o0[(size_t)m * MLA_DNP + n] = f2bf(acc[i]);
    }
  } else if constexpr (EPI == EPI_MLAQ) {
    const int n = nb + r;
    const int hd = n / 192, c = n % 192;
    const float qs = 0.07216878364870322f * 1.4426950408889634f;
    const bool isr = c >= 128;
    const int cc = c - 128;
    const int jj = cc & 15;
    const bool first = (cc & 31) < 16;
    const float invf = __expf(-(float)jj * (9.210340371976184f / 16.f));
#pragma unroll
    for (int i = 0; i < 16; ++i) {
      const int m = mb + crow(i, h);
      const int b = m >> 13, l = m & 8191;
      float v = acc[i];
      const float pv = shx(v, 16, lane);
      if (isr) {
        const float pos = (float)((cc < 32) ? (l >> 6) : (l & 63));
        const float ang = pos * invf;
        float sn, cs;
        __sincosf(ang, &sn, &cs);
        v = first ? (v * cs - pv * sn) : (pv * sn + v * cs);
      }
      ea.o0[((size_t)(b * 8 + hd) * SEQ + l) * 192 + c] = f2bf(v * qs);
    }
  } else if constexpr (EPI == EPI_MLAKV) {
    const int n = nb + r;
    const int hd = n >> 8, c = n & 255;
#pragma unroll
    for (int g = 0; g < 4; ++g) {
      const int m = mb + 8 * g + 4 * h;
      int b, key;
      if (m < NL) { b = m >> 13; key = NCTX + (m & 8191); } else { b = (m - NL) >> 8; key = (m - NL) & 255; }
      if (c < 128) {
#pragma unroll
        for (int q = 0; q < 4; ++q) ea.o0[((size_t)(b * 8 + hd) * NKEY + key + q) * 128 + c] = f2bf(acc[4 * g + q]);
      } else {
        u16x4 o;
#pragma unroll
        for (int q = 0; q < 4; ++q) o[q] = f2bf(acc[4 * g + q]);
        *(u16x4*)(ea.o1 + ((size_t)(b * 8 + hd) * 128 + (c - 128)) * NKEY + key) = o;
      }
    }
  }
}

template <int EPI>
DI void gemm_phase(const u16* __restrict__ A, int lda, const u16* __restrict__ WT, int K, int mtiles, int ntiles,
                           const EpiArgs& ea, unsigned char* smem, int bid, int nblk) {
  constexpr bool SWAP = (EPI == EPI_HYIN || EPI == EPI_FILT);
  u16* As = (u16*)smem;
  u16* Bs = As + 2 * 256 * GS;
  const int tid = ltid(), lane = tid & 63, wv = tid >> 6;
  const int wm = wv & 3, wn = wv >> 2;
  const int r = lane & 31, h = lane >> 5;
  const int nk = K / 64;
  for (int tile = bid; tile < mtiles * ntiles; tile += nblk) {
    const int mt = tile / ntiles, nt = tile % ntiles;
    const int m0 = mt * 256, n0 = nt * 128;
    const u16* Ag = A + (size_t)m0 * lda;
    const u16* Bg = WT + (size_t)n0 * K;
    f32x16 acc00, acc01, acc10, acc11;
#pragma unroll
    for (int q = 0; q < 16; ++q) { acc00[q] = 0.f; acc01[q] = 0.f; acc10[q] = 0.f; acc11[q] = 0.f; }
    uint4 ra0, ra1, ra2, ra3, rb0, rb1;
#define G_LD(k0_)                                                                        \
    ra0 = *(const uint4*)(Ag + (size_t)((tid) >> 3) * lda + (k0_) + (tid & 7) * 8);          \
    ra1 = *(const uint4*)(Ag + (size_t)((tid + NT) >> 3) * lda + (k0_) + (tid & 7) * 8);     \
    ra2 = *(const uint4*)(Ag + (size_t)((tid + 2 * NT) >> 3) * lda + (k0_) + (tid & 7) * 8); \
    ra3 = *(const uint4*)(Ag + (size_t)((tid + 3 * NT) >> 3) * lda + (k0_) + (tid & 7) * 8); \
    rb0 = *(const uint4*)(Bg + (size_t)((tid) >> 3) * K + (k0_) + (tid & 7) * 8);            \
    rb1 = *(const uint4*)(Bg + (size_t)((tid + NT) >> 3) * K + (k0_) + (tid & 7) * 8);
#define G_ST(buf_)                                                                        \
    *(uint4*)(As + (buf_) * 256 * GS + ((tid) >> 3) * GS + (tid & 7) * 8) = ra0;              \
    *(uint4*)(As + (buf_) * 256 * GS + ((tid + NT) >> 3) * GS + (tid & 7) * 8) = ra1;         \
    *(uint4*)(As + (buf_) * 256 * GS + ((tid + 2 * NT) >> 3) * GS + (tid & 7) * 8) = ra2;     \
    *(uint4*)(As + (buf_) * 256 * GS + ((tid + 3 * NT) >> 3) * GS + (tid & 7) * 8) = ra3;     \
    *(uint4*)(Bs + (buf_) * 128 * GS + ((tid) >> 3) * GS + (tid & 7) * 8) = rb0;              \
    *(uint4*)(Bs + (buf_) * 128 * GS + ((tid + NT) >> 3) * GS + (tid & 7) * 8) = rb1;
    G_LD(0)
    __syncthreads();
    G_ST(0)
    __syncthreads();
    for (int kt = 0; kt < nk; ++kt) {
      const int cur = kt & 1;
      if (kt + 1 < nk) { G_LD((kt + 1) * 64) }
      const u16* as = As + cur * 256 * GS + (wm * 64 + r) * GS + h * 8;
      const u16* bs = Bs + cur * 128 * GS + (wn * 64 + r) * GS + h * 8;
#pragma unroll
      for (int kk = 0; kk < 4; ++kk) {
        const bf16x8 a0 = *(const bf16x8*)(as + kk * 16);
        const bf16x8 a1 = *(const bf16x8*)(as + 32 * GS + kk * 16);
        const bf16x8 b0 = *(const bf16x8*)(bs + kk * 16);
        const bf16x8 b1 = *(const bf16x8*)(bs + 32 * GS + kk * 16);
        if constexpr (SWAP) {
          acc00 = MFMA32(b0, a0, acc00); acc01 = MFMA32(b1, a0, acc01);
          acc10 = MFMA32(b0, a1, acc10); acc11 = MFMA32(b1, a1, acc11);
        } else {
          acc00 = MFMA32(a0, b0, acc00); acc01 = MFMA32(a0, b1, acc01);
          acc10 = MFMA32(a1, b0, acc10); acc11 = MFMA32(a1, b1, acc11);
        }
      }
      if (kt + 1 < nk) { G_ST(cur ^ 1) }
      __syncthreads();
    }
    epi_tile<EPI>(ea, acc00, m0 + wm * 64, n0 + wn * 64, lane);
    epi_tile<EPI>(ea, acc01, m0 + wm * 64, n0 + wn * 64 + 32, lane);
    epi_tile<EPI>(ea, acc10, m0 + wm * 64 + 32, n0 + wn * 64, lane);
    epi_tile<EPI>(ea, acc11, m0 + wm * 64 + 32, n0 + wn * 64 + 32, lane);
  }
}

DI float2 cmul(float2 a, float2 b) { return make_float2(a.x * b.x - a.y * b.y, a.x * b.y + a.y * b.x); }
DI float2 cmulc(float2 a, float2 b) { return make_float2(a.x * b.x + a.y * b.y, a.y * b.x - a.x * b.y); }
DI float2 twid(float rev) { return make_float2(__builtin_amdgcn_cosf(rev), __builtin_amdgcn_sinf(rev)); }

#define FWD_BFLY(a0, a1, a2, a3, y0, y1, y2, y3)                                  \
  {                                                                               \
    const float2 t0 = make_float2(a0.x + a2.x, a0.y + a2.y);                      \
    const float2 t1 = make_float2(a0.x - a2.x, a0.y - a2.y);                      \
    const float2 t2 = make_float2(a1.x + a3.x, a1.y + a3.y);                      \
    const float2 t3 = make_float2(a1.y - a3.y, -(a1.x - a3.x));                   \
    y0 = make_float2(t0.x + t2.x, t0.y + t2.y);                                   \
    y1 = make_float2(t1.x + t3.x, t1.y + t3.y);                                   \
    y2 = make_float2(t0.x - t2.x, t0.y - t2.y);                                   \
    y3 = make_float2(t1.x - t3.x, t1.y - t3.y);                                   \
  }
#define INV_BFLY(b0, b1, b2, b3, y0, y1, y2, y3)                                  \
  {                                                                               \
    const float2 t0 = make_float2(b0.x + b2.x, b0.y + b2.y);                      \
    const float2 t1 = make_float2(b0.x - b2.x, b0.y - b2.y);                      \
    const float2 t2 = make_float2(b1.x + b3.x, b1.y + b3.y);                      \
    const float2 t3 = make_float2(-(b1.y - b3.y), b1.x - b3.x);                   \
    y0 = make_float2(t0.x + t2.x, t0.y + t2.y);                                   \
    y1 = make_float2(t1.x + t3.x, t1.y + t3.y);                                   \
    y2 = make_float2(t0.x - t2.x, t0.y - t2.y);                                   \
    y3 = make_float2(t1.x - t3.x, t1.y - t3.y);                                   \
  }

template <int Q>
DI void dif_stage(float2* buf, int tid) {
#pragma unroll 2
  for (int j = tid; j < 4096; j += NT) {
    const int p = j & (Q - 1);
    const int base = ((j - p) << 2) + p;
    const float2 a0 = buf[base], a1 = buf[base + Q], a2 = buf[base + 2 * Q], a3 = buf[base + 3 * Q];
    float2 y0, y1, y2, y3;
    FWD_BFLY(a0, a1, a2, a3, y0, y1, y2, y3);
    const float2 w1 = twid(-(float)p * (1.f / (4.f * Q)));
    const float2 w2 = cmul(w1, w1), w3 = cmul(w2, w1);
    buf[base] = y0; buf[base + Q] = cmul(y1, w1); buf[base + 2 * Q] = cmul(y2, w2); buf[base + 3 * Q] = cmul(y3, w3);
  }
  __syncthreads();
}
template <int Q>
DI void dit_stage(float2* buf, int tid) {
#pragma unroll 2
  for (int j = tid; j < 4096; j += NT) {
    const int p = j & (Q - 1);
    const int base = ((j - p) << 2) + p;
    const float2 w1 = twid(-(float)p * (1.f / (4.f * Q)));
    const float2 w2 = cmul(w1, w1), w3 = cmul(w2, w1);
    const float2 b0 = buf[base], b1 = cmulc(buf[base + Q], w1), b2 = cmulc(buf[base + 2 * Q], w2), b3 = cmulc(buf[base + 3 * Q], w3);
    float2 y0, y1, y2, y3;
    INV_BFLY(b0, b1, b2, b3, y0, y1, y2, y3);
    buf[base] = y0; buf[base + Q] = y1; buf[base + 2 * Q] = y2; buf[base + 3 * Q] = y3;
  }
  __syncthreads();
}
DI void fft_fwd_upto4(float2* buf, int tid) {
  dif_stage<4096>(buf, tid); dif_stage<1024>(buf, tid); dif_stage<256>(buf, tid);
  dif_stage<64>(buf, tid); dif_stage<16>(buf, tid); dif_stage<4>(buf, tid);
}
DI void fft_inv_from4_to1024(float2* buf, int tid) {
  dit_stage<4>(buf, tid); dit_stage<16>(buf, tid); dit_stage<64>(buf, tid);
  dit_stage<256>(buf, tid); dit_stage<1024>(buf, tid);
}
DI float sconv(const u16* z, int t, int L, float w0, float w1, float w2, float cb) {
  const float c = bf2f(z[t]);
  const float a = t > 0 ? bf2f(z[t - 1]) : 0.f;
  const float b = t < L - 1 ? bf2f(z[t + 1]) : 0.f;
  return w0 * a + w1 * c + w2 * b + cb;
}
DI float block_sum(float v, float* red, int tid) {
  v = wave_sum(v, tid & 63);
  __syncthreads();
  if ((tid & 63) == 0) red[tid >> 6] = v;
  __syncthreads();
  float s = 0.f;
#pragma unroll
  for (int i = 0; i < 8; ++i) s += red[i];
  return s;
}

DI void fft_middle(float2* buf, const float2* Kg, int tid) {
#pragma unroll 2
  for (int j = tid; j < 4096; j += NT) {
    float4* p4 = (float4*)(buf + 4 * j);
    const float4* k4 = (const float4*)(Kg + 4 * j);
    const float4 u0 = p4[0], u1 = p4[1];
    const float4 k0 = k4[0], k1 = k4[1];
    const float2 a0 = make_float2(u0.x, u0.y), a1 = make_float2(u0.z, u0.w), a2 = make_float2(u1.x, u1.y), a3 = make_float2(u1.z, u1.w);
    float2 y0, y1, y2, y3;
    FWD_BFLY(a0, a1, a2, a3, y0, y1, y2, y3);
    const float2 b0 = cmul(y0, make_float2(k0.x, k0.y)), b1 = cmul(y1, make_float2(k0.z, k0.w));
    const float2 b2 = cmul(y2, make_float2(k1.x, k1.y)), b3 = cmul(y3, make_float2(k1.z, k1.w));
    float2 z0, z1, z2, z3;
    INV_BFLY(b0, b1, b2, b3, z0, z1, z2, z3);
    p4[0] = make_float4(z0.x, z0.y, z1.x, z1.y);
    p4[1] = make_float4(z2.x, z2.y, z3.x, z3.y);
  }
  __syncthreads();
}
DI void fft_filter_last(const float2* buf, float2* Kg, int tid, float scl, float skp) {
#pragma unroll 2
  for (int j = tid; j < 4096; j += NT) {
    const float4* p4 = (const float4*)(buf + 4 * j);
    float4* k4 = (float4*)(Kg + 4 * j);
    const float4 u0 = p4[0], u1 = p4[1];
    const float2 a0 = make_float2(u0.x, u0.y), a1 = make_float2(u0.z, u0.w), a2 = make_float2(u1.x, u1.y), a3 = make_float2(u1.z, u1.w);
    float2 y0, y1, y2, y3;
    FWD_BFLY(a0, a1, a2, a3, y0, y1, y2, y3);
    k4[0] = make_float4(y0.x * scl + skp, y0.y * scl, y1.x * scl + skp, y1.y * scl);
    k4[1] = make_float4(y2.x * scl + skp, y2.y * scl, y3.x * scl + skp, y3.y * scl);
  }
}

DI void hyena_lat_unit(const Params& P, int jl, int d, unsigned char* smem) {
  float2* buf = (float2*)smem;
  float* red = (float*)(smem + 131072);
  const int tid = ltid();
  const u16* zT = (const u16*)(P.ws + OFF_BIG + B_ZT);
  const u16* kT = (const u16*)(P.ws + OFF_BIG + B_KT);
  u16* yT = (u16*)(P.ws + OFF_BIG + B_YT);
  float2* Kg = (float2*)(P.ws + OFF_A) + (size_t)blockIdx.x * 32768;
#pragma unroll 1
  for (int n = 0; n < 2; ++n) {
    const u16* kf = kT + (size_t)((n * 2 + 0) * 1024 + d) * KTL;
    const u16* kb = kT + (size_t)((n * 2 + 1) * 1024 + d) * KTL;
    float s = 0.f;
    for (int t = tid; t < SEQ; t += NT) {
      const float f = bf2f(kf[t]);
      buf[t] = make_float2(f, 0.f);
      s += fabsf(f);
      if (t >= 1) { const float g = bf2f(kb[t]); buf[16384 - t] = make_float2(g, 0.f); s += fabsf(g); }
    }
    if (tid == 0) buf[SEQ] = make_float2(0.f, 0.f);
    const float S = block_sum(s, red, tid);
    fft_fwd_upto4(buf, tid);
    const float scl = 1.f / (S * 16384.f);
    const float skp = P.hy_bias[(jl * 2 + n) * 1024 + d] * (1.f / 16384.f);
    fft_filter_last(buf, Kg + n * 16384, tid, scl, skp);
    __syncthreads();
  }
  const float* cw = P.hy_conv_w + (size_t)jl * 3 * 3072;
  const float* cbp = P.hy_conv_b + (size_t)jl * 3072;
  const float w00 = cw[d], w01 = cw[3072 + d], w02 = cw[2 * 3072 + d], cb0 = cbp[d];
  const float w10 = cw[1024 + d], w11 = cw[3072 + 1024 + d], w12 = cw[2 * 3072 + 1024 + d], cb1 = cbp[1024 + d];
  const float w20 = cw[2048 + d], w21 = cw[3072 + 2048 + d], w22 = cw[2 * 3072 + 2048 + d], cb2 = cbp[2048 + d];
  for (int pair = 0; pair < 2; ++pair) {
    const u16* za0 = zT + (size_t)d * NTOK + (size_t)(2 * pair) * SEQ;
    const u16* za1 = za0 + SEQ;
    const u16* zb0 = zT + (size_t)(1024 + d) * NTOK + (size_t)(2 * pair) * SEQ;
    const u16* zb1 = zb0 + SEQ;
    const u16* zc0 = zT + (size_t)(2048 + d) * NTOK + (size_t)(2 * pair) * SEQ;
    const u16* zc1 = zc0 + SEQ;
#pragma unroll 1
    for (int p = tid; p < 4096; p += NT) {
      const float2 a0 = make_float2(sconv(za0, p, SEQ, w00, w01, w02, cb0), sconv(za1, p, SEQ, w00, w01, w02, cb0));
      const float2 a1 = make_float2(sconv(za0, p + 4096, SEQ, w00, w01, w02, cb0), sconv(za1, p + 4096, SEQ, w00, w01, w02, cb0));
      const float2 zz = make_float2(0.f, 0.f);
      float2 y0, y1, y2, y3;
      FWD_BFLY(a0, a1, zz, zz, y0, y1, y2, y3);
      const float2 w1 = twid(-(float)p * (1.f / 16384.f));
      const float2 w2 = cmul(w1, w1), w3 = cmul(w2, w1);
      buf[p] = y0; buf[p + 4096] = cmul(y1, w1); buf[p + 8192] = cmul(y2, w2); buf[p + 12288] = cmul(y3, w3);
    }
    __syncthreads();
    dif_stage<1024>(buf, tid); dif_stage<256>(buf, tid); dif_stage<64>(buf, tid); dif_stage<16>(buf, tid); dif_stage<4>(buf, tid);
    fft_middle(buf, Kg, tid);
    fft_inv_from4_to1024(buf, tid);
#pragma unroll 1
    for (int p = tid; p < 4096; p += NT) {
      const float2 w1 = twid(-(float)p * (1.f / 16384.f));
      const float2 w2 = cmul(w1, w1), w3 = cmul(w2, w1);
      const float2 b0 = buf[p], b1 = cmulc(buf[p + 4096], w1), b2 = cmulc(buf[p + 8192], w2), b3 = cmulc(buf[p + 12288], w3);
      float2 y0, y1, y2, y3;
      INV_BFLY(b0, b1, b2, b3, y0, y1, y2, y3);
      const float g00 = sconv(zb0, p, SEQ, w10, w11, w12, cb1), g01 = sconv(zb1, p, SEQ, w10, w11, w12, cb1);
      const float g10 = sconv(zb0, p + 4096, SEQ, w10, w11, w12, cb1), g11 = sconv(zb1, p + 4096, SEQ, w10, w11, w12, cb1);
      buf[p] = make_float2(y0.x * g00, y0.y * g01);
      buf[p + 4096] = make_float2(y1.x * g10, y1.y * g11);
      buf[p + 8192] = make_float2(0.f, 0.f);
      buf[p + 12288] = make_float2(0.f, 0.f);
    }
    __syncthreads();
    fft_fwd_upto4(buf, tid);
    fft_middle(buf, Kg + 16384, tid);
    fft_inv_from4_to1024(buf, tid);
#pragma unroll 1
    for (int p = tid; p < 4096; p += NT) {
      const float2 w1 = twid(-(float)p * (1.f / 16384.f));
      const float2 w2 = cmul(w1, w1), w3 = cmul(w2, w1);
      const float2 b0 = buf[p], b1 = cmulc(buf[p + 4096], w1), b2 = cmulc(buf[p + 8192], w2), b3 = cmulc(buf[p + 12288], w3);
      float2 y0, y1, y2, y3;
      INV_BFLY(b0, b1, b2, b3, y0, y1, y2, y3);
      const float g00 = sconv(zc0, p, SEQ, w20, w21, w22, cb2), g01 = sconv(zc1, p, SEQ, w20, w21, w22, cb2);
      const float g10 = sconv(zc0, p + 4096, SEQ, w20, w21, w22, cb2), g11 = sconv(zc1, p + 4096, SEQ, w20, w21, w22, cb2);
      u16* yo = yT + (size_t)d * NTOK + (size_t)(2 * pair) * SEQ;
      yo[p] = f2bf(y0.x * g00); yo[SEQ + p] = f2bf(y0.y * g01);
      yo[p + 4096] = f2bf(y1.x * g10); yo[SEQ + p + 4096] = f2bf(y1.y * g11);
    }
    __syncthreads();
  }
}

DI void hyena_ctx_unit(const Params& P, int jl, int d, unsigned char* smem) {
  float* kk = (float*)smem;
  float* ya = kk + 1024;
  float* yb = ya + 1024;
  float* red = yb + 1024;
  const int tid = ltid();
  const u16* zT = (const u16*)(P.ws + OFF_BIG + B_ZT);
  const u16* kT = (const u16*)(P.ws + OFF_BIG + B_KT);
  u16* yT = (u16*)(P.ws + OFF_BIG + B_YT);
  const float* cw = P.hy_conv_w + (size_t)jl * 3 * 3072;
  const float* cbp = P.hy_conv_b + (size_t)jl * 3072;
#pragma unroll
  for (int n = 0; n < 2; ++n) {
    const u16* kf = kT + (size_t)((n * 2 + 0) * 1024 + d) * KTL + SEQ;
    const u16* kb = kT + (size_t)((n * 2 + 1) * 1024 + d) * KTL + SEQ;
    float s = 0.f, f = 0.f, g = 0.f;
    if (tid < 256) { f = bf2f(kf[tid]); s = fabsf(f); }
    else if (tid > 256) { g = bf2f(kb[tid - 256]); s = fabsf(g); }
    const float S = block_sum(s, red, tid);
    if (tid < 256) kk[n * 512 + 256 + tid] = f / S;
    else if (tid > 256) kk[n * 512 + 256 - (tid - 256)] = g / S;
    else kk[n * 512 + 0] = 0.f;
  }
  for (int e = tid; e < 1024; e += NT) {
    const int b = e >> 8, t = e & 255;
    const u16* z0 = zT + (size_t)d * NTOK + NL + b * 256;
    ya[e] = sconv(z0, t, NCTX, cw[d], cw[3072 + d], cw[2 * 3072 + d], cbp[d]);
  }
  __syncthreads();
#pragma unroll
  for (int n = 0; n < 2; ++n) {
    const float* src = n == 0 ? ya : yb;
    float* dst = n == 0 ? yb : ya;
    const int ch = (n + 1) * 1024 + d;
    const float skp = P.hy_bias[(jl * 2 + n) * 1024 + d];
    for (int e = tid; e < 1024; e += NT) {
      const int b = e >> 8, t = e & 255;
      float acc = 0.f;
      for (int s = 0; s < 256; ++s) acc += kk[n * 512 + 256 + t - s] * src[b * 256 + s];
      acc += skp * src[e];
      const u16* zg = zT + (size_t)ch * NTOK + NL + b * 256;
      const float gate = sconv(zg, t, NCTX, cw[ch], cw[3072 + ch], cw[2 * 3072 + ch], cbp[ch]);
      const float o = acc * gate;
      if (n == 0) dst[e] = o;
      else yT[(size_t)d * NTOK + NL + e] = f2bf(o);
    }
    __syncthreads();
  }
}

DI void hyena_conv_phase(const Params& P, int jl, bool with_ctx, unsigned char* smem, int bid, int nblk) {
  for (int u = bid; u < 1024; u += nblk) hyena_lat_unit(P, jl, u, smem);
  if (with_ctx) {
    __syncthreads();
    for (int u = bid; u < 1024; u += nblk) hyena_ctx_unit(P, jl, u, smem);
  }
}

DI void transpose_phase(const Params& P, int ncols, unsigned char* smem, int bid, int nblk) {
  u16* t = (u16*)smem;
  const u16* yT = (const u16*)(P.ws + OFF_BIG + B_YT);
  u16* A = (u16*)(P.ws + OFF_A);
  const int tid = ltid();
  const int tcols = ncols / 64;
  for (int tile = bid; tile < 16 * tcols; tile += nblk) {
    const int d0 = (tile / tcols) * 64, m0 = (tile % tcols) * 64;
    {
      const int rr = tid >> 3, ch = tid & 7;
      *(uint4*)(t + rr * 72 + ch * 8) = *(const uint4*)(yT + (size_t)(d0 + rr) * NTOK + m0 + ch * 8);
    }
    __syncthreads();
    {
      const int m = tid >> 3, dc = (tid & 7) * 8;
      u16x8 o;
#pragma unroll
      for (int j = 0; j < 8; ++j) o[j] = t[(dc + j) * 72 + m];
      *(u16x8*)(A + (size_t)(m0 + m) * 1024 + d0 + dc) = o;
    }
    __syncthreads();
  }
}

DI float logsigmoid(float x) { return fminf(x, 0.f) - __logf(1.f + __expf(-fabsf(x))); }

DI void gla_scan_phase(const Params& P, unsigned char* smem, int bid, int nblk) {
  u16* qs = (u16*)smem;
  u16* ks = qs + 64 * 136;
  u16* ket = ks + 64 * 136;
  u16* vt = ket + 128 * 72;
  u16* sb = vt + 32 * 72;
  u16* ps = sb + 32 * 136;
  float* gs = (float*)(ps + 64 * 72);
  float* w2s = gs + 64 * 129;
  float* gkb = w2s + 16 * 128;
  float* rs = gkb + 128;
  float* tots = rs + 64 * 16;
  const int tid = ltid(), lane = tid & 63, wv = tid >> 6;
  const int r = lane & 31, h = lane >> 5;
  const u16* Z = (const u16*)(P.ws + OFF_BIG + B_GZ);
  for (int u = bid; u < 256; u += nblk) {
    const int vs = u & 7, dir = (u >> 3) & 1, hd = (u >> 4) & 3, b = u >> 6;
    u16* O = dir == 0 ? (u16*)(P.ws + OFF_A) : (u16*)(P.ws + OFF_BIG + B_GOB);
    __syncthreads();
    for (int e = tid; e < 16 * 128; e += NT) w2s[e] = P.gla_gk_w2[(size_t)(dir * 16 + (e >> 7)) * 512 + hd * 128 + (e & 127)];
    if (tid < 128) gkb[tid] = P.gla_gk_b[dir * 512 + hd * 128 + tid];
    for (int e = tid; e < 32 * 136; e += NT) sb[e] = 0;
    f32x16 S;
#pragma unroll
    for (int i = 0; i < 16; ++i) S[i] = 0.f;
    for (int ci = 0; ci < 132; ++ci) {
      int row0;
      if (ci < 4) row0 = NL + b * 256 + (dir == 0 ? ci : 3 - ci) * 64;
      else row0 = b * SEQ + (dir == 0 ? ci - 4 : 131 - ci) * 64;
      const u16* Zr = Z + (size_t)row0 * GLA_N;
      __syncthreads();
#pragma unroll
      for (int i = 0; i < 2; ++i) {
        const int c = tid + i * NT, rr = c >> 4, cc = (c & 15) * 8;
        *(uint4*)(qs + rr * 136 + cc) = *(const uint4*)(Zr + (size_t)rr * GLA_N + hd * 128 + cc);
        *(uint4*)(ks + rr * 136 + cc) = *(const uint4*)(Zr + (size_t)rr * GLA_N + 512 + hd * 128 + cc);
      }
      if (tid < 256) {
        const int rr = tid >> 2, cc = (tid & 3) * 8;
        const u16x8 v = *(const u16x8*)(Zr + (size_t)rr * GLA_N + 1024 + hd * 256 + vs * 32 + cc);
#pragma unroll
        for (int j = 0; j < 8; ++j) vt[(cc + j) * 72 + rr] = v[j];
      } else if (tid < 384) {
        const int t2 = tid - 256, rr = t2 >> 1, cc = (t2 & 1) * 8;
        const u16x8 v = *(const u16x8*)(Zr + (size_t)rr * GLA_N + 3072 + dir * 16 + cc);
#pragma unroll
        for (int j = 0; j < 8; ++j) rs[rr * 16 + cc + j] = bf2f(v[j]);
      }
      __syncthreads();
#pragma unroll 4
      for (int m = 0; m < 16; ++m) {
        const int e = tid + m * NT, i = e >> 7, dk = e & 127;
        float a = gkb[dk];
#pragma unroll
        for (int q = 0; q < 16; ++q) a += rs[i * 16 + q] * w2s[q * 128 + dk];
        gs[i * 129 + dk] = logsigmoid(a) * (1.f / 16.f);
      }
      __syncthreads();
      if (tid < 128) {
        float run = 0.f;
        if (dir == 0) { for (int i = 0; i < 64; ++i) { run += gs[i * 129 + tid]; gs[i * 129 + tid] = run; } }
        else { for (int i = 63; i >= 0; --i) { run += gs[i * 129 + tid]; gs[i * 129 + tid] = run; } }
        tots[tid] = run;
      }
      __syncthreads();
#pragma unroll 4
      for (int m = 0; m < 16; ++m) {
        const int e = tid + m * NT, i = e >> 7, dk = e & 127;
        const float bb = gs[i * 129 + dk];
        const float qv = bf2f(qs[i * 136 + dk]), kv = bf2f(ks[i * 136 + dk]);
        qs[i * 136 + dk] = f2bf(qv * __expf(bb) * 0.08838834764831845f);
        ks[i * 136 + dk] = f2bf(kv * __expf(-bb));
        ket[dk * 72 + i] = f2bf(kv * __expf(tots[dk] - bb));
      }
      __syncthreads();
      f32x16 Sn;
      if (wv < 4) {
#pragma unroll
        for (int i = 0; i < 16; ++i) Sn[i] = S[i] * __expf(tots[wv * 32 + crow(i, h)]);
#pragma unroll
        for (int ss = 0; ss < 4; ++ss) {
          const bf16x8 a = *(const bf16x8*)(ket + (wv * 32 + r) * 72 + ss * 16 + h * 8);
          const bf16x8 bv = *(const bf16x8*)(vt + r * 72 + ss * 16 + h * 8);
          Sn = MFMA32(a, bv, Sn);
        }
      } else {
        const int w4 = wv - 4, ti = w4 & 1, tj = w4 >> 1;
        f32x16 at;
#pragma unroll
        for (int i = 0; i < 16; ++i) at[i] = 0.f;
#pragma unroll
        for (int kk = 0; kk < 8; ++kk) {
          const bf16x8 a = *(const bf16x8*)(qs + (ti * 32 + r) * 136 + kk * 16 + h * 8);
          const bf16x8 bv = *(const bf16x8*)(ks + (tj * 32 + r) * 136 + kk * 16 + h * 8);
          at = MFMA32(a, bv, at);
        }
#pragma unroll
        for (int i = 0; i < 16; ++i) {
          const int ii = ti * 32 + crow(i, h), sj = tj * 32 + r;
          const bool keep = dir == 0 ? (sj <= ii) : (sj >= ii);
          ps[ii * 72 + sj] = f2bf(keep ? at[i] : 0.f);
        }
      }
      __syncthreads();
      if (wv == 4 || wv == 5) {
        const int ti = wv - 4;
        f32x16 o;
#pragma unroll
        for (int i = 0; i < 16; ++i) o[i] = 0.f;
#pragma unroll
        for (int ss = 0; ss < 4; ++ss) {
          const bf16x8 a = *(const bf16x8*)(ps + (ti * 32 + r) * 72 + ss * 16 + h * 8);
          const bf16x8 bv = *(const bf16x8*)(vt + r * 72 + ss * 16 + h * 8);
          o = MFMA32(a, bv, o);
        }
#pragma unroll
        for (int kk = 0; kk < 8; ++kk) {
          const bf16x8 a = *(const bf16x8*)(qs + (ti * 32 + r) * 136 + kk * 16 + h * 8);
          const bf16x8 bv = *(const bf16x8*)(sb + r * 136 + kk * 16 + h * 8);
          o = MFMA32(a, bv, o);
        }
#pragma unroll
        for (int i = 0; i < 16; ++i) {
          const int ii = ti * 32 + crow(i, h);
          O[(size_t)(row0 + ii) * 1024 + hd * 256 + vs * 32 + r] = f2bf(o[i]);
        }
      }
      __syncthreads();
      if (wv < 4) {
        S = Sn;
#pragma unroll
        for (int g = 0; g < 4; ++g) {
          u16x4 o;
#pragma unroll
          for (int q = 0; q < 4; ++q) o[q] = f2bf(S[4 * g + q]);
          *(u16x4*)(sb + r * 136 + wv * 32 + 8 * g + 4 * h) = o;
        }
      }
    }
  }
}

DI void gla_out_phase(const Params& P, int bid, int nblk) {
  const int lane = ltid() & 63, wv = ltid() >> 6;
  u16* A = (u16*)(P.ws + OFF_A);
  const u16* Ob = (const u16*)(P.ws + OFF_BIG + B_GOB);
  const u16* Z = (const u16*)(P.ws + OFF_BIG + B_GZ);
  for (int task = bid * 8 + wv; task < NTOK * 4; task += nblk * 8) {
    const int row = task >> 2, hd = task & 3;
    const size_t o = (size_t)row * 1024 + hd * 256 + lane * 4;
    const u16x4 a = *(const u16x4*)(A + o), bq = *(const u16x4*)(Ob + o);
    const u16x4 og = *(const u16x4*)(Z + (size_t)row * GLA_N + 2048 + hd * 256 + lane * 4);
    float v[4];
    float ss = 0.f;
#pragma unroll
    for (int j = 0; j < 4; ++j) { v[j] = bf2f(a[j]) + bf2f(bq[j]); ss += v[j] * v[j]; }
    ss = wave_sum(ss, lane);
    const float rstd = rsqrtf(ss * (1.f / 256.f) + EPS);
    u16x4 res;
#pragma unroll
    for (int j = 0; j < 4; ++j) res[j] = f2bf(v[j] * rstd * P.gla_onorm[lane * 4 + j] * silu(bf2f(og[j])));
    *(u16x4*)(A + o) = res;
  }
}

DI void mla_prep_phase(const Params& P, int bid, int nblk) {
  const int lane = ltid() & 63, wv = ltid() >> 6;
  const u16* Cd = (const u16*)(P.ws + OFF_BIG + B_CD);
  u16* CQN = (u16*)(P.ws + OFF_A + A_CQN);
  u16* CKVN = (u16*)(P.ws + OFF_A + A_CKVN);
  u16* KR = (u16*)(P.ws + OFF_BIG + B_KR);
  for (int row = bid * 8 + wv; row < NTOK; row += nblk * 8) {
    const u16* cr = Cd + (size_t)row * MLA_DNP;
    if (row < NL) {
      float v[6], ss = 0.f;
#pragma unroll
      for (int j = 0; j < 6; ++j) { v[j] = bf2f(cr[lane + 64 * j]); ss += v[j] * v[j]; }
      ss = wave_sum(ss, lane);
      const float rstd = rsqrtf(ss * (1.f / 384.f) + EPS);
#pragma unroll
      for (int j = 0; j < 6; ++j) CQN[(size_t)row * 384 + lane + 64 * j] = f2bf(v[j] * rstd * P.mla_qnorm[lane + 64 * j]);
    }
    {
      float v[4], ss = 0.f;
#pragma unroll
      for (int j = 0; j < 4; ++j) { v[j] = bf2f(cr[384 + lane + 64 * j]); ss += v[j] * v[j]; }
      ss = wave_sum(ss, lane);
      const float rstd = rsqrtf(ss * (1.f / 256.f) + EPS);
#pragma unroll
      for (int j = 0; j < 4; ++j) CKVN[(size_t)row * 256 + lane + 64 * j] = f2bf(v[j] * rstd * P.mla_kvnorm[lane + 64 * j]);
    }
    {
      float x = bf2f(cr[640 + lane]);
      const float px = shx(x, 16, lane);
      int b, key;
      if (row < NL) {
        b = row >> 13; const int l = row & 8191; key = NCTX + l;
        const int jj = lane & 15;
        const bool first = (lane & 31) < 16;
        const float invf = __expf(-(float)jj * (9.210340371976184f / 16.f));
        const float pos = (float)(lane < 32 ? (l >> 6) : (l & 63));
        float sn, cs;
        __sincosf(pos * invf, &sn, &cs);
        x = first ? (x * cs - px * sn) : (px * sn + x * cs);
      } else { b = (row - NL) >> 8; key = (row - NL) & 255; }
      KR[((size_t)b * NKEY + key) * 64 + lane] = f2bf(x);
    }
  }
}

constexpr int KS_STRIDE = 200;
constexpr int VS_STRIDE = 68;
DI void mla_attn_phase(const Params& P, unsigned char* smem, int bid, int nblk) {
  u16* Ks = (u16*)smem;
  u16* Vs = Ks + 2 * 64 * KS_STRIDE;
  const int tid = ltid(), lane = tid & 63, wv = tid >> 6;
  const int r = lane & 31, h = lane >> 5;
  const u16* Qg = (const u16*)(P.ws + OFF_BIG + B_Q);
  const u16* Kn = (const u16*)(P.ws + OFF_BIG + B_KN);
  const u16* VT = (const u16*)(P.ws + OFF_BIG + B_VT);
  const u16* KR = (const u16*)(P.ws + OFF_BIG + B_KR);
  u16* O = (u16*)(P.ws + OFF_A);
  for (int u = bid; u < 1024; u += nblk) {
    const int bh = u >> 5, qb = u & 31, b = bh >> 3, hd = bh & 7;
    const int l = qb * 256 + wv * 32 + r;
    bf16x8 qf[12];
    {
      const u16* qp = Qg + ((size_t)bh * SEQ + l) * 192 + h * 8;
#pragma unroll
      for (int s = 0; s < 12; ++s) qf[s] = *(const bf16x8*)(qp + s * 16);
    }
    f32x16 oacc[4];
#pragma unroll
    for (int d = 0; d < 4; ++d)
#pragma unroll
      for (int i = 0; i < 16; ++i) oacc[d][i] = 0.f;
    float mrun = -1e30f, lrun = 0.f;
    const u16* Kb = Kn + (size_t)bh * NKEY * 128;
    const u16* Rb = KR + (size_t)b * NKEY * 64;
    const u16* Vb = VT + (size_t)bh * 128 * NKEY;
    uint4 rk0, rk1, rk2, rv0, rv1;
#define ATT_GLOAD(kt_)                                                                                      \
    { const int key0 = (kt_) * 64;                                                                          \
      rk0 = *(const uint4*)(Kb + (size_t)(key0 + (tid >> 4)) * 128 + (tid & 15) * 8);                       \
      rk1 = *(const uint4*)(Kb + (size_t)(key0 + 32 + (tid >> 4)) * 128 + (tid & 15) * 8);                  \
      rk2 = *(const uint4*)(Rb + (size_t)(key0 + (tid >> 3)) * 64 + (tid & 7) * 8);                         \
      rv0 = *(const uint4*)(Vb + (size_t)(tid >> 3) * NKEY + key0 + (tid & 7) * 8);                         \
      rv1 = *(const uint4*)(Vb + (size_t)(64 + (tid >> 3)) * NKEY + key0 + (tid & 7) * 8); }
#define ATT_STV(src_, row_, buf_)                                                                           \
    { uint2* dp = (uint2*)(Vs + (buf_) * 128 * VS_STRIDE + (row_) * VS_STRIDE + (tid & 7) * 8);                \
      dp[0] = make_uint2(src_.x, src_.y); dp[1] = make_uint2(src_.z, src_.w); }
#define ATT_SSTORE(buf_)                                                                                    \
    { *(uint4*)(Ks + (buf_) * 64 * KS_STRIDE + (tid >> 4) * KS_STRIDE + (tid & 15) * 8) = rk0;                \
      *(uint4*)(Ks + (buf_) * 64 * KS_STRIDE + (32 + (tid >> 4)) * KS_STRIDE + (tid & 15) * 8) = rk1;         \
      *(uint4*)(Ks + (buf_) * 64 * KS_STRIDE + (tid >> 3) * KS_STRIDE + 128 + (tid & 7) * 8) = rk2;           \
      ATT_STV(rv0, (tid >> 3), buf_) ATT_STV(rv1, (64 + (tid >> 3)), buf_) }
    ATT_GLOAD(0);
    __syncthreads();
    ATT_SSTORE(0);
    __syncthreads();
    for (int kt = 0; kt < 132; ++kt) {
      const int cur = kt & 1;
      if (kt + 1 < 132) ATT_GLOAD(kt + 1);
      const u16* kc = Ks + cur * 64 * KS_STRIDE;
      const u16* vc = Vs + cur * 128 * VS_STRIDE;
#pragma unroll 1
      for (int t2 = 0; t2 < 2; ++t2) {
        f32x16 st;
#pragma unroll
        for (int i = 0; i < 16; ++i) st[i] = 0.f;
#pragma unroll
        for (int s = 0; s < 12; ++s) {
          const bf16x8 a = *(const bf16x8*)(kc + (t2 * 32 + r) * KS_STRIDE + s * 16 + h * 8);
          st = MFMA32(a, qf[s], st);
        }
        float mx = st[0];
#pragma unroll
        for (int i = 1; i < 16; ++i) mx = fmaxf(mx, st[i]);
        mx = fmaxf(mx, shx(mx, 32, lane));
        const float mnew = fmaxf(mrun, mx);
        const float alpha = __builtin_amdgcn_exp2f(mrun - mnew);
        mrun = mnew;
        float ls = 0.f;
#pragma unroll
        for (int i = 0; i < 16; ++i) { const float p = __builtin_amdgcn_exp2f(st[i] - mnew); st[i] = p; ls += p; }
        ls += shx(ls, 32, lane);
        lrun = lrun * alpha + ls;
#pragma unroll
        for (int d = 0; d < 4; ++d)
#pragma unroll
          for (int i = 0; i < 16; ++i) oacc[d][i] *= alpha;
        if (t2 == 0 && kt + 1 < 132) ATT_SSTORE(cur ^ 1);
#pragma unroll
        for (int s2 = 0; s2 < 2; ++s2) {
          bf16x8 pf;
#pragma unroll
          for (int j = 0; j < 8; ++j) pf[j] = (short)f2bf(st[8 * s2 + j]);
#pragma unroll
          for (int d = 0; d < 4; ++d) {
            const u16* vp = vc + (d * 32 + r) * VS_STRIDE + t2 * 32 + 16 * s2 + 4 * h;
            const uint2 lo = *(const uint2*)vp, hi = *(const uint2*)(vp + 8);
            uint4 av = make_uint4(lo.x, lo.y, hi.x, hi.y);
            oacc[d] = MFMA32(__builtin_bit_cast(bf16x8, av), pf, oacc[d]);
          }
        }
      }
      __syncthreads();
    }
    const float inv = 1.f / lrun;
    u16* op = O + (size_t)(b * SEQ + l) * 1024 + hd * 128;
#pragma unroll
    for (int d = 0; d < 4; ++d)
#pragma unroll
      for (int g = 0; g < 4; ++g) {
        u16x4 o;
#pragma unroll
        for (int q = 0; q < 4; ++q) o[q] = f2bf(oacc[d][4 * g + q] * inv);
        *(u16x4*)(op + d * 32 + 8 * g + 4 * h) = o;
      }
  }
}

constexpr int NPHASE = 35;

DI void run_phase(const Params& P, int ph, unsigned char* smem, int bid, int nblk) {
  u16* WT = (u16*)(P.ws + OFF_WT);
  u16* A = (u16*)(P.ws + OFF_A);
  unsigned char* BIG = P.ws + OFF_BIG;
  float* XC = (float*)(P.ws + OFF_XC);
  const float* MOD = (const float*)(P.ws + OFF_MOD);
  EpiArgs ea{};
  if (ph == 0) {
    pro_weights(P, smem, bid, nblk);
    __syncthreads();
    pro_adaln(P, smem, bid, nblk);
    pro_filter_mlp(P, bid, nblk);
    return;
  }
  if (ph == 34) { final_norm_phase(P, bid, nblk); return; }
  int li, sub;
  if (ph <= 8) { li = 0; sub = ph - 1; }
  else if (ph <= 16) { li = 1; sub = ph - 9; }
  else if (ph <= 25) { li = 2; sub = ph - 17; }
  else { li = 3; sub = ph - 26; }
  const bool ctx_on = li <= 1;
  const int rows_all = ctx_on ? NTOK : NL;
  const int mt_all = rows_all / 256;
  const float* xl = li == 0 ? P.x : P.out;
  const float* xc = li == 0 ? P.ctx : XC;
  const int nsub = li == 2 ? 9 : 8;
  if (sub == nsub - 3) { normmod_phase(P, li, 1, rows_all, P.out, XC, bid, nblk); return; }
  if (sub == nsub - 2) {
    ea.o0 = (u16*)(BIG + B_HID);
    gemm_phase<EPI_MLP1>(A, 1024, WT + W_MLP1(li), 1024, mt_all, 32, ea, smem, bid, nblk);
    return;
  }
  if (sub == nsub - 1) {
    ea.gate = MOD + (size_t)li * 5 * 6144; ea.gofs = 5 * 1024;
    ea.xsl = P.out; ea.xsc = XC; ea.xdl = P.out; ea.xdc = XC;
    gemm_phase<EPI_RES>((const u16*)(BIG + B_HID), HID, WT + W_MLP2(li), HID, mt_all, 8, ea, smem, bid, nblk);
    return;
  }
  ea.gate = MOD + (size_t)li * 5 * 6144; ea.gofs = 2 * 1024;
  ea.xsl = xl; ea.xsc = xc; ea.xdl = P.out; ea.xdc = XC;
  if (li == 0 || li == 3) {
    const int jl = li == 0 ? 0 : 1;
    switch (sub) {
      case 0: normmod_phase(P, li, 0, rows_all, xl, xc, bid, nblk); break;
      case 1: {
        EpiArgs e1{};
        e1.bias = P.hy_b_in + jl * 3072; e1.o0 = (u16*)(BIG + B_ZT);
        gemm_phase<EPI_HYIN>(A, 1024, WT + W_HYIN(jl), 1024, mt_all, 24, e1, smem, bid, nblk);
        EpiArgs e2{};
        e2.o0 = (u16*)(BIG + B_KT); e2.mrow0 = 0; e2.L = SEQ;
        const u16* h3 = (const u16*)(P.ws + OFF_H3) + (size_t)jl * KTL * 64;
        gemm_phase<EPI_FILT>(h3, 64, WT + W_HYF4(jl), 64, 32, 32, e2, smem, bid, nblk);
        if (ctx_on) {
          e2.mrow0 = SEQ; e2.L = NCTX;
          gemm_phase<EPI_FILT>(h3 + (size_t)SEQ * 64, 64, WT + W_HYF4(jl), 64, 1, 32, e2, smem, bid, nblk);
        }
      } break;
      case 2: hyena_conv_phase(P, jl, ctx_on, smem, bid, nblk); break;
      case 3: transpose_phase(P, rows_all, smem, bid, nblk); break;
      case 4:
        ea.bias = P.hy_b_out + jl * 1024;
        gemm_phase<EPI_RES>(A, 1024, WT + W_HYOUT(jl), 1024, mt_all, 8, ea, smem, bid, nblk);
        break;
    }
    return;
  }
  if (li == 1) {
    switch (sub) {
      case 0: normmod_phase(P, li, 0, NTOK, xl, xc, bid, nblk); break;
      case 1: {
        EpiArgs e1{};
        e1.o0 = (u16*)(BIG + B_GZ);
        gemm_phase<EPI_GLAIN>(A, 1024, WT + W_GLAIN, 1024, NTOK / 256, GLA_NP / 128, e1, smem, bid, nblk);
      } break;
      case 2: gla_scan_phase(P, smem, bid, nblk); break;
      case 3: gla_out_phase(P, bid, nblk); break;
      case 4: gemm_phase<EPI_RES>(A, 1024, WT + W_GLAWO, 1024, NTOK / 256, 8, ea, smem, bid, nblk); break;
    }
    return;
  }
  switch (sub) {
    case 0: normmod_phase(P, li, 0, NTOK, xl, xc, bid, nblk); break;
    case 1: {
      EpiArgs e1{};
      e1.o0 = (u16*)(BIG + B_CD);
      gemm_phase<EPI_MLADN>(A, 1024, WT + W_MLADN, 1024, NTOK / 256, MLA_DNP / 128, e1, smem, bid, nblk);
    } break;
    case 2: mla_prep_phase(P, bid, nblk); break;
    case 3: {
      EpiArgs e1{};
      e1.o0 = (u16*)(BIG + B_Q);
      gemm_phase<EPI_MLAQ>((const u16*)(P.ws + OFF_A + A_CQN), 384, WT + W_MLAUQ, 384, NL / 256, 12, e1, smem, bid, nblk);
      EpiArgs e2{};
      e2.o0 = (u16*)(BIG + B_KN); e2.o1 = (u16*)(BIG + B_VT);
      gemm_phase<EPI_MLAKV>((const u16*)(P.ws + OFF_A + A_CKVN), 256, WT + W_MLAUKV, 256, NTOK / 256, 16, e2, smem, bid, nblk);
    } break;
    case 4: mla_attn_phase(P, smem, bid, nblk); break;
    case 5: gemm_phase<EPI_RES>(A, 1024, WT + W_MLAWO, 1024, NL / 256, 8, ea, smem, bid, nblk); break;
  }
}

__global__ void __launch_bounds__(NT) mega(Params P) {
  extern __shared__ __attribute__((aligned(16))) unsigned char smem[];
  const int bid = blockIdx.x, nblk = gridDim.x;
  for (int ph = P.ph_lo; ph < P.ph_hi; ++ph) {
    run_phase(P, ph, smem, bid, nblk);
    if (ph + 1 < P.ph_hi) { cg::this_grid().sync(); }
  }
}

extern "C" void kernel_launch(void* const* d_in, const int* in_sizes, int n_in, void* d_out, int out_size, void* d_ws, size_t ws_size,
                              hipStream_t stream) {
  static int grid = 0;
  if (grid == 0) {
    if (n_in != 37 || ws_size < WS_NEED) { fprintf(stderr, "kernel_launch: bad n_in %d / ws %zu\n", n_in, ws_size); grid = -1; return; }
    int dev = 0, cus = 0, per_cu = 0;
    hipGetDevice(&dev);
    hipDeviceGetAttribute(&cus, hipDeviceAttributeMultiprocessorCount, dev);
    if (hipFuncSetAttribute((const void*)mega, hipFuncAttributeMaxDynamicSharedMemorySize, LDS_BYTES) != hipSuccess) { fprintf(stderr, "hipFuncSetAttribute failed\n"); grid = -1; return; }
    hipOccupancyMaxActiveBlocksPerMultiprocessor(&per_cu, (const void*)mega, NT, LDS_BYTES);
    (void)hipGetLastError();
    if (per_cu < 1) per_cu = 1;
    grid = cus * per_cu;
  }
  if (grid < 0) return;
  Params p{};
  const float** fp = (const float**)&p;
  for (int i = 0; i < 37; ++i) fp[i] = (const float*)d_in[i];
  p.out = (float*)d_out;
  p.ws = (unsigned char*)d_ws;
  {
    int m = 0, tot = 0;
    auto add = [&](const float* src, size_t dst, int K, int N, int Np) {
      p.mats[m].src = src; p.mats[m].dst = dst; p.mats[m].K = K; p.mats[m].N = N; p.mats[m].Np = Np;
      p.mats[m].tiles = (K / 64) * (Np / 64); tot += p.mats[m].tiles; ++m;
    };
    for (int i = 0; i < 4; ++i) {
      add(p.mlp_w1 + (size_t)i * 1024 * 4096, W_MLP1(i), 1024, 4096, 4096);
      add(p.mlp_w2 + (size_t)i * 4096 * 1024, W_MLP2(i), 4096, 1024, 1024);
    }
    for (int j = 0; j < 2; ++j) {
      add(p.hy_w_in + (size_t)j * 1024 * 3072, W_HYIN(j), 1024, 3072, 3072);
      add(p.hy_w_out + (size_t)j * 1024 * 1024, W_HYOUT(j), 1024, 1024, 1024);
      add(p.hy_f_w4 + (size_t)j * 64 * 4096, W_HYF4(j), 64, 4096, 4096);
    }
    add(p.gla_w_in, W_GLAIN, 1024, GLA_N, GLA_NP);
    add(p.gla_wo, W_GLAWO, 1024, 1024, 1024);
    add(p.mla_w_down, W_MLADN, 1024, MLA_DN, MLA_DNP);
    add(p.mla_w_uq, W_MLAUQ, 384, 1536, 1536);
    add(p.mla_w_ukv, W_MLAUKV, 256, 2048, 2048);
    add(p.mla_wo, W_MLAWO, 1024, 1024, 1024);
    for (; m < NMAT; ++m) { p.mats[m].tiles = 0; }
    p.total_mat_tiles = tot;
  }
#if MULTI
  for (int ph = 0; ph < NPHASE; ++ph) {
    p.ph_lo = ph; p.ph_hi = ph + 1;
    hipLaunchKernelGGL(mega, dim3(grid), dim3(NT), LDS_BYTES, stream, p);
  }
#else
  p.ph_lo = 0; p.ph_hi = NPHASE;
  void* args[] = {&p};
  hipError_t e = hipLaunchCooperativeKernel((const void*)mega, dim3(grid), dim3(NT), args, LDS_BYTES, stream);
  if (e != hipSuccess) fprintf(stderr, "cooperative launch failed: %s (grid %d)\n", hipGetErrorString(e), grid);
#endif
}
```

```cpp
#include <hip/hip_runtime.h>
#include <hip/hip_cooperative_groups.h>
#include <cstdio>
#include <cstdint>
namespace cg = cooperative_groups;

#ifndef MULTI
#define MULTI 0
#endif
#ifndef CHECKS
#define CHECKS 0
#endif

typedef unsigned short u16;
using bf16x8 = __attribute__((ext_vector_type(8))) short;
using u16x4  = __attribute__((ext_vector_type(4))) unsigned short;
using u16x8  = __attribute__((ext_vector_type(8))) unsigned short;
using f32x16 = __attribute__((ext_vector_type(16))) float;
#define DI __device__ __forceinline__
#define MFMA32(a, b, c) __builtin_amdgcn_mfma_f32_32x32x16_bf16((a), (b), (c), 0, 0, 0)

constexpr int DM = 1024, NB = 4, SEQ = 8192, NCTX = 256;
constexpr int NL = NB * SEQ;
constexpr int NTOK = NL + NB * NCTX;
constexpr int HID = 4096;
constexpr int NT = 512;
constexpr int GLA_N = 3104, GLA_NP = 3200;
constexpr int MLA_DN = 704, MLA_DNP = 768;
constexpr int KTL = SEQ + NCTX;
constexpr int NKEY = SEQ + NCTX;
constexpr float EPS = 1e-6f;

constexpr size_t MiB = 1048576;
constexpr size_t OFF_MOD = 0;
constexpr size_t OFF_ERR = 512 * 1024;
constexpr size_t OFF_XC  = 1 * MiB;
constexpr size_t OFF_H3  = 5 * MiB;
constexpr size_t OFF_WT  = 8 * MiB;
constexpr size_t OFF_A   = 104 * MiB;
constexpr size_t OFF_BIG = 170 * MiB;
constexpr size_t WS_NEED = 500 * MiB;
constexpr size_t W_MLP1(int i) { return (size_t)i * 8388608; }
constexpr size_t W_MLP2(int i) { return (size_t)i * 8388608 + 4194304; }
constexpr size_t W_HY0 = 33554432;
constexpr size_t W_HYIN(int j)  { return W_HY0 + (size_t)j * 4456448; }
constexpr size_t W_HYOUT(int j) { return W_HYIN(j) + 3145728; }
constexpr size_t W_HYF4(int j)  { return W_HYOUT(j) + 1048576; }
constexpr size_t W_GLAIN = W_HY0 + 2 * 4456448;
constexpr size_t W_GLAWO = W_GLAIN + (size_t)GLA_NP * 1024;
constexpr size_t W_MLADN = W_GLAWO + 1048576;
constexpr size_t W_MLAUQ = W_MLADN + (size_t)MLA_DNP * 1024;
constexpr size_t W_MLAUKV = W_MLAUQ + 1536 * 384;
constexpr size_t W_MLAWO = W_MLAUKV + 2048 * 256;
constexpr size_t W_END = W_MLAWO + 1048576;
static_assert(W_END * 2 <= 96 * MiB, "wt");
constexpr size_t B_ZT = 0;
constexpr size_t B_YT = (size_t)3072 * NTOK * 2;
constexpr size_t B_KT = B_YT + (size_t)1024 * NTOK * 2;
constexpr size_t B_HID = 0;
constexpr size_t B_GZ = 0;
constexpr size_t B_GOB = (size_t)NTOK * GLA_N * 2;
constexpr size_t B_Q = 0;
constexpr size_t B_KN = (size_t)NL * 1536 * 2;
constexpr size_t B_VT = B_KN + (size_t)NTOK * 1024 * 2;
constexpr size_t B_KR = B_VT + (size_t)NTOK * 1024 * 2;
constexpr size_t B_CD = B_KR + (size_t)NTOK * 64 * 2;
static_assert(B_KT + (size_t)4096 * KTL * 2 <= 330 * MiB, "big");
static_assert(B_CD + (size_t)NTOK * 768 * 2 <= 330 * MiB, "big2");
static_assert(B_GOB + (size_t)NTOK * 1024 * 2 <= 330 * MiB, "big3");
constexpr size_t A_CQN = 0;
constexpr size_t A_CKVN = (size_t)NL * 384 * 2;

constexpr int LDS_BYTES = 136 * 1024;

struct MatDesc { const float* src; unsigned long long dst; int K, N, Np, tiles; };
constexpr int NMAT = 22;

struct Params {
  const float *x, *c, *ctx, *c_ctx, *ada_w, *ada_b, *norm1_g, *norm2_g, *mlp_w1, *mlp_w2, *final_g;
  const float *hy_w_in, *hy_b_in, *hy_conv_w, *hy_conv_b, *hy_f_w1, *hy_f_b1, *hy_f_w2, *hy_f_b2, *hy_f_w3, *hy_f_b3, *hy_f_w4,
      *hy_freq, *hy_bias, *hy_w_out, *hy_b_out;
  const float *gla_w_in, *gla_gk_w2, *gla_gk_b, *gla_onorm, *gla_wo;
  const float *mla_w_down, *mla_qnorm, *mla_w_uq, *mla_kvnorm, *mla_w_ukv, *mla_wo;
  float* out;
  unsigned char* ws;
  MatDesc mats[NMAT];
  int total_mat_tiles;
  int ph_lo, ph_hi;
  int pad0;
};

DI u16 f2bf(float x) { unsigned u = __float_as_uint(x); u += 0x7fffu + ((u >> 16) & 1u); return (u16)(u >> 16); }
DI float bf2f(u16 v) { return __uint_as_float(((unsigned)v) << 16); }
DI float shx(float v, int mask, int lane) { return __int_as_float(__builtin_amdgcn_ds_bpermute((lane ^ mask) << 2, __float_as_int(v))); }
DI float wave_sum(float v, int lane) {
#pragma unroll
  for (int o = 32; o > 0; o >>= 1) v += shx(v, o, lane);
  return v;
}
DI int ltid() { int t = threadIdx.x; asm volatile("" : "+v"(t)); return t; }
DI int crow(int reg, int h) { return (reg & 3) + 8 * (reg >> 2) + 4 * h; }
DI float silu(float x) { return x / (1.f + __expf(-x)); }
DI int mod_index(int row) { return row < NL ? (row >> 13) : 4; }

DI void pro_weights(const Params& P, unsigned char* smem, int bid, int nblk) {
  float* t = (float*)smem;
  const int tid = ltid();
  for (int tile = bid; tile < P.total_mat_tiles; tile += nblk) {
    int mi = 0, rem = tile;
    while (rem >= P.mats[mi].tiles) { rem -= P.mats[mi].tiles; ++mi; }
    const MatDesc md = P.mats[mi];
    const int ntn = md.Np / 64;
    const int k0 = (rem / ntn) * 64, n0 = (rem % ntn) * 64;
    u16* dst = (u16*)(P.ws + OFF_WT) + md.dst;
#pragma unroll
    for (int pass = 0; pass < 2; ++pass) {
      const int kr = (tid >> 4) + pass * 32, nc = (tid & 15) * 4;
      float4 v = make_float4(0.f, 0.f, 0.f, 0.f);
      if (n0 + nc < md.N) v = *(const float4*)(md.src + (size_t)(k0 + kr) * md.N + n0 + nc);
      t[kr * 65 + nc + 0] = v.x; t[kr * 65 + nc + 1] = v.y; t[kr * 65 + nc + 2] = v.z; t[kr * 65 + nc + 3] = v.w;
    }
    __syncthreads();
    {
      const int n = tid >> 3, kc = (tid & 7) * 8;
      u16x8 o;
#pragma unroll
      for (int j = 0; j < 8; ++j) o[j] = f2bf(t[(kc + j) * 65 + n]);
      *(u16x8*)(dst + (size_t)(n0 + n) * md.K + k0 + kc) = o;
    }
    __syncthreads();
  }
}

DI void pro_adaln(const Params& P, unsigned char* smem, int bid, int nblk) {
  float* sc = (float*)smem;
  float* red = sc + 5 * 1024;
  float* modw = (float*)(P.ws + OFF_MOD);
  const int tid = ltid();
  for (int u = bid; u < 4 * 48; u += nblk) {
    const int li = u / 48, n0 = (u % 48) * 128;
    for (int e = tid; e < 5 * 1024; e += NT) {
      const int mi = e >> 10, k = e & 1023;
      const float v = mi < 4 ? P.c[mi * 1024 + k] : P.c_ctx[k];
      sc[e] = silu(v);
    }
    __syncthreads();
    const int nq = tid & 31, kg = tid >> 5;
    float acc[5][4];
#pragma unroll
    for (int a = 0; a < 5; ++a)
#pragma unroll
      for (int b = 0; b < 4; ++b) acc[a][b] = 0.f;
    const float* w = P.ada_w + (size_t)li * 1024 * 6144 + n0 + nq * 4;
    for (int kk = 0; kk < 64; ++kk) {
      const int k = kg * 64 + kk;
      const float4 wv = *(const float4*)(w + (size_t)k * 6144);
#pragma unroll
      for (int a = 0; a < 5; ++a) {
        const float s = sc[a * 1024 + k];
        acc[a][0] += s * wv.x; acc[a][1] += s * wv.y; acc[a][2] += s * wv.z; acc[a][3] += s * wv.w;
      }
    }
#pragma unroll
    for (int a = 0; a < 5; ++a)
#pragma unroll
      for (int b = 0; b < 4; ++b) red[(kg * 5 + a) * 128 + nq * 4 + b] = acc[a][b];
    __syncthreads();
    for (int e = tid; e < 5 * 128; e += NT) {
      const int a = e >> 7, n = e & 127;
      float s = P.ada_b[li * 6144 + n0 + n];
#pragma unroll
      for (int g = 0; g < 16; ++g) s += red[(g * 5 + a) * 128 + n];
      modw[(size_t)(li * 5 + a) * 6144 + n0 + n] = s;
    }
    __syncthreads();
  }
}

DI void pro_filter_mlp(const Params& P, int bid, int nblk) {
  const int lane = ltid() & 63, wv = ltid() >> 6;
  u16* h3 = (u16*)(P.ws + OFF_H3);
  for (int task = bid * 8 + wv; task < 2 * KTL; task += nblk * 8) {
    const int j = task / KTL, row = task % KTL;
    const int L = row < SEQ ? SEQ : NCTX;
    const int l = row < SEQ ? row : row - SEQ;
    const float* w1 = P.hy_f_w1 + j * 33 * 64; const float* b1 = P.hy_f_b1 + j * 64;
    const float* w2 = P.hy_f_w2 + j * 64 * 64; const float* b2 = P.hy_f_b2 + j * 64;
    const float* w3 = P.hy_f_w3 + j * 64 * 64; const float* b3 = P.hy_f_b3 + j * 64;
    const float fr = P.hy_freq[j * 64 + lane];
    const float tl = (float)l / (float)(L - 1);
    const float w = 6.283185307179586f * (float)l / (float)L;
    float zf = 0.f;
    if (lane == 0) zf = tl;
    else if (lane <= 32) {
      const int bi = (lane - 1) & 15;
      const float f = 1e-4f + (float)bi * ((15.f - 1e-4f) / 15.f);
      const float a = f * w;
      zf = lane <= 16 ? cosf(a) : -sinf(a);
    }
    float acc = b1[lane];
#pragma unroll
    for (int k = 0; k < 33; ++k) acc += __int_as_float(__builtin_amdgcn_readlane(__float_as_int(zf), k)) * w1[k * 64 + lane];
    float h = sinf(fr * acc);
    acc = b2[lane];
#pragma unroll
    for (int k = 0; k < 64; ++k) acc += __int_as_float(__builtin_amdgcn_readlane(__float_as_int(h), k)) * w2[k * 64 + lane];
    h = sinf(fr * acc);
    acc = b3[lane];
#pragma unroll
    for (int k = 0; k < 64; ++k) acc += __int_as_float(__builtin_amdgcn_readlane(__float_as_int(h), k)) * w3[k * 64 + lane];
    h = sinf(fr * acc);
    h3[((size_t)j * KTL + row) * 64 + lane] = f2bf(h);
  }
}

DI void normmod_phase(const Params& P, int li, int which, int nrows, const float* xl, const float* xc, int bid, int nblk) {
  const int lane = ltid() & 63, wv = ltid() >> 6;
  u16* A = (u16*)(P.ws + OFF_A);
  const float* g = (which ? P.norm2_g : P.norm1_g) + li * 1024;
  const float* modw = (const float*)(P.ws + OFF_MOD) + (size_t)li * 5 * 6144;
  for (int row = bid * 8 + wv; row < nrows; row += nblk * 8) {
    const float* xr = row < NL ? xl + (size_t)row * 1024 : xc + (size_t)(row - NL) * 1024;
    const float* md = modw + mod_index(row) * 6144 + (which ? 3 * 1024 : 0);
    float4 v[4];
    float ss = 0.f;
#pragma unroll
    for (int j = 0; j < 4; ++j) {
      v[j] = *(const float4*)(xr + j * 256 + lane * 4);
      ss += v[j].x * v[j].x + v[j].y * v[j].y + v[j].z * v[j].z + v[j].w * v[j].w;
    }
    ss = wave_sum(ss, lane);
    const float rstd = rsqrtf(ss * (1.f / 1024.f) + EPS);
#pragma unroll
    for (int j = 0; j < 4; ++j) {
      const int k = j * 256 + lane * 4;
      const float4 gg = *(const float4*)(g + k);
      const float4 sh = *(const float4*)(md + k);
      const float4 sc = *(const float4*)(md + 1024 + k);
      u16x4 o;
      o[0] = f2bf(v[j].x * rstd * gg.x * (1.f + sc.x) + sh.x);
      o[1] = f2bf(v[j].y * rstd * gg.y * (1.f + sc.y) + sh.y);
      o[2] = f2bf(v[j].z * rstd * gg.z * (1.f + sc.z) + sh.z);
      o[3] = f2bf(v[j].w * rstd * gg.w * (1.f + sc.w) + sh.w);
      *(u16x4*)(A + (size_t)row * 1024 + k) = o;
    }
  }
}

DI void final_norm_phase(const Params& P, int bid, int nblk) {
  const int lane = ltid() & 63, wv = ltid() >> 6;
  for (int row = bid * 8 + wv; row < NL; row += nblk * 8) {
    float* xr = P.out + (size_t)row * 1024;
    float4 v[4];
    float ss = 0.f;
#pragma unroll
    for (int j = 0; j < 4; ++j) {
      v[j] = *(const float4*)(xr + j * 256 + lane * 4);
      ss += v[j].x * v[j].x + v[j].y * v[j].y + v[j].z * v[j].z + v[j].w * v[j].w;
    }
    ss = wave_sum(ss, lane);
    const float rstd = rsqrtf(ss * (1.f / 1024.f) + EPS);
#pragma unroll
    for (int j = 0; j < 4; ++j) {
      const int k = j * 256 + lane * 4;
      const float4 gg = *(const float4*)(P.final_g + k);
      float4 o;
      o.x = v[j].x * rstd * gg.x; o.y = v[j].y * rstd * gg.y; o.z = v[j].z * rstd * gg.z; o.w = v[j].w * rstd * gg.w;
      *(float4*)(xr + k) = o;
    }
  }
}

enum { EPI_HYIN = 0, EPI_FILT, EPI_RES, EPI_MLP1, EPI_GLAIN, EPI_MLADN, EPI_MLAQ, EPI_MLAKV };
struct EpiArgs {
  const float* bias;
  const float* gate;
  int gofs;
  const float* xsl; const float* xsc;
  float* xdl; float* xdc;
  u16* o0; u16* o1;
  int mrow0;
  int L;
};

constexpr int GS = 72;

template <int EPI>
DI void epi_tile(const EpiArgs& ea, const f32x16& acc, int mb, int nb, int lane) {
  const int r = lane & 31, h = lane >> 5;
  if constexpr (EPI == EPI_HYIN) {
    const int m = mb + r;
#pragma unroll
    for (int i = 0; i < 16; ++i) {
      const int n = nb + crow(i, h);
      ea.o0[(size_t)n * NTOK + m] = f2bf(acc[i] + ea.bias[n]);
    }
  } else if constexpr (EPI == EPI_FILT) {
    const int l = mb + r;
    const float t = (float)l / (float)(ea.L - 1);
#pragma unroll
    for (int i = 0; i < 16; ++i) {
      const int n = nb + crow(i, h);
      const int d = n & 1023;
      const float mind = -3.0701134573253945f, maxd = -15.350567286626972f;
      const float delta = mind + (float)d * ((maxd - mind) / 1023.f);
      ea.o0[(size_t)n * KTL + ea.mrow0 + l] = f2bf(acc[i] * __expf(-t * fabsf(delta)));
    }
  } else if constexpr (EPI == EPI_RES) {
    const int n = nb + r;
    const float bz = ea.bias ? ea.bias[n] : 0.f;
#pragma unroll
    for (int i = 0; i < 16; ++i) {
      const int m = mb + crow(i, h);
      const float gt = ea.gate[mod_index(m) * 6144 + ea.gofs + n];
      if (m < NL) { const size_t o = (size_t)m * 1024 + n; ea.xdl[o] = ea.xsl[o] + gt * (acc[i] + bz); }
      else { const size_t o = (size_t)(m - NL) * 1024 + n; ea.xdc[o] = ea.xsc[o] + gt * (acc[i] + bz); }
    }
  } else if constexpr (EPI == EPI_MLP1) {
    const int n = nb + r;
#pragma unroll
    for (int i = 0; i < 16; ++i) {
      const int m = mb + crow(i, h);
      const float v = fmaxf(acc[i], 0.f);
      ea.o0[(size_t)m * HID + n] = f2bf(v * v);
    }
  } else if constexpr (EPI == EPI_GLAIN) {
    const int n = nb + r;
    if (n < GLA_N) {
#pragma unroll
      for (int i = 0; i < 16; ++i) {
        const int m = mb + crow(i, h);
        ea.o0[(size_t)m * GLA_N + n] = f2bf(acc[i]);
      }
    }
  } else if constexpr (EPI == EPI_MLADN) {
    const int n = nb + r;
#pragma unroll
    for (int i = 0; i < 16; ++i) {
      const int m = mb + crow(i, h);
      ea.o0[(size_t)m * MLA_DNP + n] = f2bf(acc[i]);
    }
  } else if constexpr (EPI == EPI_MLAQ) {
    const int n = nb + r;
    const int hd = n / 192, c = n % 192;
    const float qs = 0.07216878364870322f * 1.4426950408889634f;
    const bool isr = c >= 128;
    const int cc = c - 128;
    const int jj = cc & 15;
    const bool first = (cc & 31) < 16;
    const float invf = __expf(-(float)jj * (9.210340371976184f / 16.f));
#pragma unroll
    for (int i = 0; i < 16; ++i) {
      const int m = mb + crow(i, h);
      const int b = m >> 13, l = m & 8191;
      float v = acc[i];
      const float pv = shx(v, 16, lane);
      if (isr) {
        const float pos = (float)((cc < 32) ? (l >> 6) : (l & 63));
        const float ang = pos * invf;
        float sn, cs;
        __sincosf(ang, &sn, &cs);
        v = first ? (v * cs - pv * sn) : (pv * sn + v * cs);
      }
      ea.o0[((size_t)(b * 8 + hd) * SEQ + l) * 192 + c] = f2bf(v * qs);
    }
  } else if constexpr (EPI == EPI_MLAKV) {
    const int n = nb + r;
    const int hd = n >> 8, c = n & 255;
#pragma unroll
    for (int g = 0; g < 4; ++g) {
      const int m = mb + 8 * g + 4 * h;
      int b, key;
      if (m < NL) { b = m >> 13; key = NCTX + (m & 8191); } else { b = (m - NL) >> 8; key = (m - NL) & 255; }
      if (c < 128) {
#pragma unroll
        for (int q = 0; q < 4; ++q) ea.o0[((size_t)(b * 8 + hd) * NKEY + key + q) * 128 + c] = f2bf(acc[4 * g + q]);
      } else {
        u16x4 o;
#pragma unroll
        for (int q = 0; q < 4; ++q) o[q] = f2bf(acc[4 * g + q]);
        *(u16x4*)(ea.o1 + ((size_t)(b * 8 + hd) * 128 + (c - 128)) * NKEY + key) = o;
      }
    }
  }
}

template <int EPI>
DI void gemm_phase(const u16* __restrict__ A, int lda, const u16* __restrict__ WT, int K, int mtiles, int ntiles,
                           const EpiArgs& ea, unsigned char* smem, int bid, int nblk) {
  constexpr bool SWAP = (EPI == EPI_HYIN || EPI == EPI_FILT);
  u16* As = (u16*)smem;
  u16* Bs = As + 2 * 256 * GS;
  const int tid = ltid(), lane = tid & 63, wv = tid >> 6;
  const int wm = wv & 3, wn = wv >> 2;
  const int r = lane & 31, h = lane >> 5;
  const int nk = K / 64;
  for (int tile = bid; tile < mtiles * ntiles; tile += nblk) {
    const int mt = tile / ntiles, nt = tile % ntiles;
    const int m0 = mt * 256, n0 = nt * 128;
    const u16* Ag = A + (size_t)m0 * lda;
    const u16* Bg = WT + (size_t)n0 * K;
    f32x16 acc00, acc01, acc10, acc11;
#pragma unroll
    for (int q = 0; q < 16; ++q) { acc00[q] = 0.f; acc01[q] = 0.f; acc10[q] = 0.f; acc11[q] = 0.f; }
    uint4 ra0, ra1, ra2, ra3, rb0, rb1;
#define G_LD(k0_)                                                                        \
    ra0 = *(const uint4*)(Ag + (size_t)((tid) >> 3) * lda + (k0_) + (tid & 7) * 8);          \
    ra1 = *(const uint4*)(Ag + (size_t)((tid + NT) >> 3) * lda + (k0_) + (tid & 7) * 8);     \
    ra2 = *(const uint4*)(Ag + (size_t)((tid + 2 * NT) >> 3) * lda + (k0_) + (tid & 7) * 8); \
    ra3 = *(const uint4*)(Ag + (size_t)((tid + 3 * NT) >> 3) * lda + (k0_) + (tid & 7) * 8); \
    rb0 = *(const uint4*)(Bg + (size_t)((tid) >> 3) * K + (k0_) + (tid & 7) * 8);            \
    rb1 = *(const uint4*)(Bg + (size_t)((tid + NT) >> 3) * K + (k0_) + (tid & 7) * 8);
#define G_ST(buf_)                                                                        \
    *(uint4*)(As + (buf_) * 256 * GS + ((tid) >> 3) * GS + (tid & 7) * 8) = ra0;              \
    *(uint4*)(As + (buf_) * 256 * GS + ((tid + NT) >> 3) * GS + (tid & 7) * 8) = ra1;         \
    *(uint4*)(As + (buf_) * 256 * GS + ((tid + 2 * NT) >> 3) * GS + (tid & 7) * 8) = ra2;     \
    *(uint4*)(As + (buf_) * 256 * GS + ((tid + 3 * NT) >> 3) * GS + (tid & 7) * 8) = ra3;     \
    *(uint4*)(Bs + (buf_) * 128 * GS + ((tid) >> 3) * GS + (tid & 7) * 8) = rb0;              \
    *(uint4*)(Bs + (buf_) * 128 * GS + ((tid + NT) >> 3) * GS + (tid & 7) * 8) = rb1;
    G_LD(0)
    __syncthreads();
    G_ST(0)
    __syncthreads();
    for (int kt = 0; kt < nk; ++kt) {
      const int cur = kt & 1;
      if (kt + 1 < nk) { G_LD((kt + 1) * 64) }
      const u16* as = As + cur * 256 * GS + (wm * 64 + r) * GS + h * 8;
      const u16* bs = Bs + cur * 128 * GS + (wn * 64 + r) * GS + h * 8;
#pragma unroll
      for (int kk = 0; kk < 4; ++kk) {
        const bf16x8 a0 = *(const bf16x8*)(as + kk * 16);
        const bf16x8 a1 = *(const bf16x8*)(as + 32 * GS + kk * 16);
        const bf16x8 b0 = *(const bf16x8*)(bs + kk * 16);
        const bf16x8 b1 = *(const bf16x8*)(bs + 32 * GS + kk * 16);
        if constexpr (SWAP) {
          acc00 = MFMA32(b0, a0, acc00); acc01 = MFMA32(b1, a0, acc01);
          acc10 = MFMA32(b0, a1, acc10); acc11 = MFMA32(b1, a1, acc11);
        } else {
          acc00 = MFMA32(a0, b0, acc00); acc01 = MFMA32(a0, b1, acc01);
          acc10 = MFMA32(a1, b0, acc10); acc11 = MFMA32(a1, b1, acc11);
        }
      }
      if (kt + 1 < nk) { G_ST(cur ^ 1) }
      __syncthreads();
    }
    epi_tile<EPI>(ea, acc00, m0 + wm * 64, n0 + wn * 64, lane);
    epi_tile<EPI>(ea, acc01, m0 + wm * 64, n0 + wn * 64 + 32, lane);
    epi_tile<EPI>(ea, acc10, m0 + wm * 64 + 32, n0 + wn * 64, lane);
    epi_tile<EPI>(ea, acc11, m0 + wm * 64 + 32, n0 + wn * 64 + 32, lane);
  }
}

DI float2 cmul(float2 a, float2 b) { return make_float2(a.x * b.x - a.y * b.y, a.x * b.y + a.y * b.x); }
DI float2 cmulc(float2 a, float2 b) { return make_float2(a.x * b.x + a.y * b.y, a.y * b.x - a.x * b.y); }
DI float2 twid(float rev) { return make_float2(__builtin_amdgcn_cosf(rev), __builtin_amdgcn_sinf(rev)); }

#define FWD_BFLY(a0, a1, a2, a3, y0, y1, y2, y3)                                  \
  {                                                                               \
    const float2 t0 = make_float2(a0.x + a2.x, a0.y + a2.y);                      \
    const float2 t1 = make_float2(a0.x - a2.x, a0.y - a2.y);                      \
    const float2 t2 = make_float2(a1.x + a3.x, a1.y + a3.y);                      \
    const float2 t3 = make_float2(a1.y - a3.y, -(a1.x - a3.x));                   \
    y0 = make_float2(t0.x + t2.x, t0.y + t2.y);                                   \
    y1 = make_float2(t1.x + t3.x, t1.y + t3.y);                                   \
    y2 = make_float2(t0.x - t2.x, t0.y - t2.y);                                   \
    y3 = make_float2(t1.x - t3.x, t1.y - t3.y);                                   \
  }
#define INV_BFLY(b0, b1, b2, b3, y0, y1, y2, y3)                                  \
  {                                                                               \
    const float2 t0 = make_float2(b0.x + b2.x, b0.y + b2.y);                      \
    const float2 t1 = make_float2(b0.x - b2.x, b0.y - b2.y);                      \
    const float2 t2 = make_float2(b1.x + b3.x, b1.y + b3.y);                      \
    const float2 t3 = make_float2(-(b1.y - b3.y), b1.x - b3.x);                   \
    y0 = make_float2(t0.x + t2.x, t0.y + t2.y);                                   \
    y1 = make_float2(t1.x + t3.x, t1.y + t3.y);                                   \
    y2 = make_float2(t0.x - t2.x, t0.y - t2.y);                                   \
    y3 = make_float2(t1.x - t3.x, t1.y - t3.y);                                   \
  }

template <int Q>
DI void dif_stage(float2* buf, int tid) {
#pragma unroll 2
  for (int j = tid; j < 4096; j += NT) {
    const int p = j & (Q - 1);
    const int base = ((j - p) << 2) + p;
    const float2 a0 = buf[base], a1 = buf[base + Q], a2 = buf[base + 2 * Q], a3 = buf[base + 3 * Q];
    float2 y0, y1, y2, y3;
    FWD_BFLY(a0, a1, a2, a3, y0, y1, y2, y3);
    const float2 w1 = twid(-(float)p * (1.f / (4.f * Q)));
    const float2 w2 = cmul(w1, w1), w3 = cmul(w2, w1);
    buf[base] = y0; buf[base + Q] = cmul(y1, w1); buf[base + 2 * Q] = cmul(y2, w2); buf[base + 3 * Q] = cmul(y3, w3);
  }
  __syncthreads();
}
template <int Q>
DI void dit_stage(float2* buf, int tid) {
#pragma unroll 2
  for (int j = tid; j < 4096; j += NT) {
    const int p = j & (Q - 1);
    const int base = ((j - p) << 2) + p;
    const float2 w1 = twid(-(float)p * (1.f / (4.f * Q)));
    const float2 w2 = cmul(w1, w1), w3 = cmul(w2, w1);
    const float2 b0 = buf[base], b1 = cmulc(buf[base + Q], w1), b2 = cmulc(buf[base + 2 * Q], w2), b3 = cmulc(buf[base + 3 * Q], w3);
    float2 y0, y1, y2, y3;
    INV_BFLY(b0, b1, b2, b3, y0, y1, y2, y3);
    buf[base] = y0; buf[base + Q] = y1; buf[base + 2 * Q] = y2; buf[base + 3 * Q] = y3;
  }
  __syncthreads();
}
DI void fft_fwd_upto4(float2* buf, int tid) {
  dif_stage<4096>(buf, tid); dif_stage<1024>(buf, tid); dif_stage<256>(buf, tid);
  dif_stage<64>(buf, tid); dif_stage<16>(buf, tid); dif_stage<4>(buf, tid);
}
DI void fft_inv_from4_to1024(float2* buf, int tid) {
  dit_stage<4>(buf, tid); dit_stage<16>(buf, tid); dit_stage<64>(buf, tid);
  dit_stage<256>(buf, tid); dit_stage<1024>(buf, tid);
}
DI float sconv(const u16* z, int t, int L, float w0, float w1, float w2, float cb) {
  const float c = bf2f(z[t]);
  const float a = t > 0 ? bf2f(z[t - 1]) : 0.f;
  const float b = t < L - 1 ? bf2f(z[t + 1]) : 0.f;
  return w0 * a + w1 * c + w2 * b + cb;
}
DI float block_sum(float v, float* red, int tid) {
  v = wave_sum(v, tid & 63);
  __syncthreads();
  if ((tid & 63) == 0) red[tid >> 6] = v;
  __syncthreads();
  float s = 0.f;
#pragma unroll
  for (int i = 0; i < 8; ++i) s += red[i];
  return s;
}

DI void fft_middle(float2* buf, const float2* Kg, int tid) {
#pragma unroll 2
  for (int j = tid; j < 4096; j += NT) {
    float4* p4 = (float4*)(buf + 4 * j);
    const float4* k4 = (const float4*)(Kg + 4 * j);
    const float4 u0 = p4[0], u1 = p4[1];
    const float4 k0 = k4[0], k1 = k4[1];
    const float2 a0 = make_float2(u0.x, u0.y), a1 = make_float2(u0.z, u0.w), a2 = make_float2(u1.x, u1.y), a3 = make_float2(u1.z, u1.w);
    float2 y0, y1, y2, y3;
    FWD_BFLY(a0, a1, a2, a3, y0, y1, y2, y3);
    const float2 b0 = cmul(y0, make_float2(k0.x, k0.y)), b1 = cmul(y1, make_float2(k0.z, k0.w));
    const float2 b2 = cmul(y2, make_float2(k1.x, k1.y)), b3 = cmul(y3, make_float2(k1.z, k1.w));
    float2 z0, z1, z2, z3;
    INV_BFLY(b0, b1, b2, b3, z0, z1, z2, z3);
    p4[0] = make_float4(z0.x, z0.y, z1.x, z1.y);
    p4[1] = make_float4(z2.x, z2.y, z3.x, z3.y);
  }
  __syncthreads();
}
DI void fft_filter_last(const float2* buf, float2* Kg, int tid, float scl, float skp) {
#pragma unroll 2
  for (int j = tid; j < 4096; j += NT) {
    const float4* p4 = (const float4*)(buf + 4 * j);
    float4* k4 = (float4*)(Kg + 4 * j);
    const float4 u0 = p4[0], u1 = p4[1];
    const float2 a0 = make_float2(u0.x, u0.y), a1 = make_float2(u0.z, u0.w), a2 = make_float2(u1.x, u1.y), a3 = make_float2(u1.z, u1.w);
    float2 y0, y1, y2, y3;
    FWD_BFLY(a0, a1, a2, a3, y0, y1, y2, y3);
    k4[0] = make_float4(y0.x * scl + skp, y0.y * scl, y1.x * scl + skp, y1.y * scl);
    k4[1] = make_float4(y2.x * scl + skp, y2.y * scl, y3.x * scl + skp, y3.y * scl);
  }
}

DI void hyena_lat_unit(const Params& P, int jl, int d, unsigned char* smem) {
  float2* buf = (float2*)smem;
  float* red = (float*)(smem + 131072);
  const int tid = ltid();
  const u16* zT = (const u16*)(P.ws + OFF_BIG + B_ZT);
  const u16* kT = (const u16*)(P.ws + OFF_BIG + B_KT);
  u16* yT = (u16*)(P.ws + OFF_BIG + B_YT);
  float2* Kg = (float2*)(P.ws + OFF_A) + (size_t)blockIdx.x * 32768;
#pragma unroll 1
  for (int n = 0; n < 2; ++n) {
    const u16* kf = kT + (size_t)((n * 2 + 0) * 1024 + d) * KTL;
    const u16* kb = kT + (size_t)((n * 2 + 1) * 1024 + d) * KTL;
    float s = 0.f;
    for (int t = tid; t < SEQ; t += NT) {
      const float f = bf2f(kf[t]);
      buf[t] = make_float2(f, 0.f);
      s += fabsf(f);
      if (t >= 1) { const float g = bf2f(kb[t]); buf[16384 - t] = make_float2(g, 0.f); s += fabsf(g); }
    }
    if (tid == 0) buf[SEQ] = make_float2(0.f, 0.f);
    const float S = block_sum(s, red, tid);
    fft_fwd_upto4(buf, tid);
    const float scl = 1.f / (S * 16384.f);
    const float skp = P.hy_bias[(jl * 2 + n) * 1024 + d] * (1.f / 16384.f);
    fft_filter_last(buf, Kg + n * 16384, tid, scl, skp);
    __syncthreads();
  }
  const float* cw = P.hy_conv_w + (size_t)jl * 3 * 3072;
  const float* cbp = P.hy_conv_b + (size_t)jl * 3072;
  const float w00 = cw[d], w01 = cw[3072 + d], w02 = cw[2 * 3072 + d], cb0 = cbp[d];
  const float w10 = cw[1024 + d], w11 = cw[3072 + 1024 + d], w12 = cw[2 * 3072 + 1024 + d], cb1 = cbp[1024 + d];
  const float w20 = cw[2048 + d], w21 = cw[3072 + 2048 + d], w22 = cw[2 * 3072 + 2048 + d], cb2 = cbp[2048 + d];
  for (int pair = 0; pair < 2; ++pair) {
    const u16* za0 = zT + (size_t)d * NTOK + (size_t)(2 * pair) * SEQ;
    const u16* za1 = za0 + SEQ;
    const u16* zb0 = zT + (size_t)(1024 + d) * NTOK + (size_t)(2 * pair) * SEQ;
    const u16* zb1 = zb0 + SEQ;
    const u16* zc0 = zT + (size_t)(2048 + d) * NTOK + (size_t)(2 * pair) * SEQ;
    const u16* zc1 = zc0 + SEQ;
#pragma unroll 1
    for (int p = tid; p < 4096; p += NT) {
      const float2 a0 = make_float2(sconv(za0, p, SEQ, w00, w01, w02, cb0), sconv(za1, p, SEQ, w00, w01, w02, cb0));
      const float2 a1 = make_float2(sconv(za0, p + 4096, SEQ, w00, w01, w02, cb0), sconv(za1, p + 4096, SEQ, w00, w01, w02, cb0));
      const float2 zz = make_float2(0.f, 0.f);
      float2 y0, y1, y2, y3;
      FWD_BFLY(a0, a1, zz, zz, y0, y1, y2, y3);
      const float2 w1 = twid(-(float)p * (1.f / 16384.f));
      const float2 w2 = cmul(w1, w1), w3 = cmul(w2, w1);
      buf[p] = y0; buf[p + 4096] = cmul(y1, w1); buf[p + 8192] = cmul(y2, w2); buf[p + 12288] = cmul(y3, w3);
    }
    __syncthreads();
    dif_stage<1024>(buf, tid); dif_stage<256>(buf, tid); dif_stage<64>(buf, tid); dif_stage<16>(buf, tid); dif_stage<4>(buf, tid);
    fft_middle(buf, Kg, tid);
    fft_inv_from4_to1024(buf, tid);
#pragma unroll 1
    for (int p = tid; p < 4096; p += NT) {
      const float2 w1 = twid(-(float)p * (1.f / 16384.f));
      const float2 w2 = cmul(w1, w1), w3 = cmul(w2, w1);
      const float2 b0 = buf[p], b1 = cmulc(buf[p + 4096], w1), b2 = cmulc(buf[p + 8192], w2), b3 = cmulc(buf[p + 12288], w3);
      float2 y0, y1, y2, y3;
      INV_BFLY(b0, b1, b2, b3, y0, y1, y2, y3);
      const float g00 = sconv(zb0, p, SEQ, w10, w11, w12, cb1), g01 = sconv(zb1, p, SEQ, w10, w11, w12, cb1);
      const float g10 = sconv(zb0, p + 4096, SEQ, w10, w11, w12, cb1), g11 = sconv(zb1, p + 4096, SEQ, w10, w11, w12, cb1);
      buf[p] = make_float2(y0.x * g00, y0.y * g01);
      buf[p + 4096] = make_float2(y1.x * g10, y1.y * g11);
      buf[p + 8192] = make_float2(0.f, 0.f);
      buf[p + 12288] = make_float2(0.f, 0.f);
    }
    __syncthreads();
    fft_fwd_upto4(buf, tid);
    fft_middle(buf, Kg + 16384, tid);
    fft_inv_from4_to1024(buf, tid);
#pragma unroll 1
    for (int p = tid; p < 4096; p += NT) {
      const float2 w1 = twid(-(float)p * (1.f / 16384.f));
      const float2 w2 = cmul(w1, w1), w3 = cmul(w2, w1);
      const float2 b0 = buf[p], b1 = cmulc(buf[p + 4096], w1), b2 = cmulc(buf[p + 8192], w2), b3 = cmulc(buf[p + 12288], w3);
      float2 y0, y1, y2, y3;
      INV_BFLY(b0, b1, b2, b3, y0, y1, y2, y3);
      const float g00 = sconv(zc0, p, SEQ, w20, w21, w22, cb2), g01 = sconv(zc1, p, SEQ, w20, w21, w22, cb2);
      const float g10 = sconv(zc0, p + 4096, SEQ, w20, w21, w22, cb2), g11 = sconv(zc1, p + 4096, SEQ, w20, w21, w22, cb2);
      u16* yo = yT + (size_t)d * NTOK + (size_t)(2 * pair) * SEQ;
      yo[p] = f2bf(y0.x * g00); yo[SEQ + p] = f2bf(y0.y * g01);
      yo[p + 4096] = f2bf(y1.x * g10); yo[SEQ + p + 4096] = f2bf(y1.y * g11);
    }
    __syncthreads();
  }
}

DI void hyena_ctx_unit(const Params& P, int jl, int d, unsigned char* smem) {
  float* kk = (float*)smem;
  float* ya = kk + 1024;
  float* yb = ya + 1024;
  float* red = yb + 1024;
  const int tid = ltid();
  const u16* zT = (const u16*)(P.ws + OFF_BIG + B_ZT);
  const u16* kT = (const u16*)(P.ws + OFF_BIG + B_KT);
  u16* yT = (u16*)(P.ws + OFF_BIG + B_YT);
  const float* cw = P.hy_conv_w + (size_t)jl * 3 * 3072;
  const float* cbp = P.hy_conv_b + (size_t)jl * 3072;
#pragma unroll
  for (int n = 0; n < 2; ++n) {
    const u16* kf = kT + (size_t)((n * 2 + 0) * 1024 + d) * KTL + SEQ;
    const u16* kb = kT + (size_t)((n * 2 + 1) * 1024 + d) * KTL + SEQ;
    float s = 0.f, f = 0.f, g = 0.f;
    if (tid < 256) { f = bf2f(kf[tid]); s = fabsf(f); }
    else if (tid > 256) { g = bf2f(kb[tid - 256]); s = fabsf(g); }
    const float S = block_sum(s, red, tid);
    if (tid < 256) kk[n * 512 + 256 + tid] = f / S;
    else if (tid > 256) kk[n * 512 + 256 - (tid - 256)] = g / S;
    else kk[n * 512 + 0] = 0.f;
  }
  for (int e = tid; e < 1024; e += NT) {
    const int b = e >> 8, t = e & 255;
    const u16* z0 = zT + (size_t)d * NTOK + NL + b * 256;
    ya[e] = sconv(z0, t, NCTX, cw[d], cw[3072 + d], cw[2 * 3072 + d], cbp[d]);
  }
  __syncthreads();
#pragma unroll
  for (int n = 0; n < 2; ++n) {
    const float* src = n == 0 ? ya : yb;
    float* dst = n == 0 ? yb : ya;
    const int ch = (n + 1) * 1024 + d;
    const float skp = P.hy_bias[(jl * 2 + n) * 1024 + d];
    for (int e = tid; e < 1024; e += NT) {
      const int b = e >> 8, t = e & 255;
      float acc = 0.f;
      for (int s = 0; s < 256; ++s) acc += kk[n * 512 + 256 + t - s] * src[b * 256 + s];
      acc += skp * src[e];
      const u16* zg = zT + (size_t)ch * NTOK + NL + b * 256;
      const float gate = sconv(zg, t, NCTX, cw[ch], cw[3072 + ch], cw[2 * 3072 + ch], cbp[ch]);
      const float o = acc * gate;
      if (n == 0) dst[e] = o;
      else yT[(size_t)d * NTOK + NL + e] = f2bf(o);
    }
    __syncthreads();
  }
}

DI void hyena_conv_phase(const Params& P, int jl, bool with_ctx, unsigned char* smem, int bid, int nblk) {
  for (int u = bid; u < 1024; u += nblk) hyena_lat_unit(P, jl, u, smem);
  if (with_ctx) {
    __syncthreads();
    for (int u = bid; u < 1024; u += nblk) hyena_ctx_unit(P, jl, u, smem);
  }
}

DI void transpose_phase(const Params& P, int ncols, unsigned char* smem, int bid, int nblk) {
  u16* t = (u16*)smem;
  const u16* yT = (const u16*)(P.ws + OFF_BIG + B_YT);
  u16* A = (u16*)(P.ws + OFF_A);
  const int tid = ltid();
  const int tcols = ncols / 64;
  for (int tile = bid; tile < 16 * tcols; tile += nblk) {
    const int d0 = (tile / tcols) * 64, m0 = (tile % tcols) * 64;
    {
      const int rr = tid >> 3, ch = tid & 7;
      *(uint4*)(t + rr * 72 + ch * 8) = *(const uint4*)(yT + (size_t)(d0 + rr) * NTOK + m0 + ch * 8);
    }
    __syncthreads();
    {
      const int m = tid >> 3, dc = (tid & 7) * 8;
      u16x8 o;
#pragma unroll
      for (int j = 0; j < 8; ++j) o[j] = t[(dc + j) * 72 + m];
      *(u16x8*)(A + (size_t)(m0 + m) * 1024 + d0 + dc) = o;
    }
    __syncthreads();
  }
}

DI float logsigmoid(float x) { return fminf(x, 0.f) - __logf(1.f + __expf(-fabsf(x))); }

DI void gla_scan_phase(const Params& P, unsigned char* smem, int bid, int nblk) {
  u16* qs = (u16*)smem;
  u16* ks = qs + 64 * 136;
  u16* ket = ks + 64 * 136;
  u16* vt = ket + 128 * 72;
  u16* sb = vt + 32 * 72;
  u16* ps = sb + 32 * 136;
  float* gs = (float*)(ps + 64 * 72);
  float* w2s = gs + 64 * 129;
  float* gkb = w2s + 16 * 128;
  float* rs = gkb + 128;
  float* tots = rs + 64 * 16;
  const int tid = ltid(), lane = tid & 63, wv = tid >> 6;
  const int r = lane & 31, h = lane >> 5;
  const u16* Z = (const u16*)(P.ws + OFF_BIG + B_GZ);
  for (int u = bid; u < 256; u += nblk) {
    const int vs = u & 7, dir = (u >> 3) & 1, hd = (u >> 4) & 3, b = u >> 6;
    u16* O = dir == 0 ? (u16*)(P.ws + OFF_A) : (u16*)(P.ws + OFF_BIG + B_GOB);
    __syncthreads();
    for (int e = tid; e < 16 * 128; e += NT) w2s[e] = P.gla_gk_w2[(size_t)(dir * 16 + (e >> 7)) * 512 + hd * 128 + (e & 127)];
    if (tid < 128) gkb[tid] = P.gla_gk_b[dir * 512 + hd * 128 + tid];
    for (int e = tid; e < 32 * 136; e += NT) sb[e] = 0;
    f32x16 S;
#pragma unroll
    for (int i = 0; i < 16; ++i) S[i] = 0.f;
    for (int ci = 0; ci < 132; ++ci) {
      int row0;
      if (ci < 4) row0 = NL + b * 256 + (dir == 0 ? ci : 3 - ci) * 64;
      else row0 = b * SEQ + (dir == 0 ? ci - 4 : 131 - ci) * 64;
      const u16* Zr = Z + (size_t)row0 * GLA_N;
      __syncthreads();
#pragma unroll
      for (int i = 0; i < 2; ++i) {
        const int c = tid + i * NT, rr = c >> 4, cc = (c & 15) * 8;
        *(uint4*)(qs + rr * 136 + cc) = *(const uint4*)(Zr + (size_t)rr * GLA_N + hd * 128 + cc);
        *(uint4*)(ks + rr * 136 + cc) = *(const uint4*)(Zr + (size_t)rr * GLA_N + 512 + hd * 128 + cc);
      }
      if (tid < 256) {
        const int rr = tid >> 2, cc = (tid & 3) * 8;
        const u16x8 v = *(const u16x8*)(Zr + (size_t)rr * GLA_N + 1024 + hd * 256 + vs * 32 + cc);
#pragma unroll
        for (int j = 0; j < 8; ++j) vt[(cc + j) * 72 + rr] = v[j];
      } else if (tid < 384) {
        const int t2 = tid - 256, rr = t2 >> 1, cc = (t2 & 1) * 8;
        const u16x8 v = *(const u16x8*)(Zr + (size_t)rr * GLA_N + 3072 + dir * 16 + cc);
#pragma unroll
        for (int j = 0; j < 8; ++j) rs[rr * 16 + cc + j] = bf2f(v[j]);
      }
      __syncthreads();
#pragma unroll 4
      for (int m = 0; m < 16; ++m) {
        const int e = tid + m * NT, i = e >> 7, dk = e & 127;
        float a = gkb[dk];
#pragma unroll
        for (int q = 0; q < 16; ++q) a += rs[i * 16 + q] * w2s[q * 128 + dk];
        gs[i * 129 + dk] = logsigmoid(a) * (1.f / 16.f);
      }
      __syncthreads();
      if (tid < 128) {
        float run = 0.f;
        if (dir == 0) { for (int i = 0; i < 64; ++i) { run += gs[i * 129 + tid]; gs[i * 129 + tid] = run; } }
        else { for (int i = 63; i >= 0; --i) { run += gs[i * 129 + tid]; gs[i * 129 + tid] = run; } }
        tots[tid] = run;
      }
      __syncthreads();
#pragma unroll 4
      for (int m = 0; m < 16; ++m) {
        const int e = tid + m * NT, i = e >> 7, dk = e & 127;
        const float bb = gs[i * 129 + dk];
        const float qv = bf2f(qs[i * 136 + dk]), kv = bf2f(ks[i * 136 + dk]);
        qs[i * 136 + dk] = f2bf(qv * __expf(bb) * 0.08838834764831845f);
        ks[i * 136 + dk] = f2bf(kv * __expf(-bb));
        ket[dk * 72 + i] = f2bf(kv * __expf(tots[dk] - bb));
      }
      __syncthreads();
      f32x16 Sn;
      if (wv < 4) {
#pragma unroll
        for (int i = 0; i < 16; ++i) Sn[i] = S[i] * __expf(tots[wv * 32 + crow(i, h)]);
#pragma unroll
        for (int ss = 0; ss < 4; ++ss) {
          const bf16x8 a = *(const bf16x8*)(ket + (wv * 32 + r) * 72 + ss * 16 + h * 8);
          const bf16x8 bv = *(const bf16x8*)(vt + r * 72 + ss * 16 + h * 8);
          Sn = MFMA32(a, bv, Sn);
        }
      } else {
        const int w4 = wv - 4, ti = w4 & 1, tj = w4 >> 1;
        f32x16 at;
#pragma unroll
        for (int i = 0; i < 16; ++i) at[i] = 0.f;
#pragma unroll
        for (int kk = 0; kk < 8; ++kk) {
          const bf16x8 a = *(const bf16x8*)(qs + (ti * 32 + r) * 136 + kk * 16 + h * 8);
          const bf16x8 bv = *(const bf16x8*)(ks + (tj * 32 + r) * 136 + kk * 16 + h * 8);
          at = MFMA32(a, bv, at);
        }
#pragma unroll
        for (int i = 0; i < 16; ++i) {
          const int ii = ti * 32 + crow(i, h), sj = tj * 32 + r;
          const bool keep = dir == 0 ? (sj <= ii) : (sj >= ii);
          ps[ii * 72 + sj] = f2bf(keep ? at[i] : 0.f);
        }
      }
      __syncthreads();
      if (wv == 4 || wv == 5) {
        const int ti = wv - 4;
        f32x16 o;
#pragma unroll
        for (int i = 0; i < 16; ++i) o[i] = 0.f;
#pragma unroll
        for (int ss = 0; ss < 4; ++ss) {
          const bf16x8 a = *(const bf16x8*)(ps + (ti * 32 + r) * 72 + ss * 16 + h * 8);
          const bf16x8 bv = *(const bf16x8*)(vt + r * 72 + ss * 16 + h * 8);
          o = MFMA32(a, bv, o);
        }
#pragma unroll
        for (int kk = 0; kk < 8; ++kk) {
          const bf16x8 a = *(const bf16x8*)(qs + (ti * 32 + r) * 136 + kk * 16 + h * 8);
          const bf16x8 bv = *(const bf16x8*)(sb + r * 136 + kk * 16 + h * 8);
          o = MFMA32(a, bv, o);
        }
#pragma unroll
        for (int i = 0; i < 16; ++i) {
          const int ii = ti * 32 + crow(i, h);
          O[(size_t)(row0 + ii) * 1024 + hd * 256 + vs * 32 + r] = f2bf(o[i]);
        }
      }
      __syncthreads();
      if (wv < 4) {
        S = Sn;
#pragma unroll
        for (int g = 0; g < 4; ++g) {
          u16x4 o;
#pragma unroll
          for (int q = 0; q < 4; ++q) o[q] = f2bf(S[4 * g + q]);
          *(u16x4*)(sb + r * 136 + wv * 32 + 8 * g + 4 * h) = o;
        }
      }
    }
  }
}

DI void gla_out_phase(const Params& P, int bid, int nblk) {
  const int lane = ltid() & 63, wv = ltid() >> 6;
  u16* A = (u16*)(P.ws + OFF_A);
  const u16* Ob = (const u16*)(P.ws + OFF_BIG + B_GOB);
  const u16* Z = (const u16*)(P.ws + OFF_BIG + B_GZ);
  for (int task = bid * 8 + wv; task < NTOK * 4; task += nblk * 8) {
    const int row = task >> 2, hd = task & 3;
    const size_t o = (size_t)row * 1024 + hd * 256 + lane * 4;
    const u16x4 a = *(const u16x4*)(A + o), bq = *(const u16x4*)(Ob + o);
    const u16x4 og = *(const u16x4*)(Z + (size_t)row * GLA_N + 2048 + hd * 256 + lane * 4);
    float v[4];
    float ss = 0.f;
#pragma unroll
    for (int j = 0; j < 4; ++j) { v[j] = bf2f(a[j]) + bf2f(bq[j]); ss += v[j] * v[j]; }
    ss = wave_sum(ss, lane);
    const float rstd = rsqrtf(ss * (1.f / 256.f) + EPS);
    u16x4 res;
#pragma unroll
    for (int j = 0; j < 4; ++j) res[j] = f2bf(v[j] * rstd * P.gla_onorm[lane * 4 + j] * silu(bf2f(og[j])));
    *(u16x4*)(A + o) = res;
  }
}

DI void mla_prep_phase(const Params& P, int bid, int nblk) {
  const int lane = ltid() & 63, wv = ltid() >> 6;
  const u16* Cd = (const u16*)(P.ws + OFF_BIG + B_CD);
  u16* CQN = (u16*)(P.ws + OFF_A + A_CQN);
  u16* CKVN = (u16*)(P.ws + OFF_A + A_CKVN);
  u16* KR = (u16*)(P.ws + OFF_BIG + B_KR);
  for (int row = bid * 8 + wv; row < NTOK; row += nblk * 8) {
    const u16* cr = Cd + (size_t)row * MLA_DNP;
    if (row < NL) {
      float v[6], ss = 0.f;
#pragma unroll
      for (int j = 0; j < 6; ++j) { v[j] = bf2f(cr[lane + 64 * j]); ss += v[j] * v[j]; }
      ss = wave_sum(ss, lane);
      const float rstd = rsqrtf(ss * (1.f / 384.f) + EPS);
#pragma unroll
      for (int j = 0; j < 6; ++j) CQN[(size_t)row * 384 + lane + 64 * j] = f2bf(v[j] * rstd * P.mla_qnorm[lane + 64 * j]);
    }
    {
      float v[4], ss = 0.f;
#pragma unroll
      for (int j = 0; j < 4; ++j) { v[j] = bf2f(cr[384 + lane + 64 * j]); ss += v[j] * v[j]; }
      ss = wave_sum(ss, lane);
      const float rstd = rsqrtf(ss * (1.f / 256.f) + EPS);
#pragma unroll
      for (int j = 0; j < 4; ++j) CKVN[(size_t)row * 256 + lane + 64 * j] = f2bf(v[j] * rstd * P.mla_kvnorm[lane + 64 * j]);
    }
    {
      float x = bf2f(cr[640 + lane]);
      const float px = shx(x, 16, lane);
      int b, key;
      if (row < NL) {
        b = row >> 13; const int l = row & 8191; key = NCTX + l;
        const int jj = lane & 15;
        const bool first = (lane & 31) < 16;
        const float invf = __expf(-(float)jj * (9.210340371976184f / 16.f));
        const float pos = (float)(lane < 32 ? (l >> 6) : (l & 63));
        float sn, cs;
        __sincosf(pos * invf, &sn, &cs);
        x = first ? (x * cs - px * sn) : (px * sn + x * cs);
      } else { b = (row - NL) >> 8; key = (row - NL) & 255; }
      KR[((size_t)b * NKEY + key) * 64 + lane] = f2bf(x);
    }
  }
}

constexpr int KS_STRIDE = 200;
constexpr int VS_STRIDE = 68;
DI void mla_attn_phase(const Params& P, unsigned char* smem, int bid, int nblk) {
  u16* Ks = (u16*)smem;
  u16* Vs = Ks + 2 * 64 * KS_STRIDE;
  const int tid = ltid(), lane = tid & 63, wv = tid >> 6;
  const int r = lane & 31, h = lane >> 5;
  const u16* Qg = (const u16*)(P.ws + OFF_BIG + B_Q);
  const u16* Kn = (const u16*)(P.ws + OFF_BIG + B_KN);
  const u16* VT = (const u16*)(P.ws + OFF_BIG + B_VT);
  const u16* KR = (const u16*)(P.ws + OFF_BIG + B_KR);
  u16* O = (u16*)(P.ws + OFF_A);
  for (int u = bid; u < 1024; u += nblk) {
    const int bh = u >> 5, qb = u & 31, b = bh >> 3, hd = bh & 7;
    const int l = qb * 256 + wv * 32 + r;
    bf16x8 qf[12];
    {
      const u16* qp = Qg + ((size_t)bh * SEQ + l) * 192 + h * 8;
#pragma unroll
      for (int s = 0; s < 12; ++s) qf[s] = *(const bf16x8*)(qp + s * 16);
    }
    f32x16 oacc[4];
#pragma unroll
    for (int d = 0; d < 4; ++d)
#pragma unroll
      for (int i = 0; i < 16; ++i) oacc[d][i] = 0.f;
    float mrun = -1e30f, lrun = 0.f;
    const u16* Kb = Kn + (size_t)bh * NKEY * 128;
    const u16* Rb = KR + (size_t)b * NKEY * 64;
    const u16* Vb = VT + (size_t)bh * 128 * NKEY;
    uint4 rk0, rk1, rk2, rv0, rv1;
#define ATT_GLOAD(kt_)                                                                                      \
    { const int key0 = (kt_) * 64;                                                                          \
      rk0 = *(const uint4*)(Kb + (size_t)(key0 + (tid >> 4)) * 128 + (tid & 15) * 8);                       \
      rk1 = *(const uint4*)(Kb + (size_t)(key0 + 32 + (tid >> 4)) * 128 + (tid & 15) * 8);                  \
      rk2 = *(const uint4*)(Rb + (size_t)(key0 + (tid >> 3)) * 64 + (tid & 7) * 8);                         \
      rv0 = *(const uint4*)(Vb + (size_t)(tid >> 3) * NKEY + key0 + (tid & 7) * 8);                         \
      rv1 = *(const uint4*)(Vb + (size_t)(64 + (tid >> 3)) * NKEY + key0 + (tid & 7) * 8); }
#define ATT_STV(src_, row_, buf_)                                                                           \
    { uint2* dp = (uint2*)(Vs + (buf_) * 128 * VS_STRIDE + (row_) * VS_STRIDE + (tid & 7) * 8);                \
      dp[0] = make_uint2(src_.x, src_.y); dp[1] = make_uint2(src_.z, src_.w); }
#define ATT_SSTORE(buf_)                                                                                    \
    { *(uint4*)(Ks + (buf_) * 64 * KS_STRIDE + (tid >> 4) * KS_STRIDE + (tid & 15) * 8) = rk0;                \
      *(uint4*)(Ks + (buf_) * 64 * KS_STRIDE + (32 + (tid >> 4)) * KS_STRIDE + (tid & 15) * 8) = rk1;         \
      *(uint4*)(Ks + (buf_) * 64 * KS_STRIDE + (tid >> 3) * KS_STRIDE + 128 + (tid & 7) * 8) = rk2;           \
      ATT_STV(rv0, (tid >> 3), buf_) ATT_STV(rv1, (64 + (tid >> 3)), buf_) }
    ATT_GLOAD(0);
    __syncthreads();
    ATT_SSTORE(0);
    __syncthreads();
    for (int kt = 0; kt < 132; ++kt) {
      const int cur = kt & 1;
      if (kt + 1 < 132) ATT_GLOAD(kt + 1);
      const u16* kc = Ks + cur * 64 * KS_STRIDE;
      const u16* vc = Vs + cur * 128 * VS_STRIDE;
#pragma unroll 1
      for (int t2 = 0; t2 < 2; ++t2) {
        f32x16 st;
#pragma unroll
        for (int i = 0; i < 16; ++i) st[i] = 0.f;
#pragma unroll
        for (int s = 0; s < 12; ++s) {
          const bf16x8 a = *(const bf16x8*)(kc + (t2 * 32 + r) * KS_STRIDE + s * 16 + h * 8);
          st = MFMA32(a, qf[s], st);
        }
        float mx = st[0];
#pragma unroll
        for (int i = 1; i < 16; ++i) mx = fmaxf(mx, st[i]);
        mx = fmaxf(mx, shx(mx, 32, lane));
        const float mnew = fmaxf(mrun, mx);
        const float alpha = __builtin_amdgcn_exp2f(mrun - mnew);
        mrun = mnew;
        float ls = 0.f;
#pragma unroll
        for (int i = 0; i < 16; ++i) { const float p = __builtin_amdgcn_exp2f(st[i] - mnew); st[i] = p; ls += p; }
        ls += shx(ls, 32, lane);
        lrun = lrun * alpha + ls;
#pragma unroll
        for (int d = 0; d < 4; ++d)
#pragma unroll
          for (int i = 0; i < 16; ++i) oacc[d][i] *= alpha;
        if (t2 == 0 && kt + 1 < 132) ATT_SSTORE(cur ^ 1);
#pragma unroll
        for (int s2 = 0; s2 < 2; ++s2) {
          bf16x8 pf;
#pragma unroll
          for (int j = 0; j < 8; ++j) pf[j] = (short)f2bf(st[8 * s2 + j]);
#pragma unroll
          for (int d = 0; d < 4; ++d) {
            const u16* vp = vc + (d * 32 + r) * VS_STRIDE + t2 * 32 + 16 * s2 + 4 * h;
            const uint2 lo = *(const uint2*)vp, hi = *(const uint2*)(vp + 8);
            uint4 av = make_uint4(lo.x, lo.y, hi.x, hi.y);
            oacc[d] = MFMA32(__builtin_bit_cast(bf16x8, av), pf, oacc[d]);
          }
        }
      }
      __syncthreads();
    }
    const float inv = 1.f / lrun;
    u16* op = O + (size_t)(b * SEQ + l) * 1024 + hd * 128;
#pragma unroll
    for (int d = 0; d < 4; ++d)
#pragma unroll
      for (int g = 0; g < 4; ++g) {
        u16x4 o;
#pragma unroll
        for (int q = 0; q < 4; ++q) o[q] = f2bf(oacc[d][4 * g + q] * inv);
        *(u16x4*)(op + d * 32 + 8 * g + 4 * h) = o;
      }
  }
}

constexpr int NPHASE = 35;

DI void run_phase(const Params& P, int ph, unsigned char* smem, int bid, int nblk) {
  u16* WT = (u16*)(P.ws + OFF_WT);
  u16* A = (u16*)(P.ws + OFF_A);
  unsigned char* BIG = P.ws + OFF_BIG;
  float* XC = (float*)(P.ws + OFF_XC);
  const float* MOD = (const float*)(P.ws + OFF_MOD);
  EpiArgs ea{};
  if (ph == 0) {
    pro_weights(P, smem, bid, nblk);
    __syncthreads();
    pro_adaln(P, smem, bid, nblk);
    pro_filter_mlp(P, bid, nblk);
    return;
  }
  if (ph == 34) { final_norm_phase(P, bid, nblk); return; }
  int li, sub;
  if (ph <= 8) { li = 0; sub = ph - 1; }
  else if (ph <= 16) { li = 1; sub = ph - 9; }
  else if (ph <= 25) { li = 2; sub = ph - 17; }
  else { li = 3; sub = ph - 26; }
  const bool ctx_on = li <= 1;
  const int rows_all = ctx_on ? NTOK : NL;
  const int mt_all = rows_all / 256;
  const float* xl = li == 0 ? P.x : P.out;
  const float* xc = li == 0 ? P.ctx : XC;
  const int nsub = li == 2 ? 9 : 8;
  if (sub == nsub - 3) { normmod_phase(P, li, 1, rows_all, P.out, XC, bid, nblk); return; }
  if (sub == nsub - 2) {
    ea.o0 = (u16*)(BIG + B_HID);
    gemm_phase<EPI_MLP1>(A, 1024, WT + W_MLP1(li), 1024, mt_all, 32, ea, smem, bid, nblk);
    return;
  }
  if (sub == nsub - 1) {
    ea.gate = MOD + (size_t)li * 5 * 6144; ea.gofs = 5 * 1024;
    ea.xsl = P.out; ea.xsc = XC; ea.xdl = P.out; ea.xdc = XC;
    gemm_phase<EPI_RES>((const u16*)(BIG + B_HID), HID, WT + W_MLP2(li), HID, mt_all, 8, ea, smem, bid, nblk);
    return;
  }
  ea.gate = MOD + (size_t)li * 5 * 6144; ea.gofs = 2 * 1024;
  ea.xsl = xl; ea.xsc = xc; ea.xdl = P.out; ea.xdc = XC;
  if (li == 0 || li == 3) {
    const int jl = li == 0 ? 0 : 1;
    switch (sub) {
      case 0: normmod_phase(P, li, 0, rows_all, xl, xc, bid, nblk); break;
      case 1: {
        EpiArgs e1{};
        e1.bias = P.hy_b_in + jl * 3072; e1.o0 = (u16*)(BIG + B_ZT);
        gemm_phase<EPI_HYIN>(A, 1024, WT + W_HYIN(jl), 1024, mt_all, 24, e1, smem, bid, nblk);
        EpiArgs e2{};
        e2.o0 = (u16*)(BIG + B_KT); e2.mrow0 = 0; e2.L = SEQ;
        const u16* h3 = (const u16*)(P.ws + OFF_H3) + (size_t)jl * KTL * 64;
        gemm_phase<EPI_FILT>(h3, 64, WT + W_HYF4(jl), 64, 32, 32, e2, smem, bid, nblk);
        if (ctx_on) {
          e2.mrow0 = SEQ; e2.L = NCTX;
          gemm_phase<EPI_FILT>(h3 + (size_t)SEQ * 64, 64, WT + W_HYF4(jl), 64, 1, 32, e2, smem, bid, nblk);
        }
      } break;
      case 2: hyena_conv_phase(P, jl, ctx_on, smem, bid, nblk); break;
      case 3: transpose_phase(P, rows_all, smem, bid, nblk); break;
      case 4:
        ea.bias = P.hy_b_out + jl * 1024;
        gemm_phase<EPI_RES>(A, 1024, WT + W_HYOUT(jl), 1024, mt_all, 8, ea, smem, bid, nblk);
        break;
    }
    return;
  }
  if (li == 1) {
    switch (sub) {
      case 0: normmod_phase(P, li, 0, NTOK, xl, xc, bid, nblk); break;
      case 1: {
        EpiArgs e1{};
        e1.o0 = (u16*)(BIG + B_GZ);
        gemm_phase<EPI_GLAIN>(A, 1024, WT + W_GLAIN, 1024, NTOK / 256, GLA_NP / 128, e1, smem, bid, nblk);
      } break;
      case 2: gla_scan_phase(P, smem, bid, nblk); break;
      case 3: gla_out_phase(P, bid, nblk); break;
      case 4: gemm_phase<EPI_RES>(A, 1024, WT + W_GLAWO, 1024, NTOK / 256, 8, ea, smem, bid, nblk); break;
    }
    return;
  }
  switch (sub) {
    case 0: normmod_phase(P, li, 0, NTOK, xl, xc, bid, nblk); break;
    case 1: {
      EpiArgs e1{};
      e1.o0 = (u16*)(BIG + B_CD);
      gemm_phase<EPI_MLADN>(A, 1024, WT + W_MLADN, 1024, NTOK / 256, MLA_DNP / 128, e1, smem, bid, nblk);
    } break;
    case 2: mla_prep_phase(P, bid, nblk); break;
    case 3: {
      EpiArgs e1{};
      e1.o0 = (u16*)(BIG + B_Q);
      gemm_phase<EPI_MLAQ>((const u16*)(P.ws + OFF_A + A_CQN), 384, WT + W_MLAUQ, 384, NL / 256, 12, e1, smem, bid, nblk);
      EpiArgs e2{};
      e2.o0 = (u16*)(BIG + B_KN); e2.o1 = (u16*)(BIG + B_VT);
      gemm_phase<EPI_MLAKV>((const u16*)(P.ws + OFF_A + A_CKVN), 256, WT + W_MLAUKV, 256, NTOK / 256, 16, e2, smem, bid, nblk);
    } break;
    case 4: mla_attn_phase(P, smem, bid, nblk); break;
    case 5: gemm_phase<EPI_RES>(A, 1024, WT + W_MLAWO, 1024, NL / 256, 8, ea, smem, bid, nblk); break;
  }
}

__global__ void __launch_bounds__(NT) mega(Params P) {
  extern __shared__ __attribute__((aligned(16))) unsigned char smem[];
  const int bid = blockIdx.x, nblk = gridDim.x;
  for (int ph = P.ph_lo; ph < P.ph_hi; ++ph) {
    run_phase(P, ph, smem, bid, nblk);
    if (ph + 1 < P.ph_hi) { cg::this_grid().sync(); }
  }
}

extern "C" void kernel_launch(void* const* d_in, const int* in_sizes, int n_in, void* d_out, int out_size, void* d_ws, size_t ws_size,
                              hipStream_t stream) {
  static int grid = 0;
  if (grid == 0) {
    if (n_in != 37 || ws_size < WS_NEED) { fprintf(stderr, "kernel_launch: bad n_in %d / ws %zu\n", n_in, ws_size); grid = -1; return; }
    int dev = 0, cus = 0, per_cu = 0;
    hipGetDevice(&dev);
    hipDeviceGetAttribute(&cus, hipDeviceAttributeMultiprocessorCount, dev);
    if (hipFuncSetAttribute((const void*)mega, hipFuncAttributeMaxDynamicSharedMemorySize, LDS_BYTES) != hipSuccess) { fprintf(stderr, "hipFuncSetAttribute failed\n"); grid = -1; return; }
    hipOccupancyMaxActiveBlocksPerMultiprocessor(&per_cu, (const void*)mega, NT, LDS_BYTES);
    (void)hipGetLastError();
    if (per_cu < 1) per_cu = 1;
    grid = cus * per_cu;
  }
  if (grid < 0) return;
  Params p{};
  const float** fp = (const float**)&p;
  for (int i = 0; i < 37; ++i) fp[i] = (const float*)d_in[i];
  p.out = (float*)d_out;
  p.ws = (unsigned char*)d_ws;
  {
    int m = 0, tot = 0;
    auto add = [&](const float* src, size_t dst, int K, int N, int Np) {
      p.mats[m].src = src; p.mats[m].dst = dst; p.mats[m].K = K; p.mats[m].N = N; p.mats[m].Np = Np;
      p.mats[m].tiles = (K / 64) * (Np / 64); tot += p.mats[m].tiles; ++m;
    };
    for (int i = 0; i < 4; ++i) {
      add(p.mlp_w1 + (size_t)i * 1024 * 4096, W_MLP1(i), 1024, 4096, 4096);
      add(p.mlp_w2 + (size_t)i * 4096 * 1024, W_MLP2(i), 4096, 1024, 1024);
    }
    for (int j = 0; j < 2; ++j) {
      add(p.hy_w_in + (size_t)j * 1024 * 3072, W_HYIN(j), 1024, 3072, 3072);
      add(p.hy_w_out + (size_t)j * 1024 * 1024, W_HYOUT(j), 1024, 1024, 1024);
      add(p.hy_f_w4 + (size_t)j * 64 * 4096, W_HYF4(j), 64, 4096, 4096);
    }
    add(p.gla_w_in, W_GLAIN, 1024, GLA_N, GLA_NP);
    add(p.gla_wo, W_GLAWO, 1024, 1024, 1024);
    add(p.mla_w_down, W_MLADN, 1024, MLA_DN, MLA_DNP);
    add(p.mla_w_uq, W_MLAUQ, 384, 1536, 1536);
    add(p.mla_w_ukv, W_MLAUKV, 256, 2048, 2048);
    add(p.mla_wo, W_MLAWO, 1024, 1024, 1024);
    for (; m < NMAT; ++m) { p.mats[m].tiles = 0; }
    p.total_mat_tiles = tot;
  }
#if MULTI
  for (int ph = 0; ph < NPHASE; ++ph) {
    p.ph_lo = ph; p.ph_hi = ph + 1;
    hipLaunchKernelGGL(mega, dim3(grid), dim3(NT), LDS_BYTES, stream, p);
  }
#else
  p.ph_lo = 0; p.ph_hi = NPHASE;
  void* args[] = {&p};
  hipError_t e = hipLaunchCooperativeKernel((const void*)mega, dim3(grid), dim3(NT), args, LDS_BYTES, stream);
  if (e != hipSuccess) fprintf(stderr, "cooperative launch failed: %s (grid %d)\n", hipGetErrorString(e), grid);
#endif
}
```

```cpp
#include <hip/hip_runtime.h>
#include <hip/hip_cooperative_groups.h>
#include <cstdio>
#include <cstdint>
namespace cg = cooperative_groups;

#ifndef MULTI
#define MULTI 0
#endif
#ifndef CHECKS
#define CHECKS 0
#endif

typedef unsigned short u16;
using bf16x8 = __attribute__((ext_vector_type(8))) short;
using u16x4  = __attribute__((ext_vector_type(4))) unsigned short;
using u16x8  = __attribute__((ext_vector_type(8))) unsigned short;
using f32x16 = __attribute__((ext_vector_type(16))) float;
#define DI __device__ __forceinline__
#define MFMA32(a, b, c) __builtin_amdgcn_mfma_f32_32x32x16_bf16((a), (b), (c), 0, 0, 0)

constexpr int DM = 1024, NB = 4, SEQ = 8192, NCTX = 256;
constexpr int NL = NB * SEQ;
constexpr int NTOK = NL + NB * NCTX;
constexpr int HID = 4096;
constexpr int NT = 512;
constexpr int GLA_N = 3104, GLA_NP = 3328;
constexpr int MLA_DN = 704, MLA_DNP = 768;
constexpr int KTL = SEQ + NCTX;
constexpr int NKEY = SEQ + NCTX;
constexpr float EPS = 1e-6f;

constexpr size_t MiB = 1048576;
constexpr size_t OFF_MOD = 0;
constexpr size_t OFF_ERR = 512 * 1024;
constexpr size_t OFF_XC  = 1 * MiB;
constexpr size_t OFF_H3  = 5 * MiB;
constexpr size_t OFF_WT  = 8 * MiB;
constexpr size_t OFF_A   = 104 * MiB;
constexpr size_t OFF_BIG = 170 * MiB;
constexpr size_t WS_NEED = 510 * MiB;
constexpr size_t W_MLP1(int i) { return (size_t)i * 8388608; }
constexpr size_t W_MLP2(int i) { return (size_t)i * 8388608 + 4194304; }
constexpr size_t W_HY0 = 33554432;
constexpr size_t W_HYIN(int j)  { return W_HY0 + (size_t)j * 4456448; }
constexpr size_t W_HYOUT(int j) { return W_HYIN(j) + 3145728; }
constexpr size_t W_HYF4(int j)  { return W_HYOUT(j) + 1048576; }
constexpr size_t W_GLAIN = W_HY0 + 2 * 4456448;
constexpr size_t W_GLAWO = W_GLAIN + (size_t)GLA_NP * 1024;
constexpr size_t W_MLADN = W_GLAWO + 1048576;
constexpr size_t W_MLAUQ = W_MLADN + (size_t)MLA_DNP * 1024;
constexpr size_t W_MLAUKV = W_MLAUQ + 1536 * 384;
constexpr size_t W_MLAWO = W_MLAUKV + 2048 * 256;
constexpr size_t W_END = W_MLAWO + 1048576;
static_assert(W_END * 2 <= 96 * MiB, "wt");
constexpr size_t B_ZT = 0;
constexpr size_t B_YT = (size_t)3072 * NTOK * 2;
constexpr size_t B_KT = B_YT + (size_t)1024 * NTOK * 2;
constexpr size_t B_HID = 0;
constexpr size_t B_GZ = 0;
constexpr size_t B_GOB = (size_t)NTOK * GLA_N * 2;
constexpr size_t B_G2 = B_GOB + (size_t)NTOK * 1024 * 2;
constexpr size_t B_DEC = B_G2 + (size_t)NTOK * 1024 * 2;
constexpr size_t B_Q = 0;
constexpr size_t B_KN = (size_t)NL * 1536 * 2;
constexpr size_t B_VT = B_KN + (size_t)NTOK * 1024 * 2;
constexpr size_t B_KR = B_VT + (size_t)NTOK * 1024 * 2;
constexpr size_t B_CD = B_KR + (size_t)NTOK * 64 * 2;
static_assert(B_KT + (size_t)4096 * KTL * 2 <= 330 * MiB, "big");
static_assert(B_CD + (size_t)NTOK * 768 * 2 <= 330 * MiB, "big2");
static_assert(B_DEC + (size_t)528 * 4 * 2 * 128 * 4 <= 340 * MiB, "big3");
constexpr size_t A_CQN = 0;
constexpr size_t A_CKVN = (size_t)NL * 384 * 2;

constexpr int LDS_BYTES = 148 * 1024;

struct MatDesc { const float* src; unsigned long long dst; int K, N, Np, tiles, perm, pad; };
constexpr int NMAT = 22;

struct Params {
  const float *x, *c, *ctx, *c_ctx, *ada_w, *ada_b, *norm1_g, *norm2_g, *mlp_w1, *mlp_w2, *final_g;
  const float *hy_w_in, *hy_b_in, *hy_conv_w, *hy_conv_b, *hy_f_w1, *hy_f_b1, *hy_f_w2, *hy_f_b2, *hy_f_w3, *hy_f_b3, *hy_f_w4,
      *hy_freq, *hy_bias, *hy_w_out, *hy_b_out;
  const float *gla_w_in, *gla_gk_w2, *gla_gk_b, *gla_onorm, *gla_wo;
  const float *mla_w_down, *mla_qnorm, *mla_w_uq, *mla_kvnorm, *mla_w_ukv, *mla_wo;
  float* out;
  unsigned char* ws;
  MatDesc mats[NMAT];
  int total_mat_tiles;
  int ph_lo, ph_hi;
  int pad0;
};

DI u16 f2bf(float x) { unsigned u = __float_as_uint(x); u += 0x7fffu + ((u >> 16) & 1u); return (u16)(u >> 16); }
DI float bf2f(u16 v) { return __uint_as_float(((unsigned)v) << 16); }
typedef float f2v_t __attribute__((ext_vector_type(2)));
typedef __bf16 b2v_t __attribute__((ext_vector_type(2)));
DI unsigned pk2(float lo, float hi) { f2v_t v; v.x = lo; v.y = hi; return __builtin_bit_cast(unsigned, __builtin_convertvector(v, b2v_t)); }
DI float shx(float v, int mask, int lane) { return __int_as_float(__builtin_amdgcn_ds_bpermute((lane ^ mask) << 2, __float_as_int(v))); }
DI float wave_sum(float v, int lane) {
#pragma unroll
  for (int o = 32; o > 0; o >>= 1) v += shx(v, o, lane);
  return v;
}
DI int ltid() { int t = threadIdx.x; asm volatile("" : "+v"(t)); return t; }
DI unsigned char* lws(const Params& P) { unsigned char* w = P.ws; asm volatile("" : "+s"(w)); return w; }
DI float lzero() { float z; asm volatile("v_mov_b32 %0, 0" : "=v"(z)); return z; }
DI int crow(int reg, int h) { return (reg & 3) + 8 * (reg >> 2) + 4 * h; }
DI float silu(float x) { return x / (1.f + __expf(-x)); }
DI int mod_index(int row) { return row < NL ? (row >> 13) : 4; }

namespace pg8 {
#define PG8_LAS __attribute__((address_space(3)))
typedef unsigned short bf16_t;
typedef short bf16x8 __attribute__((ext_vector_type(8)));
typedef float f32x4 __attribute__((ext_vector_type(4)));
typedef unsigned u32x4 __attribute__((ext_vector_type(4)));
constexpr int BM = 256, BK = 64, HALF = 128, HTB = HALF * BK * 2  , STAGE_BYTES = 8 * HTB, NXCD = 8, WGM = 8;

__host__ __device__ __forceinline__ int lds_byte(int r, int c) { const int st = (r >> 4) * 2 + (c >> 5), rr = r & 15, cc = c & 31, ob = rr * 64 + cc * 2; return st * 1024 + (ob ^ (((ob >> 9) & 1) << 5)); }
__host__ __device__ __forceinline__ void stage_rc(int b, int& R, int& C) { const int st = b / 1024, sb = b % 1024, swz = sb ^ (((sb >> 9) & 1) << 5); R = (st >> 1) * 16 + swz / 64; C = (st & 1) * 32 + (swz % 64) / 2; }
__host__ __device__ __forceinline__ int perm32(int rho) { const int n = rho >> 4, i = rho & 15; return 8 * (i >> 2) + 4 * n + (i & 3); }

struct Unit { int pm, pn, koff; };
struct Gemm { const bf16_t* A; const bf16_t* Bt; int M, N, K, ld; };

struct StaticOrder {
    int nM, nN, nwg, G, c;
    __host__ __device__ void init(int M, int N, int G_, int c_) { nM = M / BM; nN = N / BM; nwg = nM * nN; G = G_; c = c_; }
    __host__ __device__ bool next(int i, Unit& u) const {
        const long L = (long)i * G + c; if (L >= nwg) return false;
        int wgid = (int)L; { const int q = nwg / NXCD, r = nwg % NXCD, xcd = wgid % NXCD, off = wgid / NXCD; wgid = (xcd < r ? xcd * (q + 1) : r * (q + 1) + (xcd - r) * q) + off; }
        const int nig = WGM * nN, gid = wgid / nig, fm = gid * WGM, gsz = (nM - fm) < WGM ? (nM - fm) : WGM;
        u.pm = fm + ((wgid % nig) % gsz); u.pn = (wgid % nig) / gsz; u.koff = 0; return true;
    }
    __device__ __forceinline__ void a_ready(const Unit&) const {}
    __device__ __forceinline__ void done(const Unit&) const {}
};

template <class Epi, class Sched, bool STAMP = false>
__device__ __forceinline__ void gemm_phase(PG8_LAS unsigned char* lds, const Gemm g, const Sched& S, const Epi& E, unsigned long long* stamps) {
    const int tid = ltid(), wid = __builtin_amdgcn_readfirstlane(tid >> 6), lane = tid & 63, wr = wid >> 2, wc = wid & 3, fr = lane & 15, fq = lane >> 4;
    const int K = g.ld, nt = g.K / BK;
    int ts_lo = 0, ts_hi = 0, nts = 0; const unsigned long long rt_entry = STAMP ? (unsigned long long)wall_clock64() : 0ull;
#define PG8_STAMP() do { if (STAMP && wid == 0 && nts < 64) { const unsigned long long _c = (unsigned long long)clock64(); \
        ts_lo = (lane == nts) ? (int)(unsigned)_c : ts_lo; ts_hi = (lane == nts) ? (int)(unsigned)(_c >> 32) : ts_hi; ++nts; } } while (0)
    PG8_STAMP();
    unsigned voffA[2], voffB[2];
#pragma unroll
    for (int i = 0; i < 2; ++i) { int R, C; stage_rc(tid * 16 + i * 8192, R, C); const int Rb = Epi::PERM ? ((R & ~31) + perm32(R & 31)) : R;
        voffA[i] = (unsigned)(R * K + C) * 2u; voffB[i] = (unsigned)(Rb * K + C) * 2u; }
    const size_t kstep = (size_t)(BK * 2);
    const size_t hstep = (size_t)HALF * K * 2;
    const size_t tstep = 2 * hstep;
    const unsigned ldsw = (unsigned)wid * 1024u;
    const int aoff = lds_byte(wr * 64 + fr, fq * 8), boff = lds_byte(wc * 32 + fr, fq * 8);
#define PG8_SA(b, h) (((b) * 2 + (h)) * HTB)
#define PG8_SB(b, h) ((4 + (b) * 2 + (h)) * HTB)
#define PG8_STAGE(bufoff, gbase, voff) do { _Pragma("unroll") for (int _i = 0; _i < 2; ++_i) \
        __builtin_amdgcn_global_load_lds((const unsigned*)((const char*)(gbase) + (voff)[_i]), (PG8_LAS unsigned*)(lds + (bufoff) + ldsw + _i * 8192), 16, 0, 0); } while (0)
#define PG8_LDA(dst, b, h) do { _Pragma("unroll") for (int m = 0; m < 4; ++m) _Pragma("unroll") for (int k = 0; k < 2; ++k) dst[m][k] = *(const PG8_LAS bf16x8*)(lds + PG8_SA(b, h) + aoff + m * 2048 + k * 1024); } while (0)
#define PG8_LDB(dst, b, h) do { _Pragma("unroll") for (int n = 0; n < 2; ++n) _Pragma("unroll") for (int k = 0; k < 2; ++k) dst[n][k] = *(const PG8_LAS bf16x8*)(lds + PG8_SB(b, h) + boff + n * 2048 + k * 1024); } while (0)
#define PG8_MMA(ai, bj, At, Bt) do { __builtin_amdgcn_s_setprio(1); _Pragma("unroll") for (int m = 0; m < 4; ++m) _Pragma("unroll") for (int n = 0; n < 2; ++n) _Pragma("unroll") for (int k = 0; k < 2; ++k) \
        acc[ai][bj][m][n] = __builtin_amdgcn_mfma_f32_16x16x32_bf16(Bt[n][k], At[m][k], acc[ai][bj][m][n], 0, 0, 0); __builtin_amdgcn_s_setprio(0); } while (0)
#define PG8_WAIT_V(n) asm volatile("s_waitcnt vmcnt(" #n ")" ::: "memory")
#define PG8_WAIT_L(n) asm volatile("s_waitcnt lgkmcnt(" #n ")" ::: "memory")
#define PG8_BAR __builtin_amdgcn_s_barrier()
#define PG8_SCHED __builtin_amdgcn_sched_barrier(0)
    Unit cur, nxt; int ui = 0;
    if (!S.next(0, cur)) return;
    f32x4 acc[2][2][4][2];
#pragma unroll
    for (int a = 0; a < 2; ++a)
#pragma unroll
        for (int b = 0; b < 2; ++b)
#pragma unroll
            for (int m = 0; m < 4; ++m)
#pragma unroll
                for (int n = 0; n < 2; ++n) acc[a][b][m][n] = (f32x4){0.f, 0.f, 0.f, 0.f};
    bf16x8 At[4][2], B0[2][2], B1[2][2];
    const char* cA = (const char*)g.A + (size_t)cur.pm * tstep + (size_t)cur.koff * 2; const char* cB = (const char*)g.Bt + (size_t)cur.pn * tstep + (size_t)cur.koff * 2;
    S.a_ready(cur);
    PG8_STAGE(PG8_SB(0, 0), cB, voffB); PG8_STAGE(PG8_SA(0, 0), cA, voffA); PG8_STAGE(PG8_SB(0, 1), cB + hstep, voffB); PG8_STAGE(PG8_SA(0, 1), cA + hstep, voffA);
    if (wr == 1) PG8_BAR;
    PG8_WAIT_V(4); PG8_BAR;
    PG8_STAGE(PG8_SB(1, 0), cB + kstep, voffB); PG8_STAGE(PG8_SA(1, 0), cA + kstep, voffA); PG8_STAGE(PG8_SB(1, 1), cB + hstep + kstep, voffB);
    PG8_WAIT_V(6); PG8_BAR;
    PG8_STAMP();
    for (;;) {
        const bool has_next = S.next(ui + 1, nxt);
        const char* nA = has_next ? (const char*)g.A + (size_t)nxt.pm * tstep + (size_t)nxt.koff * 2 : cA; const char* nB = has_next ? (const char*)g.Bt + (size_t)nxt.pn * tstep + (size_t)nxt.koff * 2 : cB;
        for (int t = 0; t < nt; t += 2) {
            const bool last = (t == nt - 2);
            const char* a1 = cA + (size_t)(t + 1) * kstep;
            const char* a2 = last ? nA : cA + (size_t)(t + 2) * kstep; const char* b2 = last ? nB : cB + (size_t)(t + 2) * kstep;
            const char* a3 = a2 + kstep; const char* b3 = b2 + kstep;
            if (last && has_next) S.a_ready(nxt);
            PG8_LDB(B0, 0, 0); PG8_SCHED; PG8_LDA(At, 0, 0); PG8_STAGE(PG8_SA(1, 1), a1 + hstep, voffA);
            PG8_WAIT_L(8); PG8_BAR; PG8_WAIT_L(0); PG8_MMA(0, 0, At, B0); PG8_BAR; PG8_SCHED;
            PG8_LDB(B1, 0, 1); PG8_STAGE(PG8_SB(0, 0), b2, voffB);
            PG8_BAR; PG8_WAIT_L(0); PG8_MMA(0, 1, At, B1); PG8_BAR;
            PG8_LDA(At, 0, 1); PG8_STAGE(PG8_SA(0, 0), a2, voffA);
            PG8_BAR; PG8_WAIT_L(0); PG8_MMA(1, 0, At, B0); PG8_BAR; PG8_SCHED;
            PG8_STAGE(PG8_SB(0, 1), b2 + hstep, voffB);
            PG8_WAIT_V(6); PG8_BAR; PG8_MMA(1, 1, At, B1); PG8_BAR;
            PG8_LDB(B0, 1, 0); PG8_SCHED; PG8_LDA(At, 1, 0); PG8_STAGE(PG8_SA(0, 1), a2 + hstep, voffA);
            PG8_WAIT_L(8); PG8_BAR; PG8_WAIT_L(0); PG8_MMA(0, 0, At, B0); PG8_BAR; PG8_SCHED;
            PG8_LDB(B1, 1, 1); PG8_STAGE(PG8_SB(1, 0), b3, voffB);
            PG8_BAR; PG8_WAIT_L(0); PG8_MMA(0, 1, At, B1); PG8_BAR;
            PG8_LDA(At, 1, 1); PG8_STAGE(PG8_SA(1, 0), a3, voffA);
            PG8_BAR; PG8_WAIT_L(0); PG8_MMA(1, 0, At, B0); PG8_BAR; PG8_SCHED;
            PG8_STAGE(PG8_SB(1, 1), b3 + hstep, voffB);
            PG8_WAIT_V(6); PG8_BAR; PG8_MMA(1, 1, At, B1); PG8_BAR;
        }
        PG8_STAMP();
        if constexpr (!Epi::AFTER_DRAIN) { E(acc, cur, wr, wc, fr, fq); S.done(cur); }
        PG8_STAMP();
        if (!has_next) break;
#pragma unroll
        for (int a = 0; a < 2; ++a)
#pragma unroll
            for (int b = 0; b < 2; ++b)
#pragma unroll
                for (int m = 0; m < 4; ++m)
#pragma unroll
                    for (int n = 0; n < 2; ++n) acc[a][b][m][n] = (f32x4){0.f, 0.f, 0.f, 0.f};
        cur = nxt; cA = nA; cB = nB; ++ui;
    }
    PG8_WAIT_V(0);
    if (wr == 0) PG8_BAR;
    PG8_BAR;
    if constexpr (Epi::AFTER_DRAIN) { E.fused(acc, cur, wr, wc, fr, fq, lds, wid, lane); S.done(cur); }
    PG8_STAMP();
    if (STAMP && wid == 0) { stamps[lane] = lane < nts ? (((unsigned long long)(unsigned)ts_hi << 32) | (unsigned)ts_lo) : 0ull;
        if (lane == 62) stamps[62] = rt_entry; if (lane == 63) stamps[63] = (unsigned long long)wall_clock64(); }
#undef PG8_STAMP
#undef PG8_SA
#undef PG8_SB
#undef PG8_STAGE
#undef PG8_LDA
#undef PG8_LDB
#undef PG8_MMA
#undef PG8_WAIT_V
#undef PG8_WAIT_L
#undef PG8_BAR
#undef PG8_SCHED
}
}

using pg8::f32x4; using pg8::u32x4;
#define EPI_ROWLOOP _Pragma("unroll") for (int ai = 0; ai < 2; ++ai) _Pragma("unroll") for (int m = 0; m < 4; ++m)
struct EHyIn {
  static constexpr bool PERM = true, AFTER_DRAIN = false;
  u16* o; const float* bias;
  DI void operator()(const f32x4 (&acc)[2][2][4][2], const pg8::Unit& u, int wr, int wc, int fr, int fq) const {
    const int row0 = u.pm * 256 + wr * 64 + fr, col0 = u.pn * 256 + wc * 32 + 8 * fq;
    EPI_ROWLOOP {
      const int row = row0 + ai * 128 + m * 16;
      const float bz = bias[row];
      u16* rp = o + (size_t)row * NTOK + col0;
#pragma unroll
      for (int bj = 0; bj < 2; ++bj) {
        const f32x4 v0 = acc[ai][bj][m][0], v1 = acc[ai][bj][m][1];
        u32x4 w; w.x = pk2(v0[0] + bz, v0[1] + bz); w.y = pk2(v0[2] + bz, v0[3] + bz); w.z = pk2(v1[0] + bz, v1[1] + bz); w.w = pk2(v1[2] + bz, v1[3] + bz);
        *(u32x4*)(rp + bj * 128) = w;
      }
    }
  }
};
struct ERes {
  static constexpr bool PERM = false, AFTER_DRAIN = false;
  const float* bias; const float* gate; int gofs; const float* xsl; const float* xsc; float* xdl; float* xdc;
  DI void operator()(const f32x4 (&acc)[2][2][4][2], const pg8::Unit& u, int wr, int wc, int fr, int fq) const {
    const int rowu = u.pm * 256;
    const int row0 = rowu + wr * 64 + fr, col0 = u.pn * 256 + wc * 32 + 4 * fq;
    const float* gp = gate + mod_index(rowu) * 6144 + gofs;
    const float* xs; float* xd;
    if (rowu < NL) { xs = xsl; xd = xdl; } else { xs = xsc - (size_t)NL * 1024; xd = xdc - (size_t)NL * 1024; }
#pragma unroll
    for (int bj = 0; bj < 2; ++bj)
#pragma unroll
      for (int n = 0; n < 2; ++n) {
        const f32x4 gv = *(const f32x4*)(gp + col0 + bj * 128 + n * 16);
        const f32x4 bv = bias ? *(const f32x4*)(bias + col0 + bj * 128 + n * 16) : (f32x4){0.f, 0.f, 0.f, 0.f};
        EPI_ROWLOOP {
          const size_t ro = (size_t)(row0 + ai * 128 + m * 16) * 1024 + col0 + bj * 128 + n * 16;
          const f32x4 xv = *(const f32x4*)(xs + ro);
          *(f32x4*)(xd + ro) = xv + gv * (acc[ai][bj][m][n] + bv);
        }
      }
  }
};
struct EResAtomic {
  static constexpr bool PERM = false, AFTER_DRAIN = false;
  const float* gate; float* xbase;
  DI void operator()(const f32x4 (&acc)[2][2][4][2], const pg8::Unit& u, int wr, int wc, int fr, int fq) const {
    const int row0 = u.pm * 256 + wr * 64 + fr, col0 = u.pn * 256 + wc * 32 + 4 * fq;
#pragma unroll
    for (int bj = 0; bj < 2; ++bj)
#pragma unroll
      for (int n = 0; n < 2; ++n) {
        const f32x4 gv = *(const f32x4*)(gate + col0 + bj * 128 + n * 16);
        EPI_ROWLOOP {
          float* xp = xbase + (size_t)(row0 + ai * 128 + m * 16) * 1024 + col0 + bj * 128 + n * 16;
          const f32x4 v = gv * acc[ai][bj][m][n];
          unsafeAtomicAdd(xp + 0, v[0]); unsafeAtomicAdd(xp + 1, v[1]); unsafeAtomicAdd(xp + 2, v[2]); unsafeAtomicAdd(xp + 3, v[3]);
        }
      }
  }
};
template <int MODE> struct EBf16 {
  static constexpr bool PERM = true, AFTER_DRAIN = false;
  u16* o; int ldc; int ncols;
  DI void operator()(const f32x4 (&acc)[2][2][4][2], const pg8::Unit& u, int wr, int wc, int fr, int fq) const {
    const int row0 = u.pm * 256 + wr * 64 + fr, col0 = u.pn * 256 + wc * 32 + 8 * fq;
    EPI_ROWLOOP {
      u16* rp = o + (size_t)(row0 + ai * 128 + m * 16) * ldc + col0;
#pragma unroll
      for (int bj = 0; bj < 2; ++bj) {
        f32x4 v0 = acc[ai][bj][m][0], v1 = acc[ai][bj][m][1];
        if (MODE == 1) {
#pragma unroll
          for (int j = 0; j < 4; ++j) { const float a = fmaxf(v0[j], 0.f), b = fmaxf(v1[j], 0.f); v0[j] = a * a; v1[j] = b * b; }
        }
        if (MODE == 2) { v0 = v0 * (0.07216878364870322f * 1.4426950408889634f); v1 = v1 * (0.07216878364870322f * 1.4426950408889634f); }
        u32x4 w; w.x = pk2(v0[0], v0[1]); w.y = pk2(v0[2], v0[3]); w.z = pk2(v1[0], v1[1]); w.w = pk2(v1[2], v1[3]);
        if (col0 + bj * 128 < ncols) *(u32x4*)(rp + bj * 128) = w;
      }
    }
  }
};
struct EMlaK {
  static constexpr bool PERM = true, AFTER_DRAIN = false;
  u16* o;
  DI void operator()(const f32x4 (&acc)[2][2][4][2], const pg8::Unit& u, int wr, int wc, int fr, int fq) const {
    const int row0 = u.pm * 256 + wr * 64 + fr, col0 = u.pn * 256 + wc * 32 + 8 * fq;
    EPI_ROWLOOP {
      const int row = row0 + ai * 128 + m * 16;
      int b, key;
      if (row < NL) { b = row >> 13; key = NCTX + (row & 8191); } else { b = (row - NL) >> 8; key = (row - NL) & 255; }
#pragma unroll
      for (int bj = 0; bj < 2; ++bj) {
        const int n = col0 + bj * 128, hd = n >> 7, c = n & 127;
        const f32x4 v0 = acc[ai][bj][m][0], v1 = acc[ai][bj][m][1];
        u32x4 w; w.x = pk2(v0[0], v0[1]); w.y = pk2(v0[2], v0[3]); w.z = pk2(v1[0], v1[1]); w.w = pk2(v1[2], v1[3]);
        *(u32x4*)(o + ((size_t)(b * 8 + hd) * NKEY + key) * 128 + c) = w;
      }
    }
  }
};
struct EMlaVT {
  static constexpr bool PERM = true, AFTER_DRAIN = false;
  u16* o;
  DI void operator()(const f32x4 (&acc)[2][2][4][2], const pg8::Unit& u, int wr, int wc, int fr, int fq) const {
    const int row0 = u.pm * 256 + wr * 64 + fr, col0 = u.pn * 256 + wc * 32 + 8 * fq;
#pragma unroll
    for (int bj = 0; bj < 2; ++bj) {
      const int tok = col0 + bj * 128;
      int b, key;
      if (tok < NL) { b = tok >> 13; key = NCTX + (tok & 8191); } else { b = (tok - NL) >> 8; key = (tok - NL) & 255; }
      EPI_ROWLOOP {
        const int vr = row0 + ai * 128 + m * 16, hd = vr >> 7, dv = vr & 127;
        const f32x4 v0 = acc[ai][bj][m][0], v1 = acc[ai][bj][m][1];
        u32x4 w; w.x = pk2(v0[0], v0[1]); w.y = pk2(v0[2], v0[3]); w.z = pk2(v1[0], v1[1]); w.w = pk2(v1[2], v1[3]);
        *(u32x4*)(o + ((size_t)(b * 8 + hd) * 128 + dv) * NKEY + key) = w;
      }
    }
  }
};
struct SplitKOrder {
  int nM, nN, nwg, G, c, klen;
  DI void init(int M, int N, int pieces, int klen_, int G_, int c_) { nM = M / 256; nN = N / 256; nwg = nM * nN * pieces; G = G_; c = c_; klen = klen_; }
  DI bool next(int i, pg8::Unit& u) const {
    const int L = i * G + c; if (L >= nwg) return false;
    const int t = L % (nM * nN), piece = L / (nM * nN);
    u.pm = t / nN; u.pn = t % nN; u.koff = piece * klen; return true;
  }
  DI void a_ready(const pg8::Unit&) const {}
  DI void done(const pg8::Unit&) const {}
};
template <class Epi>
DI void gemm8_splitk(const u16* A, const u16* Bt, int M, int N, int K, int pieces, const Epi& E, unsigned char* smem, int bid, int nblk) {
  asm volatile("" : "+s"(K));
  pg8::Gemm g; g.A = A; g.Bt = Bt; g.M = M; g.N = N; g.K = K / pieces; g.ld = K;
  SplitKOrder S; S.init(M, N, pieces, K / pieces, nblk, bid);
  __syncthreads();
  pg8::gemm_phase<Epi, SplitKOrder, false>((PG8_LAS unsigned char*)smem, g, S, E, nullptr);
  __syncthreads();
}
template <class Epi>
DI void gemm8(const u16* A, const u16* Bt, int M, int N, int K, const Epi& E, unsigned char* smem, int bid, int nblk) {
  asm volatile("" : "+s"(K));
  pg8::Gemm g; g.A = A; g.Bt = Bt; g.M = M; g.N = N; g.K = K; g.ld = K;
  pg8::StaticOrder S; S.init(M, N, nblk, bid);
  __syncthreads();
  pg8::gemm_phase<Epi, pg8::StaticOrder, false>((PG8_LAS unsigned char*)smem, g, S, E, nullptr);
  __syncthreads();
}

DI void pro_weights(const Params& P, unsigned char* smem, int bid, int nblk) {
  float* t = (float*)smem;
  const int tid = ltid();
  for (int tile = bid; tile < P.total_mat_tiles; tile += nblk) {
    int mi = 0, rem = tile;
    while (rem >= P.mats[mi].tiles) { rem -= P.mats[mi].tiles; ++mi; }
    const MatDesc md = P.mats[mi];
    const int ntn = md.Np / 256;
    const int k0 = (rem / ntn) * 64, n0 = (rem % ntn) * 256;
    u16* dst = (u16*)(lws(P) + OFF_WT) + md.dst;
    float4 v[8];
#pragma unroll
    for (int pass = 0; pass < 8; ++pass) {
      const int kr = (tid >> 6) + pass * 8, nc = (tid & 63) * 4;
      v[pass] = make_float4(0.f, 0.f, 0.f, 0.f);
      if (n0 + nc < md.N) v[pass] = *(const float4*)(md.src + (size_t)(k0 + kr) * md.N + n0 + nc);
    }
#pragma unroll
    for (int pass = 0; pass < 8; ++pass) {
      const int kr = (tid >> 6) + pass * 8, nc = (tid & 63) * 4;
      float* tp = t + kr * 257 + nc;
      tp[0] = v[pass].x; tp[1] = v[pass].y; tp[2] = v[pass].z; tp[3] = v[pass].w;
    }
    __syncthreads();
    {
      const int n = tid >> 1, kc = (tid & 1) * 32;
      int nr = n0 + n;
      if (md.perm) nr = ((nr & 255) < 128 ? 0 : 1024) + (nr >> 8) * 128 + (nr & 127);
      u16* dp = dst + (size_t)nr * md.K + k0 + kc;
#pragma unroll
      for (int g = 0; g < 4; ++g) {
        uint4 o;
        o.x = pk2(t[(kc + g * 8 + 0) * 257 + n], t[(kc + g * 8 + 1) * 257 + n]);
        o.y = pk2(t[(kc + g * 8 + 2) * 257 + n], t[(kc + g * 8 + 3) * 257 + n]);
        o.z = pk2(t[(kc + g * 8 + 4) * 257 + n], t[(kc + g * 8 + 5) * 257 + n]);
        o.w = pk2(t[(kc + g * 8 + 6) * 257 + n], t[(kc + g * 8 + 7) * 257 + n]);
        *(uint4*)(dp + g * 8) = o;
      }
    }
    __syncthreads();
  }
}

DI void pro_adaln(const Params& P, unsigned char* smem, int bid, int nblk) {
  float* sc = (float*)smem;
  float* red = sc + 5 * 1024;
  float* modw = (float*)(lws(P) + OFF_MOD);
  const int tid = ltid();
  for (int u = bid; u < 4 * 48; u += nblk) {
    const int li = u / 48, n0 = (u % 48) * 128;
    for (int e = tid; e < 5 * 1024; e += NT) {
      const int mi = e >> 10, k = e & 1023;
      const float v = mi < 4 ? P.c[mi * 1024 + k] : P.c_ctx[k];
      sc[e] = silu(v);
    }
    __syncthreads();
    const int nq = tid & 31, kg = tid >> 5;
    float acc[5][4];
#pragma unroll
    for (int a = 0; a < 5; ++a)
#pragma unroll
      for (int b = 0; b < 4; ++b) acc[a][b] = 0.f;
    const float* w = P.ada_w + (size_t)li * 1024 * 6144 + n0 + nq * 4;
    for (int kk = 0; kk < 64; ++kk) {
      const int k = kg * 64 + kk;
      const float4 wv = *(const float4*)(w + (size_t)k * 6144);
#pragma unroll
      for (int a = 0; a < 5; ++a) {
        const float s = sc[a * 1024 + k];
        acc[a][0] += s * wv.x; acc[a][1] += s * wv.y; acc[a][2] += s * wv.z; acc[a][3] += s * wv.w;
      }
    }
#pragma unroll
    for (int a = 0; a < 5; ++a)
#pragma unroll
      for (int b = 0; b < 4; ++b) red[(kg * 5 + a) * 128 + nq * 4 + b] = acc[a][b];
    __syncthreads();
    for (int e = tid; e < 5 * 128; e += NT) {
      const int a = e >> 7, n = e & 127;
      float s = P.ada_b[li * 6144 + n0 + n];
#pragma unroll
      for (int g = 0; g < 16; ++g) s += red[(g * 5 + a) * 128 + n];
      modw[(size_t)(li * 5 + a) * 6144 + n0 + n] = s;
    }
    __syncthreads();
  }
}

DI void pro_filter_mlp(const Params& P, int bid, int nblk) {
  const int lane = ltid() & 63, wv = ltid() >> 6;
  u16* h3 = (u16*)(lws(P) + OFF_H3);
  for (int task = bid * 8 + wv; task < 2 * KTL; task += nblk * 8) {
    const int j = task / KTL, row = task % KTL;
    const int L = row < SEQ ? SEQ : NCTX;
    const int l = row < SEQ ? row : row - SEQ;
    const float* w1 = P.hy_f_w1 + j * 33 * 64; const float* b1 = P.hy_f_b1 + j * 64;
    const float* w2 = P.hy_f_w2 + j * 64 * 64; const float* b2 = P.hy_f_b2 + j * 64;
    const float* w3 = P.hy_f_w3 + j * 64 * 64; const float* b3 = P.hy_f_b3 + j * 64;
    const float fr = P.hy_freq[j * 64 + lane];
    const float tl = (float)l / (float)(L - 1);
    const float w = 6.283185307179586f * (float)l / (float)L;
    float zf = 0.f;
    if (lane == 0) zf = tl;
    else if (lane <= 32) {
      const int bi = (lane - 1) & 15;
      const float f = 1e-4f + (float)bi * ((15.f - 1e-4f) / 15.f);
      const float a = f * w;
      zf = lane <= 16 ? cosf(a) : -sinf(a);
    }
    float acc = b1[lane];
#pragma unroll
    for (int k = 0; k < 33; ++k) acc += __int_as_float(__builtin_amdgcn_readlane(__float_as_int(zf), k)) * w1[k * 64 + lane];
    float h = sinf(fr * acc);
    acc = b2[lane];
#pragma unroll
    for (int k = 0; k < 64; ++k) acc += __int_as_float(__builtin_amdgcn_readlane(__float_as_int(h), k)) * w2[k * 64 + lane];
    h = sinf(fr * acc);
    acc = b3[lane];
#pragma unroll
    for (int k = 0; k < 64; ++k) acc += __int_as_float(__builtin_amdgcn_readlane(__float_as_int(h), k)) * w3[k * 64 + lane];
    h = sinf(fr * acc);
    h3[((size_t)j * KTL + row) * 64 + lane] = f2bf(h);
  }
}

DI void normmod_phase(const Params& P, int li, int which, int nrows, const float* xl, const float* xc, int bid, int nblk) {
  const int lane = ltid() & 63, wv = ltid() >> 6;
  u16* A = (u16*)(lws(P) + OFF_A);
  const float* g = (which ? P.norm2_g : P.norm1_g) + li * 1024;
  const float* modw = (const float*)(lws(P) + OFF_MOD) + (size_t)li * 5 * 6144;
  for (int row = (bid * 8 + wv) * 2; row < nrows; row += nblk * 16) {
    const float* xr = row < NL ? xl + (size_t)row * 1024 : xc + (size_t)(row - NL) * 1024;
    const float* md = modw + mod_index(row) * 6144 + (which ? 3 * 1024 : 0);
    float4 v0[4], v1[4];
#pragma unroll
    for (int j = 0; j < 4; ++j) { v0[j] = *(const float4*)(xr + j * 256 + lane * 4); v1[j] = *(const float4*)(xr + 1024 + j * 256 + lane * 4); }
    float s0 = 0.f, s1 = 0.f;
#pragma unroll
    for (int j = 0; j < 4; ++j) {
      s0 += v0[j].x * v0[j].x + v0[j].y * v0[j].y + v0[j].z * v0[j].z + v0[j].w * v0[j].w;
      s1 += v1[j].x * v1[j].x + v1[j].y * v1[j].y + v1[j].z * v1[j].z + v1[j].w * v1[j].w;
    }
    s0 = wave_sum(s0, lane); s1 = wave_sum(s1, lane);
    const float r0 = rsqrtf(s0 * (1.f / 1024.f) + EPS), r1 = rsqrtf(s1 * (1.f / 1024.f) + EPS);
#pragma unroll
    for (int j = 0; j < 4; ++j) {
      const int k = j * 256 + lane * 4;
      const float4 gg = *(const float4*)(g + k);
      const float4 sh = *(const float4*)(md + k);
      const float4 sc = *(const float4*)(md + 1024 + k);
      const float mx = gg.x * (1.f + sc.x), my = gg.y * (1.f + sc.y), mz = gg.z * (1.f + sc.z), mw = gg.w * (1.f + sc.w);
      uint2 o0, o1;
      o0.x = pk2(v0[j].x * r0 * mx + sh.x, v0[j].y * r0 * my + sh.y); o0.y = pk2(v0[j].z * r0 * mz + sh.z, v0[j].w * r0 * mw + sh.w);
      o1.x = pk2(v1[j].x * r1 * mx + sh.x, v1[j].y * r1 * my + sh.y); o1.y = pk2(v1[j].z * r1 * mz + sh.z, v1[j].w * r1 * mw + sh.w);
      *(uint2*)(A + (size_t)row * 1024 + k) = o0;
      *(uint2*)(A + (size_t)(row + 1) * 1024 + k) = o1;
    }
  }
}

DI void final_norm_phase(const Params& P, int bid, int nblk) {
  const int lane = ltid() & 63, wv = ltid() >> 6;
  for (int row = (bid * 8 + wv) * 2; row < NL; row += nblk * 16) {
    float* xr = P.out + (size_t)row * 1024;
    float4 v0[4], v1[4];
#pragma unroll
    for (int j = 0; j < 4; ++j) { v0[j] = *(const float4*)(xr + j * 256 + lane * 4); v1[j] = *(const float4*)(xr + 1024 + j * 256 + lane * 4); }
    float s0 = 0.f, s1 = 0.f;
#pragma unroll
    for (int j = 0; j < 4; ++j) {
      s0 += v0[j].x * v0[j].x + v0[j].y * v0[j].y + v0[j].z * v0[j].z + v0[j].w * v0[j].w;
      s1 += v1[j].x * v1[j].x + v1[j].y * v1[j].y + v1[j].z * v1[j].z + v1[j].w * v1[j].w;
    }
    s0 = wave_sum(s0, lane); s1 = wave_sum(s1, lane);
    const float r0 = rsqrtf(s0 * (1.f / 1024.f) + EPS), r1 = rsqrtf(s1 * (1.f / 1024.f) + EPS);
#pragma unroll
    for (int j = 0; j < 4; ++j) {
      const int k = j * 256 + lane * 4;
      const float4 gg = *(const float4*)(P.final_g + k);
      float4 o0, o1;
      o0.x = v0[j].x * r0 * gg.x; o0.y = v0[j].y * r0 * gg.y; o0.z = v0[j].z * r0 * gg.z; o0.w = v0[j].w * r0 * gg.w;
      o1.x = v1[j].x * r1 * gg.x; o1.y = v1[j].y * r1 * gg.y; o1.z = v1[j].z * r1 * gg.z; o1.w = v1[j].w * r1 * gg.w;
      *(float4*)(xr + k) = o0;
      *(float4*)(xr + 1024 + k) = o1;
    }
  }
}

enum { EPI_HYIN = 0, EPI_FILT, EPI_RES, EPI_MLP1, EPI_GLAIN, EPI_MLADN, EPI_MLAQ, EPI_MLAKV };
struct EpiArgs {
  const float* bias;
  const float* gate;
  int gofs;
  const float* xsl; const float* xsc;
  float* xdl; float* xdc;
  u16* o0; u16* o1;
  int mrow0;
  int L;
};

constexpr int GS = 72;

template <int EPI>
DI void epi_tile(const EpiArgs& ea, const f32x16& acc, int mb, int nb, int lane) {
  const int r = lane & 31, h = lane >> 5;
  if constexpr (EPI == EPI_HYIN) {
    u16* base = ea.o0 + (size_t)nb * NTOK + mb;
    const float* bp = ea.bias + nb;
    const int voff = 4 * h * NTOK + r;
#pragma unroll
    for (int i = 0; i < 16; ++i) {
      const int rc = (i & 3) + 8 * (i >> 2);
      base[rc * NTOK + voff] = f2bf(acc[i] + bp[rc + 4 * h]);
    }
  } else if constexpr (EPI == EPI_FILT) {
    const int l = mb + r;
    const float t = (float)l / (float)(ea.L - 1);
    u16* base = ea.o0 + (size_t)nb * KTL + ea.mrow0 + mb;
    const int voff = 4 * h * KTL + r;
#pragma unroll
    for (int i = 0; i < 16; ++i) {
      const int rc = (i & 3) + 8 * (i >> 2);
      const int d = (nb + rc + 4 * h) & 1023;
      const float mind = -3.0701134573253945f, maxd = -15.350567286626972f;
      const float delta = mind + (float)d * ((maxd - mind) / 1023.f);
      base[rc * KTL + voff] = f2bf(acc[i] * __expf(-t * fabsf(delta)));
    }
  } else if constexpr (EPI == EPI_RES) {
    const int n = nb + r;
    const float bz = ea.bias ? ea.bias[n] : 0.f;
    const float gt = ea.gate[mod_index(mb) * 6144 + ea.gofs + n];
    const float* xs; float* xd;
    if (mb < NL) { xs = ea.xsl + (size_t)mb * 1024 + nb; xd = ea.xdl + (size_t)mb * 1024 + nb; }
    else { xs = ea.xsc + (size_t)(mb - NL) * 1024 + nb; xd = ea.xdc + (size_t)(mb - NL) * 1024 + nb; }
    const int voff = 4 * h * 1024 + r;
#pragma unroll
    for (int i = 0; i < 16; ++i) {
      const int rc = (i & 3) + 8 * (i >> 2);
      xd[rc * 1024 + voff] = xs[rc * 1024 + voff] + gt * (acc[i] + bz);
    }
  } else if constexpr (EPI == EPI_MLP1) {
    u16* base = ea.o0 + (size_t)mb * HID + nb;
    const int voff = 4 * h * HID + r;
#pragma unroll
    for (int i = 0; i < 16; ++i) {
      const int rc = (i & 3) + 8 * (i >> 2);
      const float v = fmaxf(acc[i], 0.f);
      base[rc * HID + voff] = f2bf(v * v);
    }
  } else if constexpr (EPI == EPI_GLAIN) {
    if (nb < GLA_N) {
      u16* base = ea.o0 + (size_t)mb * GLA_N + nb;
      const int voff = 4 * h * GLA_N + r;
#pragma unroll
      for (int i = 0; i < 16; ++i) {
        const int rc = (i & 3) + 8 * (i >> 2);
        base[rc * GLA_N + voff] = f2bf(acc[i]);
      }
    }
  } else if constexpr (EPI == EPI_MLADN) {
    u16* base = ea.o0 + (size_t)mb * MLA_DNP + nb;
    const int voff = 4 * h * MLA_DNP + r;
#pragma unroll
    for (int i = 0; i < 16; ++i) {
      const int rc = (i & 3) + 8 * (i >> 2);
      base[rc * MLA_DNP + voff] = f2bf(acc[i]);
    }
  } else if constexpr (EPI == EPI_MLAQ) {
    const int n = nb + r;
    const int hd = n / 192, c = n % 192;
    const float qs = 0.07216878364870322f * 1.4426950408889634f;
    const bool isr = c >= 128;
    const int cc = c - 128;
    const int jj = cc & 15;
    const bool first = (cc & 31) < 16;
    const float invf = __expf(-(float)jj * (9.210340371976184f / 16.f));
#pragma unroll
    for (int i = 0; i < 16; ++i) {
      const int m = mb + crow(i, h);
      const int b = m >> 13, l = m & 8191;
      float v = acc[i];
      const float pv = shx(v, 16, lane);
      if (isr) {
        const float pos = (float)((cc < 32) ? (l >> 6) : (l & 63));
        const float ang = pos * invf;
        float sn, cs;
        __sincosf(ang, &sn, &cs);
        v = first ? (v * cs - pv * sn) : (pv * sn + v * cs);
      }
      ea.o0[((size_t)(b * 8 + hd) * SEQ + l) * 192 + c] = f2bf(v * qs);
    }
  } else if constexpr (EPI == EPI_MLAKV) {
    const int n = nb + r;
    const int hd = n >> 8, c = n & 255;
#pragma unroll
    for (int g = 0; g < 4; ++g) {
      const int m = mb + 8 * g + 4 * h;
      int b, key;
      if (m < NL) { b = m >> 13; key = NCTX + (m & 8191); } else { b = (m - NL) >> 8; key = (m - NL) & 255; }
      if (c < 128) {
#pragma unroll
        for (int q = 0; q < 4; ++q) ea.o0[((size_t)(b * 8 + hd) * NKEY + key + q) * 128 + c] = f2bf(acc[4 * g + q]);
      } else {
        u16x4 o;
#pragma unroll
        for (int q = 0; q < 4; ++q) o[q] = f2bf(acc[4 * g + q]);
        *(u16x4*)(ea.o1 + ((size_t)(b * 8 + hd) * 128 + (c - 128)) * NKEY + key) = o;
      }
    }
  }
}

template <int EPI>
DI void gemm_phase(const u16* __restrict__ A, int lda, const u16* __restrict__ WT, int K, int mtiles, int ntiles,
                   const EpiArgs& ea, unsigned char* smem, int bid, int nblk) {
  constexpr bool SWAP = (EPI == EPI_HYIN || EPI == EPI_FILT);
  u16* As = (u16*)smem;
  u16* Bs = As + 2 * 256 * GS;
  const int tid = ltid(), lane = tid & 63, wv = __builtin_amdgcn_readfirstlane(tid >> 6);
  const int wm = wv & 1, wn = wv >> 1;
  const int r = lane & 31, h = lane >> 5;
  const int nk = K / 64;
  const int lrow = tid >> 3, lcol = (tid & 7) * 8;
  for (int tile = bid; tile < mtiles * ntiles; tile += nblk) {
    const int mt = tile / ntiles, nt = tile % ntiles;
    const int m0 = mt * 256, n0 = nt * 256;
    const u16* Ag = A + (size_t)(m0 + lrow) * lda + lcol;
    const u16* Bg = WT + (size_t)(n0 + lrow) * K + lcol;
    f32x16 c00, c01, c10, c11, c20, c21, c30, c31;
#pragma unroll
    for (int q = 0; q < 16; ++q) { c00[q] = 0.f; c01[q] = 0.f; c10[q] = 0.f; c11[q] = 0.f; c20[q] = 0.f; c21[q] = 0.f; c30[q] = 0.f; c31[q] = 0.f; }
    uint4 r0, r1, r2, r3;
#define G_LDA(k0_)                                             \
    r0 = *(const uint4*)(Ag + (k0_));                              \
    r1 = *(const uint4*)(Ag + (size_t)64 * lda + (k0_));           \
    r2 = *(const uint4*)(Ag + (size_t)128 * lda + (k0_));          \
    r3 = *(const uint4*)(Ag + (size_t)192 * lda + (k0_));
#define G_LDB(k0_)                                             \
    r0 = *(const uint4*)(Bg + (k0_));                              \
    r1 = *(const uint4*)(Bg + (size_t)64 * K + (k0_));             \
    r2 = *(const uint4*)(Bg + (size_t)128 * K + (k0_));            \
    r3 = *(const uint4*)(Bg + (size_t)192 * K + (k0_));
#define G_STX(base_, buf_)                                                  \
    *(uint4*)(base_ + (buf_) * 256 * GS + (lrow) * GS + lcol) = r0;             \
    *(uint4*)(base_ + (buf_) * 256 * GS + (lrow + 64) * GS + lcol) = r1;        \
    *(uint4*)(base_ + (buf_) * 256 * GS + (lrow + 128) * GS + lcol) = r2;       \
    *(uint4*)(base_ + (buf_) * 256 * GS + (lrow + 192) * GS + lcol) = r3;
    __syncthreads();
    G_LDB(0)
    G_STX(Bs, 0)
    G_LDA(0)
    G_STX(As, 0)
    if (nk > 1) { G_LDB(64) }
    __syncthreads();
#pragma unroll 1
    for (int kt = 0; kt < nk; ++kt) {
      const int cur = kt & 1;
      if (kt + 1 < nk) { G_STX(Bs, cur ^ 1) G_LDA((kt + 1) * 64) }
      const u16* as = As + cur * 256 * GS + (wm * 128 + r) * GS + h * 8;
      const u16* bs = Bs + cur * 256 * GS + (wn * 64 + r) * GS + h * 8;
#pragma unroll
      for (int kk = 0; kk < 4; ++kk) {
        const bf16x8 a0 = *(const bf16x8*)(as + kk * 16);
        const bf16x8 a1 = *(const bf16x8*)(as + 32 * GS + kk * 16);
        const bf16x8 a2 = *(const bf16x8*)(as + 64 * GS + kk * 16);
        const bf16x8 a3 = *(const bf16x8*)(as + 96 * GS + kk * 16);
        const bf16x8 b0 = *(const bf16x8*)(bs + kk * 16);
        const bf16x8 b1 = *(const bf16x8*)(bs + 32 * GS + kk * 16);
        if constexpr (SWAP) {
          c00 = MFMA32(b0, a0, c00); c01 = MFMA32(b1, a0, c01); c10 = MFMA32(b0, a1, c10); c11 = MFMA32(b1, a1, c11);
          c20 = MFMA32(b0, a2, c20); c21 = MFMA32(b1, a2, c21); c30 = MFMA32(b0, a3, c30); c31 = MFMA32(b1, a3, c31);
        } else {
          c00 = MFMA32(a0, b0, c00); c01 = MFMA32(a0, b1, c01); c10 = MFMA32(a1, b0, c10); c11 = MFMA32(a1, b1, c11);
          c20 = MFMA32(a2, b0, c20); c21 = MFMA32(a2, b1, c21); c30 = MFMA32(a3, b0, c30); c31 = MFMA32(a3, b1, c31);
        }
        if (kk == 1 && kt + 1 < nk) {
          G_STX(As, cur ^ 1)
          if (kt + 2 < nk) { G_LDB((kt + 2) * 64) }
        }
      }
      __syncthreads();
    }
    const int mb = m0 + wm * 128, nb = n0 + wn * 64;
#define SB __builtin_amdgcn_sched_barrier(0);
    SB epi_tile<EPI>(ea, c00, mb, nb, lane);       SB epi_tile<EPI>(ea, c01, mb, nb + 32, lane);
    SB epi_tile<EPI>(ea, c10, mb + 32, nb, lane);  SB epi_tile<EPI>(ea, c11, mb + 32, nb + 32, lane);
    SB epi_tile<EPI>(ea, c20, mb + 64, nb, lane);  SB epi_tile<EPI>(ea, c21, mb + 64, nb + 32, lane);
    SB epi_tile<EPI>(ea, c30, mb + 96, nb, lane);  SB epi_tile<EPI>(ea, c31, mb + 96, nb + 32, lane); SB
  }
}

DI float2 cmul(float2 a, float2 b) { return make_float2(a.x * b.x - a.y * b.y, a.x * b.y + a.y * b.x); }
DI float2 cmulc(float2 a, float2 b) { return make_float2(a.x * b.x + a.y * b.y, a.y * b.x - a.x * b.y); }
DI float2 twid(float rev) { return make_float2(__builtin_amdgcn_cosf(rev), __builtin_amdgcn_sinf(rev)); }
typedef float f2r_t __attribute__((ext_vector_type(2)));
DI float2 cmulp(float2 y, float2 w) {
  f2r_t yy, ww, t, r; yy.x = y.x; yy.y = y.y; ww.x = w.x; ww.y = w.y;
  asm volatile("s_nop 0\n\tv_pk_mul_f32 %0, %2, %3 op_sel_hi:[1,0]\n\tv_pk_fma_f32 %1, %2, %3, %0 op_sel:[1,1,0] op_sel_hi:[0,1,1] neg_lo:[1,0,0]"
               : "=&v"(t), "=&v"(r) : "v"(yy), "v"(ww));
  return make_float2(r.x, r.y);
}
DI float2 cmulcp(float2 y, float2 w) {
  f2r_t yy, ww, t, r; yy.x = y.x; yy.y = y.y; ww.x = w.x; ww.y = w.y;
  asm volatile("s_nop 0\n\tv_pk_mul_f32 %0, %2, %3 op_sel_hi:[1,0]\n\tv_pk_fma_f32 %1, %2, %3, %0 op_sel:[1,1,0] op_sel_hi:[0,1,1] neg_hi:[1,0,0]"
               : "=&v"(t), "=&v"(r) : "v"(yy), "v"(ww));
  return make_float2(r.x, r.y);
}

#define FWD_BFLY(a0, a1, a2, a3, y0, y1, y2, y3)                                  \
  {                                                                               \
    const float2 t0 = make_float2(a0.x + a2.x, a0.y + a2.y);                      \
    const float2 t1 = make_float2(a0.x - a2.x, a0.y - a2.y);                      \
    const float2 t2 = make_float2(a1.x + a3.x, a1.y + a3.y);                      \
    const float2 t3 = make_float2(a1.y - a3.y, -(a1.x - a3.x));                   \
    y0 = make_float2(t0.x + t2.x, t0.y + t2.y);                                   \
    y1 = make_float2(t1.x + t3.x, t1.y + t3.y);                                   \
    y2 = make_float2(t0.x - t2.x, t0.y - t2.y);                                   \
    y3 = make_float2(t1.x - t3.x, t1.y - t3.y);                                   \
  }
#define INV_BFLY(b0, b1, b2, b3, y0, y1, y2, y3)                                  \
  {                                                                               \
    const float2 t0 = make_float2(b0.x + b2.x, b0.y + b2.y);                      \
    const float2 t1 = make_float2(b0.x - b2.x, b0.y - b2.y);                      \
    const float2 t2 = make_float2(b1.x + b3.x, b1.y + b3.y);                      \
    const float2 t3 = make_float2(-(b1.y - b3.y), b1.x - b3.x);                   \
    y0 = make_float2(t0.x + t2.x, t0.y + t2.y);                                   \
    y1 = make_float2(t1.x + t3.x, t1.y + t3.y);                                   \
    y2 = make_float2(t0.x - t2.x, t0.y - t2.y);                                   \
    y3 = make_float2(t1.x - t3.x, t1.y - t3.y);                                   \
  }

DI int PH(int i) { return i + ((i >> 6) << 2); }
constexpr int FFT_LDS_ELEMS = 16384 + 1024;
template <int QA>
DI void r16_fwd(float2 (&x)[16], int rp) {
  constexpr int QB = QA / 4;
#pragma unroll
  for (int m2 = 0; m2 < 4; ++m2) {
    float2 y0, y1, y2, y3;
    FWD_BFLY(x[0 + m2], x[4 + m2], x[8 + m2], x[12 + m2], y0, y1, y2, y3);
    const float2 w1 = twid(-(float)(m2 * QB + rp) * (1.f / (4.f * QA)));
    const float2 w2 = cmulp(w1, w1), w3 = cmulp(w2, w1);
    x[0 + m2] = y0; x[4 + m2] = cmulp(y1, w1); x[8 + m2] = cmulp(y2, w2); x[12 + m2] = cmulp(y3, w3);
  }
  const float2 v1 = twid(-(float)rp * (1.f / (4.f * QB)));
  const float2 v2 = cmulp(v1, v1), v3 = cmulp(v2, v1);
#pragma unroll
  for (int k1 = 0; k1 < 4; ++k1) {
    float2 y0, y1, y2, y3;
    FWD_BFLY(x[4 * k1 + 0], x[4 * k1 + 1], x[4 * k1 + 2], x[4 * k1 + 3], y0, y1, y2, y3);
    x[4 * k1 + 0] = y0; x[4 * k1 + 1] = cmulp(y1, v1); x[4 * k1 + 2] = cmulp(y2, v2); x[4 * k1 + 3] = cmulp(y3, v3);
  }
}
template <int QA>
DI void r16_inv(float2 (&x)[16], int rp) {
  constexpr int QB = QA / 4;
  const float2 v1 = twid(-(float)rp * (1.f / (4.f * QB)));
  const float2 v2 = cmulp(v1, v1), v3 = cmulp(v2, v1);
#pragma unroll
  for (int k1 = 0; k1 < 4; ++k1) {
    const float2 b0 = x[4 * k1 + 0], b1 = cmulcp(x[4 * k1 + 1], v1), b2 = cmulcp(x[4 * k1 + 2], v2), b3 = cmulcp(x[4 * k1 + 3], v3);
    float2 y0, y1, y2, y3;
    INV_BFLY(b0, b1, b2, b3, y0, y1, y2, y3);
    x[4 * k1 + 0] = y0; x[4 * k1 + 1] = y1; x[4 * k1 + 2] = y2; x[4 * k1 + 3] = y3;
  }
#pragma unroll
  for (int m2 = 0; m2 < 4; ++m2) {
    const float2 w1 = twid(-(float)(m2 * QB + rp) * (1.f / (4.f * QA)));
    const float2 w2 = cmulp(w1, w1), w3 = cmulp(w2, w1);
    const float2 b0 = x[0 + m2], b1 = cmulcp(x[4 + m2], w1), b2 = cmulcp(x[8 + m2], w2), b3 = cmulcp(x[12 + m2], w3);
    float2 y0, y1, y2, y3;
    INV_BFLY(b0, b1, b2, b3, y0, y1, y2, y3);
    x[0 + m2] = y0; x[4 + m2] = y1; x[8 + m2] = y2; x[12 + m2] = y3;
  }
}
template <int QA, bool INV>
DI void r16_pass(float2* buf, int tid) {
  constexpr int QB = QA / 4;
  asm volatile("" : "+v"(tid));
#pragma unroll
  for (int it = 0; it < 2; ++it) {
    const int U = tid + it * NT, rp = U & (QB - 1), ib = (U / QB) * (4 * QA) + rp;
    float2 x[16];
#pragma unroll
    for (int e = 0; e < 16; ++e) x[e] = buf[PH(ib + (e >> 2) * QA + (e & 3) * QB)];
    if (INV) r16_inv<QA>(x, rp); else r16_fwd<QA>(x, rp);
#pragma unroll
    for (int e = 0; e < 16; ++e) buf[PH(ib + (e >> 2) * QA + (e & 3) * QB)] = x[e];
  }
  __syncthreads();
}
DI float sconv(const u16* z, int t, int L, float w0, float w1, float w2, float cb) {
  const float c = bf2f(z[t]);
  const float a = bf2f(z[t > 0 ? t - 1 : 0]);
  const float b = bf2f(z[t < L - 1 ? t + 1 : L - 1]);
  return (t > 0 ? w0 : 0.f) * a + w1 * c + (t < L - 1 ? w2 : 0.f) * b + cb;
}
DI float block_sum(float v, float* red, int tid) {
  v = wave_sum(v, tid & 63);
  __syncthreads();
  if ((tid & 63) == 0) red[tid >> 6] = v;
  __syncthreads();
  float s = 0.f;
#pragma unroll
  for (int i = 0; i < 8; ++i) s += red[i];
  return s;
}

DI void fft_middle(float2* buf, const float2* Kg, int tid) {
#pragma unroll 4
  for (int j = tid; j < 4096; j += NT) {
    float4* p4 = (float4*)(buf + PH(4 * j));
    const float4* k4 = (const float4*)(Kg + 4 * j);
    const float4 u0 = p4[0], u1 = p4[1];
    const float4 k0 = k4[0], k1 = k4[1];
    const float2 a0 = make_float2(u0.x, u0.y), a1 = make_float2(u0.z, u0.w), a2 = make_float2(u1.x, u1.y), a3 = make_float2(u1.z, u1.w);
    float2 y0, y1, y2, y3;
    FWD_BFLY(a0, a1, a2, a3, y0, y1, y2, y3);
    const float2 b0 = cmulp(y0, make_float2(k0.x, k0.y)), b1 = cmulp(y1, make_float2(k0.z, k0.w));
    const float2 b2 = cmulp(y2, make_float2(k1.x, k1.y)), b3 = cmulp(y3, make_float2(k1.z, k1.w));
    float2 z0, z1, z2, z3;
    INV_BFLY(b0, b1, b2, b3, z0, z1, z2, z3);
    p4[0] = make_float4(z0.x, z0.y, z1.x, z1.y);
    p4[1] = make_float4(z2.x, z2.y, z3.x, z3.y);
  }
  __syncthreads();
}
DI void fft_filter_last(const float2* buf, float2* Kg, int tid, float scl, float skp) {
#pragma unroll 4
  for (int j = tid; j < 4096; j += NT) {
    const float4* p4 = (const float4*)(buf + PH(4 * j));
    float4* k4 = (float4*)(Kg + 4 * j);
    const float4 u0 = p4[0], u1 = p4[1];
    const float2 a0 = make_float2(u0.x, u0.y), a1 = make_float2(u0.z, u0.w), a2 = make_float2(u1.x, u1.y), a3 = make_float2(u1.z, u1.w);
    float2 y0, y1, y2, y3;
    FWD_BFLY(a0, a1, a2, a3, y0, y1, y2, y3);
    k4[0] = make_float4(y0.x * scl + skp, y0.y * scl, y1.x * scl + skp, y1.y * scl);
    k4[1] = make_float4(y2.x * scl + skp, y2.y * scl, y3.x * scl + skp, y3.y * scl);
  }
}

DI void hyena_lat_unit(const Params& P, int jl, int d, unsigned char* smem) {
  float2* buf = (float2*)smem;
  float* red = (float*)(smem + (size_t)FFT_LDS_ELEMS * 8);
  const int tid = ltid();
  const u16* zT = (const u16*)(lws(P) + OFF_BIG + B_ZT);
  const u16* kT = (const u16*)(lws(P) + OFF_BIG + B_KT);
  u16* yT = (u16*)(lws(P) + OFF_BIG + B_YT);
  float2* Kg = (float2*)(lws(P) + OFF_A) + (size_t)blockIdx.x * 32768;
#pragma unroll 1
  for (int n = 0; n < 2; ++n) {
    const u16* kf = kT + (size_t)((n * 2 + 0) * 1024 + d) * KTL;
    const u16* kb = kT + (size_t)((n * 2 + 1) * 1024 + d) * KTL;
    float s = 0.f;
#pragma unroll 4
    for (int t = tid; t < SEQ; t += NT) {
      const float f = bf2f(kf[t]);
      const float graw = bf2f(kb[t]);
      const float g = t >= 1 ? graw : 0.f;
      buf[PH(t)] = make_float2(f, 0.f);
      buf[PH(t >= 1 ? 16384 - t : SEQ)] = make_float2(g, 0.f);
      s += fabsf(f) + fabsf(g);
    }
    const float S = block_sum(s, red, tid);
    r16_pass<4096, false>(buf, tid); r16_pass<256, false>(buf, tid); r16_pass<16, false>(buf, tid);
    const float scl = 1.f / (S * 16384.f);
    const float skp = P.hy_bias[(jl * 2 + n) * 1024 + d] * (1.f / 16384.f);
    fft_filter_last(buf, Kg + n * 16384, tid, scl, skp);
    __syncthreads();
  }
  const float* cw = P.hy_conv_w + (size_t)jl * 3 * 3072;
  const float* cbp = P.hy_conv_b + (size_t)jl * 3072;
  const float w00 = cw[d], w01 = cw[3072 + d], w02 = cw[2 * 3072 + d], cb0 = cbp[d];
  const float w10 = cw[1024 + d], w11 = cw[3072 + 1024 + d], w12 = cw[2 * 3072 + 1024 + d], cb1 = cbp[1024 + d];
  const float w20 = cw[2048 + d], w21 = cw[3072 + 2048 + d], w22 = cw[2 * 3072 + 2048 + d], cb2 = cbp[2048 + d];
  for (int pair = 0; pair < 2; ++pair) {
    const u16* za0 = zT + (size_t)d * NTOK + (size_t)(2 * pair) * SEQ;
    const u16* za1 = za0 + SEQ;
    const u16* zb0 = zT + (size_t)(1024 + d) * NTOK + (size_t)(2 * pair) * SEQ;
    const u16* zb1 = zb0 + SEQ;
    const u16* zc0 = zT + (size_t)(2048 + d) * NTOK + (size_t)(2 * pair) * SEQ;
    const u16* zc1 = zc0 + SEQ;
#pragma unroll 1
    for (int it = 0; it < 2; ++it) {
      const int rp = tid + it * NT;
      float2 x[16];
#pragma unroll
      for (int e = 0; e < 8; ++e) {
        const int t = (e >> 2) * 4096 + (e & 3) * 1024 + rp;
        x[e] = make_float2(sconv(za0, t, SEQ, w00, w01, w02, cb0), sconv(za1, t, SEQ, w00, w01, w02, cb0));
        if ((e & 3) == 3) __builtin_amdgcn_sched_barrier(0);
      }
#pragma unroll
      for (int e = 8; e < 16; ++e) x[e] = make_float2(0.f, 0.f);
      r16_fwd<4096>(x, rp);
#pragma unroll
      for (int e = 0; e < 16; ++e) buf[PH(rp + (e >> 2) * 4096 + (e & 3) * 1024)] = x[e];
    }
    __syncthreads();
    r16_pass<256, false>(buf, tid); r16_pass<16, false>(buf, tid);
    fft_middle(buf, Kg, tid);
    r16_pass<16, true>(buf, tid); r16_pass<256, true>(buf, tid);
#pragma unroll 1
    for (int it = 0; it < 2; ++it) {
      const int rp = tid + it * NT;
      float2 x[16];
#pragma unroll
      for (int e = 0; e < 16; ++e) x[e] = buf[PH(rp + (e >> 2) * 4096 + (e & 3) * 1024)];
      r16_inv<4096>(x, rp);
#pragma unroll
      for (int e = 0; e < 8; ++e) {
        const int t = (e >> 2) * 4096 + (e & 3) * 1024 + rp;
        const float g0 = sconv(zb0, t, SEQ, w10, w11, w12, cb1), g1 = sconv(zb1, t, SEQ, w10, w11, w12, cb1);
        buf[PH(t)] = make_float2(x[e].x * g0, x[e].y * g1);
        if ((e & 3) == 3) __builtin_amdgcn_sched_barrier(0);
      }
      const float z = lzero();
#pragma unroll
      for (int e = 8; e < 16; ++e) buf[PH(rp + (e >> 2) * 4096 + (e & 3) * 1024)] = make_float2(z, z);
    }
    __syncthreads();
    r16_pass<4096, false>(buf, tid); r16_pass<256, false>(buf, tid); r16_pass<16, false>(buf, tid);
    fft_middle(buf, Kg + 16384, tid);
    r16_pass<16, true>(buf, tid); r16_pass<256, true>(buf, tid);
#pragma unroll 1
    for (int it = 0; it < 2; ++it) {
      const int rp = tid + it * NT;
      float2 x[16];
#pragma unroll
      for (int e = 0; e < 16; ++e) x[e] = buf[PH(rp + (e >> 2) * 4096 + (e & 3) * 1024)];
      r16_inv<4096>(x, rp);
      u16* yo = yT + (size_t)d * NTOK + (size_t)(2 * pair) * SEQ;
#pragma unroll
      for (int e = 0; e < 8; ++e) {
        const int t = (e >> 2) * 4096 + (e & 3) * 1024 + rp;
        const float g0 = sconv(zc0, t, SEQ, w20, w21, w22, cb2), g1 = sconv(zc1, t, SEQ, w20, w21, w22, cb2);
        yo[t] = f2bf(x[e].x * g0); yo[SEQ + t] = f2bf(x[e].y * g1);
        if ((e & 3) == 3) __builtin_amdgcn_sched_barrier(0);
      }
    }
    __syncthreads();
  }
}

DI void hyena_ctx_unit(const Params& P, int jl, int d, unsigned char* smem) {
  float* kk = (float*)smem;
  float* ya = kk + 1024;
  float* yb = ya + 1024;
  float* red = yb + 1024;
  const int tid = ltid();
  const u16* zT = (const u16*)(lws(P) + OFF_BIG + B_ZT);
  const u16* kT = (const u16*)(lws(P) + OFF_BIG + B_KT);
  u16* yT = (u16*)(lws(P) + OFF_BIG + B_YT);
  const float* cw = P.hy_conv_w + (size_t)jl * 3 * 3072;
  const float* cbp = P.hy_conv_b + (size_t)jl * 3072;
#pragma unroll
  for (int n = 0; n < 2; ++n) {
    const u16* kf = kT + (size_t)((n * 2 + 0) * 1024 + d) * KTL + SEQ;
    const u16* kb = kT + (size_t)((n * 2 + 1) * 1024 + d) * KTL + SEQ;
    float s = 0.f, f = 0.f, g = 0.f;
    if (tid < 256) { f = bf2f(kf[tid]); s = fabsf(f); }
    else if (tid > 256) { g = bf2f(kb[tid - 256]); s = fabsf(g); }
    const float S = block_sum(s, red, tid);
    if (tid < 256) kk[n * 512 + 256 + tid] = f / S;
    else if (tid > 256) kk[n * 512 + 256 - (tid - 256)] = g / S;
    else kk[n * 512 + 0] = 0.f;
  }
  for (int e = tid; e < 1024; e += NT) {
    const int b = e >> 8, t = e & 255;
    const u16* z0 = zT + (size_t)d * NTOK + NL + b * 256;
    ya[e] = sconv(z0, t, NCTX, cw[d], cw[3072 + d], cw[2 * 3072 + d], cbp[d]);
  }
  __syncthreads();
#pragma unroll
  for (int n = 0; n < 2; ++n) {
    const float* src = n == 0 ? ya : yb;
    float* dst = n == 0 ? yb : ya;
    const int ch = (n + 1) * 1024 + d;
    const float skp = P.hy_bias[(jl * 2 + n) * 1024 + d];
    {
      const int t = tid & 255, bh = tid >> 8;
      const float* kp = kk + n * 512 + 256 + t;
      const float* s0 = src + (2 * bh) * 256;
      const float* s1 = s0 + 256;
      float acc0 = 0.f, acc1 = 0.f;
#pragma unroll 4
      for (int s = 0; s < 256; s += 4) {
        const float4 x0 = *(const float4*)(s0 + s), x1 = *(const float4*)(s1 + s);
        const float k0 = kp[-s], k1 = kp[-s - 1], k2 = kp[-s - 2], k3 = kp[-s - 3];
        acc0 += k0 * x0.x + k1 * x0.y + k2 * x0.z + k3 * x0.w;
        acc1 += k0 * x1.x + k1 * x1.y + k2 * x1.z + k3 * x1.w;
      }
#pragma unroll
      for (int q = 0; q < 2; ++q) {
        const int b = 2 * bh + q, e = b * 256 + t;
        const float acc = (q == 0 ? acc0 : acc1) + skp * src[e];
        const u16* zg = zT + (size_t)ch * NTOK + NL + b * 256;
        const float gate = sconv(zg, t, NCTX, cw[ch], cw[3072 + ch], cw[2 * 3072 + ch], cbp[ch]);
        const float o = acc * gate;
        if (n == 0) dst[e] = o;
        else yT[(size_t)d * NTOK + NL + e] = f2bf(o);
      }
    }
    __syncthreads();
  }
}

DI void hyena_conv_phase(const Params& P, int jl, bool with_ctx, unsigned char* smem, int bid, int nblk) {
  for (int u = bid; u < 1024; u += nblk) hyena_lat_unit(P, jl, u, smem);
  if (with_ctx) {
    __syncthreads();
    for (int u = bid; u < 1024; u += nblk) hyena_ctx_unit(P, jl, u, smem);
  }
}

DI void transpose_phase(const Params& P, int ncols, unsigned char* smem, int bid, int nblk) {
  u16* t = (u16*)smem;
  const u16* yT = (const u16*)(lws(P) + OFF_BIG + B_YT);
  u16* A = (u16*)(lws(P) + OFF_A);
  const int tid = ltid();
  const int tcols = ncols / 64;
  for (int tile = bid; tile < 16 * tcols; tile += nblk) {
    const int d0 = (tile / tcols) * 64, m0 = (tile % tcols) * 64;
    {
      const int rr = tid >> 3, ch = tid & 7;
      *(uint4*)(t + rr * 72 + ch * 8) = *(const uint4*)(yT + (size_t)(d0 + rr) * NTOK + m0 + ch * 8);
    }
    __syncthreads();
    {
      const int m = tid >> 3, dc = (tid & 7) * 8;
      u16x8 o;
#pragma unroll
      for (int j = 0; j < 8; ++j) o[j] = t[(dc + j) * 72 + m];
      *(u16x8*)(A + (size_t)(m0 + m) * 1024 + d0 + dc) = o;
    }
    __syncthreads();
  }
}

DI float logsigmoid(float x) { return fminf(x, 0.f) - __logf(1.f + __expf(-fabsf(x))); }

DI void gla_prep_phase(const Params& P, unsigned char* smem, int bid, int nblk) {
  u16* qraw = (u16*)smem;
  u16* kraw = qraw + 64 * 136;
  u16* vt = kraw + 64 * 136;
  u16* qt = vt + 256 * 72;
  u16* kt = qt + 64 * 136;
  u16* ps = kt + 64 * 136;
  float* rs = (float*)(ps + 64 * 72);
  float* segt = rs + 2 * 64 * 16;
  const int tid = ltid(), lane = tid & 63, wv = tid >> 6;
  const int r = lane & 31, h = lane >> 5;
  u16* Z = (u16*)(lws(P) + OFF_BIG + B_GZ);
  u16* G2 = (u16*)(lws(P) + OFF_BIG + B_G2);
  float* DEC = (float*)(lws(P) + OFF_BIG + B_DEC);
  for (int u = bid; u < 528 * 4; u += nblk) {
    const int c = u >> 2, hd = u & 3;
    const int row0 = c < 512 ? c * 64 : NL + (c - 512) * 64;
    u16* Zr = Z + (size_t)row0 * GLA_N;
    __syncthreads();
    {
      const int rr0 = tid >> 4, cc0 = (tid & 15) * 8;
      *(uint4*)(qraw + rr0 * 136 + cc0) = *(const uint4*)(Zr + (size_t)rr0 * GLA_N + hd * 128 + cc0);
      *(uint4*)(qraw + (rr0 + 32) * 136 + cc0) = *(const uint4*)(Zr + (size_t)(rr0 + 32) * GLA_N + hd * 128 + cc0);
      *(uint4*)(kraw + rr0 * 136 + cc0) = *(const uint4*)(Zr + (size_t)rr0 * GLA_N + 512 + hd * 128 + cc0);
      *(uint4*)(kraw + (rr0 + 32) * 136 + cc0) = *(const uint4*)(Zr + (size_t)(rr0 + 32) * GLA_N + 512 + hd * 128 + cc0);
    }
#pragma unroll
    for (int i = 0; i < 4; ++i) {
      const int cidx = tid + i * NT, rr = cidx >> 5, cc = (cidx & 31) * 8;
      const u16x8 v = *(const u16x8*)(Zr + (size_t)rr * GLA_N + 1024 + hd * 256 + cc);
#pragma unroll
      for (int j = 0; j < 8; ++j) vt[(cc + j) * 72 + rr] = v[j];
    }
    if (tid < 256) {
      const int rr = tid >> 2, cc = (tid & 3) * 8;
      const u16x8 v = *(const u16x8*)(Zr + (size_t)rr * GLA_N + 3072 + cc);
#pragma unroll
      for (int j = 0; j < 8; ++j) rs[((cc + j) >> 4) * 1024 + rr * 16 + ((cc + j) & 15)] = bf2f(v[j]);
    }
    __syncthreads();
#pragma unroll 1
    for (int dir = 0; dir < 2; ++dir) {
      const int dk = tid & 127, seg = tid >> 7;
      float vv[16];
      {
        const float* w2p = P.gla_gk_w2 + (size_t)(dir * 16) * 512 + hd * 128 + dk;
        float wq[16];
#pragma unroll
        for (int q = 0; q < 16; ++q) wq[q] = w2p[q * 512];
        const float gb = P.gla_gk_b[dir * 512 + hd * 128 + dk];
#pragma unroll
        for (int m = 0; m < 16; ++m) {
          const float4* rp = (const float4*)(rs + dir * 1024 + (seg * 16 + m) * 16);
          const float4 r0 = rp[0], r1 = rp[1], r2 = rp[2], r3 = rp[3];
          float a = gb;
          a += r0.x * wq[0] + r0.y * wq[1] + r0.z * wq[2] + r0.w * wq[3];
          a += r1.x * wq[4] + r1.y * wq[5] + r1.z * wq[6] + r1.w * wq[7];
          a += r2.x * wq[8] + r2.y * wq[9] + r2.z * wq[10] + r2.w * wq[11];
          a += r3.x * wq[12] + r3.y * wq[13] + r3.z * wq[14] + r3.w * wq[15];
          vv[m] = logsigmoid(a) * (1.f / 16.f);
        }
      }
      if (dir == 0) {
#pragma unroll
        for (int i = 1; i < 16; ++i) vv[i] += vv[i - 1];
        segt[seg * 128 + dk] = vv[15];
      } else {
#pragma unroll
        for (int i = 14; i >= 0; --i) vv[i] += vv[i + 1];
        segt[seg * 128 + dk] = vv[0];
      }
      __syncthreads();
      const float t0 = segt[dk], t1 = segt[128 + dk], t2 = segt[256 + dk], t3 = segt[384 + dk];
      float off;
      if (dir == 0) off = (seg > 0 ? t0 : 0.f) + (seg > 1 ? t1 : 0.f) + (seg > 2 ? t2 : 0.f);
      else off = (seg < 3 ? t3 : 0.f) + (seg < 2 ? t2 : 0.f) + (seg < 1 ? t1 : 0.f);
      const float tot = (t0 + t1) + (t2 + t3);
      if (seg == 0) DEC[((size_t)(c * 4 + hd) * 2 + dir) * 128 + dk] = __expf(tot);
      unsigned kw[8];
#pragma unroll
      for (int m = 0; m < 16; m += 2) {
        const int i0 = seg * 16 + m;
        const float b0 = vv[m] + off, b1 = vv[m + 1] + off;
        const float q0 = bf2f(qraw[i0 * 136 + dk]), q1 = bf2f(qraw[(i0 + 1) * 136 + dk]);
        const float k0 = bf2f(kraw[i0 * 136 + dk]), k1 = bf2f(kraw[(i0 + 1) * 136 + dk]);
        const unsigned qp = pk2(q0 * __expf(b0) * 0.08838834764831845f, q1 * __expf(b1) * 0.08838834764831845f);
        const unsigned kp = pk2(k0 * __expf(-b0), k1 * __expf(-b1));
        qt[i0 * 136 + dk] = (u16)(qp & 0xffffu); qt[(i0 + 1) * 136 + dk] = (u16)(qp >> 16);
        kt[i0 * 136 + dk] = (u16)(kp & 0xffffu); kt[(i0 + 1) * 136 + dk] = (u16)(kp >> 16);
        kw[m >> 1] = pk2(k0 * __expf(tot - b0), k1 * __expf(tot - b1));
      }
      {
        u16* slot = (dir == 0 ? Zr + 512 + hd * 128 : G2 + (size_t)row0 * 1024 + 512 + hd * 128);
        const size_t rstride = dir == 0 ? GLA_N : 1024;
        uint4* dp = (uint4*)(slot + (size_t)(dk >> 1) * rstride + (dk & 1) * 64 + seg * 16);
        dp[0] = make_uint4(kw[0], kw[1], kw[2], kw[3]); dp[1] = make_uint4(kw[4], kw[5], kw[6], kw[7]);
      }
      __syncthreads();
      if (wv < 4) {
        const int ti = wv & 1, tj = wv >> 1;
        f32x16 at;
#pragma unroll
        for (int i = 0; i < 16; ++i) at[i] = 0.f;
#pragma unroll
        for (int kk = 0; kk < 8; ++kk) {
          const bf16x8 a = *(const bf16x8*)(qt + (ti * 32 + r) * 136 + kk * 16 + h * 8);
          const bf16x8 bv = *(const bf16x8*)(kt + (tj * 32 + r) * 136 + kk * 16 + h * 8);
          at = MFMA32(a, bv, at);
        }
#pragma unroll
        for (int i = 0; i < 16; ++i) {
          const int ii = ti * 32 + crow(i, h), sj = tj * 32 + r;
          const bool keep = dir == 0 ? (sj <= ii) : (sj >= ii);
          ps[ii * 72 + sj] = f2bf(keep ? at[i] : 0.f);
        }
      } else {
        u16* slot = (dir == 0 ? Zr + hd * 128 : G2 + (size_t)row0 * 1024 + hd * 128);
        const size_t rstride = dir == 0 ? GLA_N : 1024;
        const int t4 = tid - 256;
#pragma unroll
        for (int i = 0; i < 4; ++i) {
          const int cidx = t4 + i * 256, rr = cidx >> 4, cc = (cidx & 15) * 8;
          *(uint4*)(slot + (size_t)rr * rstride + cc) = *(const uint4*)(qt + rr * 136 + cc);
        }
      }
      __syncthreads();
      {
        u16* O = dir == 0 ? (u16*)(lws(P) + OFF_A) : (u16*)(lws(P) + OFF_BIG + B_GOB);
        f32x16 o0, o1;
#pragma unroll
        for (int i = 0; i < 16; ++i) { o0[i] = 0.f; o1[i] = 0.f; }
#pragma unroll
        for (int ss = 0; ss < 4; ++ss) {
          const bf16x8 bv = *(const bf16x8*)(vt + (wv * 32 + r) * 72 + ss * 16 + h * 8);
          const bf16x8 a0 = *(const bf16x8*)(ps + r * 72 + ss * 16 + h * 8);
          const bf16x8 a1 = *(const bf16x8*)(ps + (32 + r) * 72 + ss * 16 + h * 8);
          o0 = MFMA32(a0, bv, o0); o1 = MFMA32(a1, bv, o1);
        }
        u16* ob = O + (size_t)row0 * 1024 + hd * 256 + wv * 32 + r;
#pragma unroll
        for (int i = 0; i < 16; ++i) {
          const int ii = crow(i, h);
          ob[(size_t)ii * 1024] = f2bf(o0[i]);
          ob[(size_t)(32 + ii) * 1024] = f2bf(o1[i]);
        }
      }
      __syncthreads();
    }
  }
}

DI void gla_scan_phase(const Params& P, unsigned char* smem, int bid, int nblk) {
  u16* qs = (u16*)smem;
  u16* ket = qs + 64 * 136;
  u16* vt = ket + 128 * 72;
  u16* sb = vt + 32 * 72;
  float* decs = (float*)(sb + 32 * 136);
  const int tid = ltid(), lane = tid & 63, wv = tid >> 6;
  const int r = lane & 31, h = lane >> 5;
  const u16* Z = (const u16*)(lws(P) + OFF_BIG + B_GZ);
  const u16* G2 = (const u16*)(lws(P) + OFF_BIG + B_G2);
  const float* DEC = (const float*)(lws(P) + OFF_BIG + B_DEC);
  for (int u0 = bid; u0 < 256; u0 += nblk) {
    int u = u0;
    if (nblk == 256) { const int xc = u0 & 7, sl = u0 >> 3; u = ((xc + 8 * (sl >> 3)) << 3) + (sl & 7); }
    const int vs = u & 7, dir = (u >> 3) & 1, hd = (u >> 4) & 3, b = u >> 6;
    u16* O = dir == 0 ? (u16*)(lws(P) + OFF_A) : (u16*)(lws(P) + OFF_BIG + B_GOB);
    const u16* TB = dir == 0 ? Z : G2;
    const size_t rst = dir == 0 ? GLA_N : 1024;
    __syncthreads();
    for (int e = tid; e < 32 * 136; e += NT) sb[e] = 0;
    f32x16 S;
#pragma unroll
    for (int i = 0; i < 16; ++i) S[i] = 0.f;
    uint4 pq0, pq1, pk0, pk1; u16x8 pv; float pd = 0.f;
#define GLA_ROW0(ci_) ((ci_) < 4 ? NL + b * 256 + (dir == 0 ? (ci_) : 3 - (ci_)) * 64 : b * SEQ + (dir == 0 ? (ci_) - 4 : 131 - (ci_)) * 64)
#define GLA_PREFETCH(ci_)                                                                                         \
    { const int rw = GLA_ROW0(ci_);                                                                               \
      const u16* Tq = TB + (size_t)rw * rst + hd * 128;                                                           \
      const u16* Tk = Tq + 512;                                                                                   \
      pq0 = *(const uint4*)(Tq + (size_t)(tid >> 4) * rst + (tid & 15) * 8);                                      \
      pq1 = *(const uint4*)(Tq + (size_t)((tid >> 4) + 32) * rst + (tid & 15) * 8);                               \
      pk0 = *(const uint4*)(Tk + (size_t)(tid >> 4) * rst + (tid & 15) * 8);             \
      pk1 = *(const uint4*)(Tk + (size_t)((tid >> 4) + 32) * rst + (tid & 15) * 8);                               \
      if (tid < 256) pv = *(const u16x8*)(Z + (size_t)(rw + (tid >> 2)) * GLA_N + 1024 + hd * 256 + vs * 32 + (tid & 3) * 8); \
      else if (tid < 384) { const int cidx = rw < NL ? (rw >> 6) : 512 + ((rw - NL) >> 6);                         \
        pd = DEC[((size_t)(cidx * 4 + hd) * 2 + dir) * 128 + (tid - 256)]; } }
    GLA_PREFETCH(0)
    __syncthreads();
    for (int ci = 0; ci < 132; ++ci) {
      const int row0 = GLA_ROW0(ci);
      {
        const int rr0 = tid >> 4, cc0 = (tid & 15) * 8;
        *(uint4*)(qs + rr0 * 136 + cc0) = pq0; *(uint4*)(qs + (rr0 + 32) * 136 + cc0) = pq1;
        const int d0 = 2 * rr0 + (cc0 >> 6), s0 = cc0 & 63;
        *(uint4*)(ket + d0 * 72 + s0) = pk0; *(uint4*)(ket + (d0 + 64) * 72 + s0) = pk1;
      }
      if (tid < 256) {
        const int rr = tid >> 2, cc = (tid & 3) * 8;
#pragma unroll
        for (int j = 0; j < 8; ++j) vt[(cc + j) * 72 + rr] = pv[j];
      } else if (tid < 384) decs[tid - 256] = pd;
      if (ci + 1 < 132) GLA_PREFETCH(ci + 1)
      __syncthreads();
      f32x16 Sn;
      if (wv < 4) {
#pragma unroll
        for (int i = 0; i < 16; ++i) Sn[i] = S[i] * decs[wv * 32 + crow(i, h)];
#pragma unroll
        for (int ss = 0; ss < 4; ++ss) {
          const bf16x8 a = *(const bf16x8*)(ket + (wv * 32 + r) * 72 + ss * 16 + h * 8);
          const bf16x8 bv = *(const bf16x8*)(vt + r * 72 + ss * 16 + h * 8);
          Sn = MFMA32(a, bv, Sn);
        }
      } else if (wv < 6) {
        const int ti = wv - 4;
        u16* ob = O + (size_t)(row0 + ti * 32) * 1024 + hd * 256 + vs * 32 + r;
        float oin[16];
#pragma unroll
        for (int i = 0; i < 16; ++i) oin[i] = bf2f(ob[(size_t)crow(i, h) * 1024]);
        f32x16 o;
#pragma unroll
        for (int i = 0; i < 16; ++i) o[i] = 0.f;
#pragma unroll
        for (int kk = 0; kk < 8; ++kk) {
          const bf16x8 a = *(const bf16x8*)(qs + (ti * 32 + r) * 136 + kk * 16 + h * 8);
          const bf16x8 bv = *(const bf16x8*)(sb + r * 136 + kk * 16 + h * 8);
          o = MFMA32(a, bv, o);
        }
#pragma unroll
        for (int i = 0; i < 16; ++i) ob[(size_t)crow(i, h) * 1024] = f2bf(o[i] + oin[i]);
      }
      __syncthreads();
      if (wv < 4) {
        S = Sn;
#pragma unroll
        for (int g = 0; g < 4; ++g) {
          u16x4 o;
#pragma unroll
          for (int q = 0; q < 4; ++q) o[q] = f2bf(S[4 * g + q]);
          *(u16x4*)(sb + r * 136 + wv * 32 + 8 * g + 4 * h) = o;
        }
      }
    }
  }
}

DI void gla_out_phase(const Params& P, int bid, int nblk) {
  const int lane = ltid() & 63, wv = ltid() >> 6;
  u16* A = (u16*)(lws(P) + OFF_A);
  const u16* Ob = (const u16*)(lws(P) + OFF_BIG + B_GOB);
  const u16* Z = (const u16*)(lws(P) + OFF_BIG + B_GZ);
  const float4 on4 = *(const float4*)(P.gla_onorm + lane * 4);
  for (int row = bid * 8 + wv; row < NTOK; row += nblk * 8) {
    u16x4 a[4], bq[4], og[4];
#pragma unroll
    for (int hd = 0; hd < 4; ++hd) {
      const size_t o = (size_t)row * 1024 + hd * 256 + lane * 4;
      a[hd] = *(const u16x4*)(A + o); bq[hd] = *(const u16x4*)(Ob + o);
      og[hd] = *(const u16x4*)(Z + (size_t)row * GLA_N + 2048 + hd * 256 + lane * 4);
    }
#pragma unroll
    for (int hd = 0; hd < 4; ++hd) {
      float v[4];
      float ss = 0.f;
#pragma unroll
      for (int j = 0; j < 4; ++j) { v[j] = bf2f(a[hd][j]) + bf2f(bq[hd][j]); ss += v[j] * v[j]; }
      ss = wave_sum(ss, lane);
      const float rstd = rsqrtf(ss * (1.f / 256.f) + EPS);
      uint2 res;
      res.x = pk2(v[0] * rstd * on4.x * silu(bf2f(og[hd][0])), v[1] * rstd * on4.y * silu(bf2f(og[hd][1])));
      res.y = pk2(v[2] * rstd * on4.z * silu(bf2f(og[hd][2])), v[3] * rstd * on4.w * silu(bf2f(og[hd][3])));
      *(uint2*)(A + (size_t)row * 1024 + hd * 256 + lane * 4) = res;
    }
  }
}

DI void mla_prep_phase(const Params& P, int bid, int nblk) {
  const int lane = ltid() & 63, wv = ltid() >> 6;
  const u16* Cd = (const u16*)(lws(P) + OFF_BIG + B_CD);
  u16* CQN = (u16*)(lws(P) + OFF_A + A_CQN);
  u16* CKVN = (u16*)(lws(P) + OFF_A + A_CKVN);
  u16* KR = (u16*)(lws(P) + OFF_BIG + B_KR);
  for (int row = bid * 8 + wv; row < NTOK; row += nblk * 8) {
    const u16* cr = Cd + (size_t)row * MLA_DNP;
    if (row < NL) {
      float v[6], ss = 0.f;
#pragma unroll
      for (int j = 0; j < 6; ++j) { v[j] = bf2f(cr[lane + 64 * j]); ss += v[j] * v[j]; }
      ss = wave_sum(ss, lane);
      const float rstd = rsqrtf(ss * (1.f / 384.f) + EPS);
#pragma unroll
      for (int j = 0; j < 6; ++j) CQN[(size_t)row * 384 + lane + 64 * j] = f2bf(v[j] * rstd * P.mla_qnorm[lane + 64 * j]);
    }
    {
      float v[4], ss = 0.f;
#pragma unroll
      for (int j = 0; j < 4; ++j) { v[j] = bf2f(cr[384 + lane + 64 * j]); ss += v[j] * v[j]; }
      ss = wave_sum(ss, lane);
      const float rstd = rsqrtf(ss * (1.f / 256.f) + EPS);
#pragma unroll
      for (int j = 0; j < 4; ++j) CKVN[(size_t)row * 256 + lane + 64 * j] = f2bf(v[j] * rstd * P.mla_kvnorm[lane + 64 * j]);
    }
    {
      float x = bf2f(cr[640 + lane]);
      const float px = shx(x, 16, lane);
      int b, key;
      if (row < NL) {
        b = row >> 13; const int l = row & 8191; key = NCTX + l;
        const int jj = lane & 15;
        const bool first = (lane & 31) < 16;
        const float invf = __expf(-(float)jj * (9.210340371976184f / 16.f));
        const float pos = (float)(lane < 32 ? (l >> 6) : (l & 63));
        float sn, cs;
        __sincosf(pos * invf, &sn, &cs);
        x = first ? (x * cs - px * sn) : (px * sn + x * cs);
      } else { b = (row - NL) >> 8; key = (row - NL) & 255; }
      KR[((size_t)b * NKEY + key) * 64 + lane] = f2bf(x);
    }
  }
}

constexpr int KS_STRIDE = 200;
constexpr int VS_STRIDE = 68;
DI void mla_attn_phase(const Params& P, unsigned char* smem, int bid, int nblk) {
  u16* Ks = (u16*)smem;
  u16* Vs = Ks + 2 * 64 * KS_STRIDE;
  const int tid = ltid(), lane = tid & 63, wv = tid >> 6;
  const int r = lane & 31, h = lane >> 5;
  const u16* Qg = (const u16*)(lws(P) + OFF_BIG + B_Q);
  const u16* Kn = (const u16*)(lws(P) + OFF_BIG + B_KN);
  const u16* VT = (const u16*)(lws(P) + OFF_BIG + B_VT);
  const u16* KR = (const u16*)(lws(P) + OFF_BIG + B_KR);
  u16* O = (u16*)(lws(P) + OFF_A);
  for (int u0 = bid; u0 < 1024; u0 += nblk) {
    int u = u0;
    if (nblk == 256) { const int rnd = u0 >> 8, c = u0 & 255; u = ((rnd * 8 + (c & 7)) << 5) + (c >> 3); }
    const int bh = u >> 5, qb = u & 31, b = bh >> 3, hd = bh & 7;
    const int l = qb * 256 + wv * 32 + r;
    bf16x8 qf[12];
    {
      const u16* qp = Qg + (size_t)(b * SEQ + l) * 1536 + hd * 192 + h * 8;
#pragma unroll
      for (int s = 0; s < 12; ++s) qf[s] = *(const bf16x8*)(qp + s * 16);
#pragma unroll
      for (int j = 0; j < 8; ++j) {
        const float invf = __expf(-(float)(8 * h + j) * (9.210340371976184f / 16.f));
        float sn, cs;
        __sincosf((float)(l >> 6) * invf, &sn, &cs);
        float x1 = bf2f((u16)qf[8][j]), x2 = bf2f((u16)qf[9][j]);
        qf[8][j] = (short)f2bf(x1 * cs - x2 * sn); qf[9][j] = (short)f2bf(x1 * sn + x2 * cs);
        __sincosf((float)(l & 63) * invf, &sn, &cs);
        x1 = bf2f((u16)qf[10][j]); x2 = bf2f((u16)qf[11][j]);
        qf[10][j] = (short)f2bf(x1 * cs - x2 * sn); qf[11][j] = (short)f2bf(x1 * sn + x2 * cs);
      }
    }
    f32x16 oacc[4];
#pragma unroll
    for (int d = 0; d < 4; ++d)
#pragma unroll
      for (int i = 0; i < 16; ++i) oacc[d][i] = 0.f;
    float mrun = -1e30f, lrun = 0.f;
    const u16* Kb = Kn + (size_t)bh * NKEY * 128;
    const u16* Rb = KR + (size_t)b * NKEY * 64;
    const u16* Vb = VT + (size_t)bh * 128 * NKEY;
    uint4 rk0, rk1, rk2, rv0, rv1;
#define ATT_GLOAD(kt_)                                                                                      \
    { const int key0 = (kt_) * 64;                                                                          \
      rk0 = *(const uint4*)(Kb + (size_t)(key0 + (tid >> 4)) * 128 + (tid & 15) * 8);                       \
      rk1 = *(const uint4*)(Kb + (size_t)(key0 + 32 + (tid >> 4)) * 128 + (tid & 15) * 8);                  \
      rk2 = *(const uint4*)(Rb + (size_t)(key0 + (tid >> 3)) * 64 + (tid & 7) * 8);                         \
      rv0 = *(const uint4*)(Vb + (size_t)(tid >> 3) * NKEY + key0 + (tid & 7) * 8);                         \
      rv1 = *(const uint4*)(Vb + (size_t)(64 + (tid >> 3)) * NKEY + key0 + (tid & 7) * 8); }
#define ATT_STV(src_, row_, buf_)                                                                           \
    { uint2* dp = (uint2*)(Vs + (buf_) * 128 * VS_STRIDE + (row_) * VS_STRIDE + (tid & 7) * 8);                \
      dp[0] = make_uint2(src_.x, src_.y); dp[1] = make_uint2(src_.z, src_.w); }
#define ATT_SSTORE(buf_)                                                                                    \
    { *(uint4*)(Ks + (buf_) * 64 * KS_STRIDE + (tid >> 4) * KS_STRIDE + (tid & 15) * 8) = rk0;                \
      *(uint4*)(Ks + (buf_) * 64 * KS_STRIDE + (32 + (tid >> 4)) * KS_STRIDE + (tid & 15) * 8) = rk1;         \
      *(uint4*)(Ks + (buf_) * 64 * KS_STRIDE + (tid >> 3) * KS_STRIDE + 128 + (tid & 7) * 8) = rk2;           \
      ATT_STV(rv0, (tid >> 3), buf_) ATT_STV(rv1, (64 + (tid >> 3)), buf_) }
    ATT_GLOAD(0);
    __syncthreads();
    ATT_SSTORE(0);
    __syncthreads();
    for (int kt = 0; kt < 132; ++kt) {
      const int cur = kt & 1;
      if (kt + 1 < 132) ATT_GLOAD(kt + 1);
      const u16* kc = Ks + cur * 64 * KS_STRIDE;
      const u16* vc = Vs + cur * 128 * VS_STRIDE;
#pragma unroll
      for (int t2 = 0; t2 < 2; ++t2) {
        f32x16 st;
#pragma unroll
        for (int i = 0; i < 16; ++i) st[i] = 0.f;
#pragma unroll
        for (int s = 0; s < 12; ++s) {
          const bf16x8 a = *(const bf16x8*)(kc + (t2 * 32 + r) * KS_STRIDE + s * 16 + h * 8);
          st = MFMA32(a, qf[s], st);
        }
        float mx = st[0];
#pragma unroll
        for (int i = 1; i < 16; ++i) mx = fmaxf(mx, st[i]);
        mx = fmaxf(mx, shx(mx, 32, lane));
        if (__builtin_amdgcn_ballot_w64(mx > mrun + 8.f) != 0ull) {
          const float mnew = fmaxf(mrun, mx);
          const float alpha = __builtin_amdgcn_exp2f(mrun - mnew);
          lrun *= alpha;
#pragma unroll
          for (int d = 0; d < 4; ++d)
#pragma unroll
            for (int i = 0; i < 16; ++i) oacc[d][i] *= alpha;
          mrun = mnew;
        }
        float ls = 0.f;
#pragma unroll
        for (int i = 0; i < 16; ++i) { const float p = __builtin_amdgcn_exp2f(st[i] - mrun); st[i] = p; ls += p; }
        lrun += ls;
        if (t2 == 0 && kt + 1 < 132) ATT_SSTORE(cur ^ 1);
#pragma unroll
        for (int s2 = 0; s2 < 2; ++s2) {
          uint4 pw;
          pw.x = pk2(st[8 * s2 + 0], st[8 * s2 + 1]); pw.y = pk2(st[8 * s2 + 2], st[8 * s2 + 3]);
          pw.z = pk2(st[8 * s2 + 4], st[8 * s2 + 5]); pw.w = pk2(st[8 * s2 + 6], st[8 * s2 + 7]);
          const bf16x8 pf = __builtin_bit_cast(bf16x8, pw);
#pragma unroll
          for (int d = 0; d < 4; ++d) {
            const u16* vp = vc + (d * 32 + r) * VS_STRIDE + t2 * 32 + 16 * s2 + 4 * h;
            const uint2 lo = *(const uint2*)vp, hi = *(const uint2*)(vp + 8);
            uint4 av = make_uint4(lo.x, lo.y, hi.x, hi.y);
            oacc[d] = MFMA32(__builtin_bit_cast(bf16x8, av), pf, oacc[d]);
          }
        }
      }
      __syncthreads();
    }
    lrun += shx(lrun, 32, lane);
    const float inv = 1.f / lrun;
    u16* op = O + (size_t)(b * SEQ + l) * 1024 + hd * 128;
#pragma unroll
    for (int d = 0; d < 4; ++d)
#pragma unroll
      for (int g = 0; g < 4; ++g) {
        u16x4 o;
#pragma unroll
        for (int q = 0; q < 4; ++q) o[q] = f2bf(oacc[d][4 * g + q] * inv);
        *(u16x4*)(op + d * 32 + 8 * g + 4 * h) = o;
      }
  }
}

constexpr int NPHASE = 36;

DI void run_phase(const Params& P, int ph, unsigned char* smem, int bid, int nblk) {
  u16* WT = (u16*)(lws(P) + OFF_WT);
  u16* A = (u16*)(lws(P) + OFF_A);
  unsigned char* BIG = lws(P) + OFF_BIG;
  float* XC = (float*)(lws(P) + OFF_XC);
  const float* MOD = (const float*)(lws(P) + OFF_MOD);
  EpiArgs ea{};
  if (ph == 0) {
    pro_weights(P, smem, bid, nblk);
    __syncthreads();
    pro_adaln(P, smem, bid, nblk);
    pro_filter_mlp(P, bid, nblk);
    return;
  }
  if (ph == 35) { final_norm_phase(P, bid, nblk); return; }
  int li, sub;
  if (ph <= 8) { li = 0; sub = ph - 1; }
  else if (ph <= 17) { li = 1; sub = ph - 9; }
  else if (ph <= 26) { li = 2; sub = ph - 18; }
  else { li = 3; sub = ph - 27; }
  const bool ctx_on = li <= 1;
  const int rows_all = ctx_on ? NTOK : NL;
  const int mt_all = rows_all / 256;
  const float* xl = li == 0 ? P.x : P.out;
  const float* xc = li == 0 ? P.ctx : XC;
  const int nsub = (li == 1 || li == 2) ? 9 : 8;
  if (sub == nsub - 3) { normmod_phase(P, li, 1, rows_all, P.out, XC, bid, nblk); return; }
  if (sub == nsub - 2) {
    EBf16<1> e{(u16*)(BIG + B_HID), HID, HID};
    gemm8(A, WT + W_MLP1(li), rows_all, HID, 1024, e, smem, bid, nblk);
    return;
  }
  if (sub == nsub - 1) {
    ea.gate = MOD + (size_t)li * 5 * 6144; ea.gofs = 5 * 1024;
    ea.xsl = P.out; ea.xsc = XC; ea.xdl = P.out; ea.xdc = XC;
    ERes e{nullptr, ea.gate, ea.gofs, ea.xsl, ea.xsc, ea.xdl, ea.xdc};
    gemm8((const u16*)(BIG + B_HID), WT + W_MLP2(li), NL, 1024, HID, e, smem, bid, nblk);
    if (ctx_on) {
      EResAtomic e2{ea.gate + 4 * 6144 + ea.gofs, XC};
      gemm8_splitk((const u16*)(BIG + B_HID) + (size_t)NL * HID, WT + W_MLP2(li), NTOK - NL, 1024, HID, 4, e2, smem, bid, nblk);
    }
    return;
  }
  ea.gate = MOD + (size_t)li * 5 * 6144; ea.gofs = 2 * 1024;
  ea.xsl = xl; ea.xsc = xc; ea.xdl = P.out; ea.xdc = XC;
  if (li == 0 || li == 3) {
    const int jl = li == 0 ? 0 : 1;
    switch (sub) {
      case 0: normmod_phase(P, li, 0, rows_all, xl, xc, bid, nblk); break;
      case 1: {
        EHyIn e1{(u16*)(BIG + B_ZT), P.hy_b_in + jl * 3072};
        gemm8(WT + W_HYIN(jl), A, 3072, rows_all, 1024, e1, smem, bid, nblk);
        EpiArgs e2{};
        e2.o0 = (u16*)(BIG + B_KT); e2.mrow0 = 0; e2.L = SEQ;
        const u16* h3 = (const u16*)(lws(P) + OFF_H3) + (size_t)jl * KTL * 64;
        gemm_phase<EPI_FILT>(h3, 64, WT + W_HYF4(jl), 64, 32, 16, e2, smem, bid, nblk);
        if (ctx_on) {
          e2.mrow0 = SEQ; e2.L = NCTX;
          gemm_phase<EPI_FILT>(h3 + (size_t)SEQ * 64, 64, WT + W_HYF4(jl), 64, 1, 16, e2, smem, bid, nblk);
        }
      } break;
      case 2: hyena_conv_phase(P, jl, ctx_on, smem, bid, nblk); break;
      case 3: transpose_phase(P, rows_all, smem, bid, nblk); break;
      case 4:
        { ERes e{P.hy_b_out + jl * 1024, ea.gate, ea.gofs, ea.xsl, ea.xsc, ea.xdl, ea.xdc};
          gemm8(A, WT + W_HYOUT(jl), rows_all, 1024, 1024, e, smem, bid, nblk); }
        break;
    }
    return;
  }
  if (li == 1) {
    switch (sub) {
      case 0: normmod_phase(P, li, 0, NTOK, xl, xc, bid, nblk); break;
      case 1: {
        EBf16<0> e1{(u16*)(BIG + B_GZ), GLA_N, GLA_N};
        gemm8(A, WT + W_GLAIN, NTOK, GLA_NP, 1024, e1, smem, bid, nblk);
      } break;
      case 2: gla_prep_phase(P, smem, bid, nblk); break;
      case 3: gla_scan_phase(P, smem, bid, nblk); break;
      case 4: gla_out_phase(P, bid, nblk); break;
      case 5: { ERes e{nullptr, ea.gate, ea.gofs, ea.xsl, ea.xsc, ea.xdl, ea.xdc};
        gemm8(A, WT + W_GLAWO, NTOK, 1024, 1024, e, smem, bid, nblk); } break;
    }
    return;
  }
  switch (sub) {
    case 0: normmod_phase(P, li, 0, NTOK, xl, xc, bid, nblk); break;
    case 1: {
      EBf16<0> e1{(u16*)(BIG + B_CD), MLA_DNP, MLA_DNP};
      gemm8(A, WT + W_MLADN, NTOK, MLA_DNP, 1024, e1, smem, bid, nblk);
    } break;
    case 2: mla_prep_phase(P, bid, nblk); break;
    case 3: {
      EBf16<2> e1{(u16*)(BIG + B_Q), 1536, 1536};
      gemm8((const u16*)(lws(P) + OFF_A + A_CQN), WT + W_MLAUQ, NL, 1536, 384, e1, smem, bid, nblk);
      EMlaK e2{(u16*)(BIG + B_KN)};
      gemm8((const u16*)(lws(P) + OFF_A + A_CKVN), WT + W_MLAUKV, NTOK, 1024, 256, e2, smem, bid, nblk);
      EMlaVT e3{(u16*)(BIG + B_VT)};
      gemm8(WT + W_MLAUKV + (size_t)1024 * 256, (const u16*)(lws(P) + OFF_A + A_CKVN), 1024, NTOK, 256, e3, smem, bid, nblk);
    } break;
    case 4: mla_attn_phase(P, smem, bid, nblk); break;
    case 5: { ERes e{nullptr, ea.gate, ea.gofs, ea.xsl, ea.xsc, ea.xdl, ea.xdc};
      gemm8(A, WT + W_MLAWO, NL, 1024, 1024, e, smem, bid, nblk); } break;
  }
}

#define XB_TMO      128
#define XB_XCNT(j)  (256  + 64 * (j))
#define XB_XSUB(j)  (1280 + 64 * (j))
#define XB_XGEN(j)  (2304 + 64 * (j))
#define XB_TOP      3328
#define XB_TOPGEN   3392
#define XCD_BAR_WORDS 3456
#define XB_SPIN_CAP (1u << 18)
#define LAS __attribute__((address_space(3)))

__device__ __forceinline__ unsigned xb_ld(unsigned* p)              { return __hip_atomic_load(p, __ATOMIC_RELAXED, __HIP_MEMORY_SCOPE_AGENT); }
__device__ __forceinline__ unsigned xb_add(unsigned* p, unsigned v) { return __hip_atomic_fetch_add(p, v, __ATOMIC_RELAXED, __HIP_MEMORY_SCOPE_AGENT); }
__device__ __forceinline__ unsigned xb_xcc_id() { return (unsigned)__builtin_amdgcn_s_getreg((3 << 11) | 20) & 0xFu; }
#define XB_SPIN(cond, bar) do { unsigned _sp = 0; while (cond) { __builtin_amdgcn_s_sleep(1); \
    if ((++_sp & 255u) == 0u) { if (xb_ld(&(bar)[XB_TMO])) break; if (_sp > XB_SPIN_CAP) { atomicAdd(&(bar)[XB_TMO], 1u); break; } } } } while (0)

struct XcdBarrier {
    unsigned* bar; unsigned x;
    volatile LAS unsigned* st;
};

__device__ __forceinline__ XcdBarrier xcd_barrier_post(unsigned* bar, volatile LAS unsigned* st) {
    XcdBarrier b; b.bar = bar; b.x = xb_xcc_id(); b.st = st;
    if (threadIdx.x == 0) (void)xb_add(&bar[XB_XCNT(b.x)], 1u);
    return b;
}
__device__ __forceinline__ void xcd_barrier_complete(unsigned* bar, unsigned x, unsigned& nloc, unsigned& nx) {
    const unsigned G = gridDim.x * gridDim.y * gridDim.z;
    unsigned sum, cnt, mine, sp = 0u;
    for (;;) {
        sum = 0u; cnt = 0u; mine = 0u;
#pragma unroll
        for (unsigned j = 0; j < 16; ++j) { const unsigned c = xb_ld(&bar[XB_XCNT(j)]); sum += c; cnt += (c > 0u) ? 1u : 0u; mine = (j == x) ? c : mine; }
        if (sum == G) break;
        __builtin_amdgcn_s_sleep(1);
        if ((++sp & 255u) == 0u) { if (xb_ld(&bar[XB_TMO])) break; if (sp > XB_SPIN_CAP) { atomicAdd(&bar[XB_TMO], 1u); break; } }
    }
    nloc = mine > 0u ? mine : 1u; nx = cnt > 0u ? cnt : 1u;
}

__device__ __forceinline__ void xcd_barrier(const XcdBarrier& b) {
    asm volatile("s_waitcnt vmcnt(0)" ::: "memory");
    __syncthreads();
    if (threadIdx.x == 0) {
        unsigned* bar = b.bar;
        __builtin_amdgcn_s_waitcnt(0);
        unsigned nloc = b.st[0], nx = b.st[1];
        if (nloc == 0u) { xcd_barrier_complete(bar, b.x, nloc, nx); b.st[0] = nloc; b.st[1] = nx; }
        const unsigned old = xb_add(&bar[XB_XSUB(b.x)], 1u);
        const unsigned gen = old / nloc;
        if (old + 1u == (gen + 1u) * nloc) {
            __builtin_amdgcn_fence(__ATOMIC_RELEASE, "agent");
            asm volatile("s_waitcnt vmcnt(0)" ::: "memory");
            const unsigned og = xb_add(&bar[XB_TOP], 1u);
            const unsigned tg = og / nx;
            if (og + 1u == (tg + 1u) * nx) xb_add(&bar[XB_TOPGEN], 1u);
            else XB_SPIN(xb_ld(&bar[XB_TOPGEN]) == tg, bar);
            __builtin_amdgcn_fence(__ATOMIC_ACQUIRE, "agent");
            xb_add(&bar[XB_XGEN(b.x)], 1u);
            asm volatile("s_waitcnt vmcnt(0)" ::: "memory");
        } else {
            XB_SPIN(xb_ld(&bar[XB_XGEN(b.x)]) == gen, bar);
            __builtin_amdgcn_fence(__ATOMIC_ACQUIRE, "agent");
            asm volatile("s_waitcnt vmcnt(0)" ::: "memory");
        }
    }
    __syncthreads();
}

DI void gbar(unsigned* ctr, unsigned nblk) {
  __syncthreads();
  if (threadIdx.x == 0) {
    __hip_atomic_fetch_add(ctr, 1u, __ATOMIC_RELEASE, __HIP_MEMORY_SCOPE_AGENT);
    while (__hip_atomic_load(ctr, __ATOMIC_RELAXED, __HIP_MEMORY_SCOPE_AGENT) < nblk) __builtin_amdgcn_s_sleep(1);
    __builtin_amdgcn_fence(__ATOMIC_ACQUIRE, "agent");
  }
  __syncthreads();
}

__global__ void __launch_bounds__(NT) mega(Params P) {
  extern __shared__ __attribute__((aligned(16))) unsigned char smem[];
  const int bid = blockIdx.x, nblk = gridDim.x;
  volatile LAS unsigned* xst = (volatile LAS unsigned*)(LAS unsigned char*)(smem + LDS_BYTES - 16);
  if (threadIdx.x == 0) { xst[0] = 0u; xst[1] = 0u; }
  __syncthreads();
  const XcdBarrier xb = xcd_barrier_post((unsigned*)(P.ws + OFF_ERR), xst);
  for (int ph = P.ph_lo; ph < P.ph_hi; ++ph) {
    int lb = bid, ln = nblk;
    asm volatile("" : "+s"(lb), "+s"(ln));
#ifdef PROBE_PH
    if (ph == PROBE_PH) { run_phase(P, ph, smem, lb, ln); cg::this_grid().sync(); }
#endif
    run_phase(P, ph, smem, lb, ln);
    if (ph + 1 < P.ph_hi) {
      if (P.ph_hi < 0) cg::this_grid().sync();
      xcd_barrier(xb);
    }
  }
}

extern "C" void kernel_launch(void* const* d_in, const int* in_sizes, int n_in, void* d_out, int out_size, void* d_ws, size_t ws_size,
                              hipStream_t stream) {
  static int grid = 0;
  if (grid == 0) {
    if (n_in != 37 || ws_size < WS_NEED) { fprintf(stderr, "kernel_launch: bad n_in %d / ws %zu\n", n_in, ws_size); grid = -1; return; }
    int dev = 0, cus = 0, per_cu = 0;
    hipGetDevice(&dev);
    hipDeviceGetAttribute(&cus, hipDeviceAttributeMultiprocessorCount, dev);
    if (hipFuncSetAttribute((const void*)mega, hipFuncAttributeMaxDynamicSharedMemorySize, LDS_BYTES) != hipSuccess) { fprintf(stderr, "hipFuncSetAttribute failed\n"); grid = -1; return; }
    hipOccupancyMaxActiveBlocksPerMultiprocessor(&per_cu, (const void*)mega, NT, LDS_BYTES);
    (void)hipGetLastError();
    if (per_cu < 1) per_cu = 1;
    grid = cus * per_cu;
  }
  if (grid < 0) return;
  Params p{};
  const float** fp = (const float**)&p;
  for (int i = 0; i < 37; ++i) fp[i] = (const float*)d_in[i];
  p.out = (float*)d_out;
  p.ws = (unsigned char*)d_ws;
  {
    int m = 0, tot = 0;
    auto add = [&](const float* src, size_t dst, int K, int N, int Np) {
      p.mats[m].src = src; p.mats[m].dst = dst; p.mats[m].K = K; p.mats[m].N = N; p.mats[m].Np = Np; p.mats[m].perm = (src == p.mla_w_ukv) ? 1 : 0;
      p.mats[m].tiles = (K / 64) * (Np / 256); tot += p.mats[m].tiles; ++m;
    };
    for (int i = 0; i < 4; ++i) {
      add(p.mlp_w1 + (size_t)i * 1024 * 4096, W_MLP1(i), 1024, 4096, 4096);
      add(p.mlp_w2 + (size_t)i * 4096 * 1024, W_MLP2(i), 4096, 1024, 1024);
    }
    for (int j = 0; j < 2; ++j) {
      add(p.hy_w_in + (size_t)j * 1024 * 3072, W_HYIN(j), 1024, 3072, 3072);
      add(p.hy_w_out + (size_t)j * 1024 * 1024, W_HYOUT(j), 1024, 1024, 1024);
      add(p.hy_f_w4 + (size_t)j * 64 * 4096, W_HYF4(j), 64, 4096, 4096);
    }
    add(p.gla_w_in, W_GLAIN, 1024, GLA_N, GLA_NP);
    add(p.gla_wo, W_GLAWO, 1024, 1024, 1024);
    add(p.mla_w_down, W_MLADN, 1024, MLA_DN, MLA_DNP);
    add(p.mla_w_uq, W_MLAUQ, 384, 1536, 1536);
    add(p.mla_w_ukv, W_MLAUKV, 256, 2048, 2048);
    add(p.mla_wo, W_MLAWO, 1024, 1024, 1024);
    for (; m < NMAT; ++m) { p.mats[m].tiles = 0; }
    p.total_mat_tiles = tot;
  }
  (void)hipMemsetAsync((unsigned char*)d_ws + OFF_ERR, 0, 16384, stream);
#if MULTI
  for (int ph = 0; ph < NPHASE; ++ph) {
    p.ph_lo = ph; p.ph_hi = ph + 1;
    hipLaunchKernelGGL(mega, dim3(grid), dim3(NT), LDS_BYTES, stream, p);
  }
#else
  p.ph_lo = 0; p.ph_hi = NPHASE;
  void* args[] = {&p};
  hipError_t e = hipLaunchCooperativeKernel((const void*)mega, dim3(grid), dim3(NT), args, LDS_BYTES, stream);
  if (e != hipSuccess) fprintf(stderr, "cooperative launch failed: %s (grid %d)\n", hipGetErrorString(e), grid);
#endif
}
```

```cpp
#include <hip/hip_runtime.h>
#include <hip/hip_cooperative_groups.h>
#include <cstdio>
#include <cstdint>
namespace cg = cooperative_groups;

#ifndef MULTI
#define MULTI 0
#endif
#ifndef CHECKS
#define CHECKS 0
#endif

typedef unsigned short u16;
using bf16x8 = __attribute__((ext_vector_type(8))) short;
using u16x4  = __attribute__((ext_vector_type(4))) unsigned short;
using u16x8  = __attribute__((ext_vector_type(8))) unsigned short;
using f32x16 = __attribute__((ext_vector_type(16))) float;
#define DI __device__ __forceinline__
#define MFMA32(a, b, c) __builtin_amdgcn_mfma_f32_32x32x16_bf16((a), (b), (c), 0, 0, 0)

constexpr int DM = 1024, NB = 4, SEQ = 8192, NCTX = 256;
constexpr int NL = NB * SEQ;
constexpr int NTOK = NL + NB * NCTX;
constexpr int HID = 4096;
constexpr int NT = 512;
constexpr int GLA_N = 3104, GLA_NP = 3328;
constexpr int MLA_DN = 704, MLA_DNP = 768;
constexpr int KTL = SEQ + NCTX;
constexpr int NKEY = SEQ + NCTX;
constexpr float EPS = 1e-6f;

constexpr size_t MiB = 1048576;
constexpr size_t OFF_MOD = 0;
constexpr size_t OFF_ERR = 512 * 1024;
constexpr size_t OFF_XC  = 1 * MiB;
constexpr size_t OFF_H3  = 5 * MiB;
constexpr size_t OFF_WT  = 8 * MiB;
constexpr size_t OFF_A   = 104 * MiB;
constexpr size_t OFF_BIG = 170 * MiB;
constexpr size_t WS_NEED = 510 * MiB;
constexpr size_t W_MLP1(int i) { return (size_t)i * 8388608; }
constexpr size_t W_MLP2(int i) { return (size_t)i * 8388608 + 4194304; }
constexpr size_t W_HY0 = 33554432;
constexpr size_t W_HYIN(int j)  { return W_HY0 + (size_t)j * 4456448; }
constexpr size_t W_HYOUT(int j) { return W_HYIN(j) + 3145728; }
constexpr size_t W_HYF4(int j)  { return W_HYOUT(j) + 1048576; }
constexpr size_t W_GLAIN = W_HY0 + 2 * 4456448;
constexpr size_t W_GLAWO = W_GLAIN + (size_t)GLA_NP * 1024;
constexpr size_t W_MLADN = W_GLAWO + 1048576;
constexpr size_t W_MLAUQ = W_MLADN + (size_t)MLA_DNP * 1024;
constexpr size_t W_MLAUKV = W_MLAUQ + 1536 * 384;
constexpr size_t W_MLAWO = W_MLAUKV + 2048 * 256;
constexpr size_t W_END = W_MLAWO + 1048576;
static_assert(W_END * 2 <= 96 * MiB, "wt");
constexpr size_t B_ZT = 0;
constexpr size_t B_YT = (size_t)3072 * NTOK * 2;
constexpr size_t B_KT = B_YT + (size_t)1024 * NTOK * 2;
constexpr size_t B_HID = 0;
constexpr size_t B_GZ = 0;
constexpr size_t B_GOB = (size_t)NTOK * GLA_N * 2;
constexpr size_t B_G2 = B_GOB + (size_t)NTOK * 1024 * 2;
constexpr size_t B_DEC = B_G2 + (size_t)NTOK * 1024 * 2;
constexpr size_t B_Q = 0;
constexpr size_t B_KN = (size_t)NL * 1536 * 2;
constexpr size_t B_VT = B_KN + (size_t)NTOK * 1024 * 2;
constexpr size_t B_KR = B_VT + (size_t)NTOK * 1024 * 2;
constexpr size_t B_CD = B_KR + (size_t)NTOK * 64 * 2;
static_assert(B_KT + (size_t)4096 * KTL * 2 <= 330 * MiB, "big");
static_assert(B_CD + (size_t)NTOK * 768 * 2 <= 330 * MiB, "big2");
static_assert(B_DEC + (size_t)528 * 4 * 2 * 128 * 4 <= 340 * MiB, "big3");
constexpr size_t A_CQN = 0;
constexpr size_t A_CKVN = (size_t)NL * 384 * 2;

constexpr int LDS_BYTES = 148 * 1024;

struct MatDesc { const float* src; unsigned long long dst; int K, N, Np, tiles, perm, pad; };
constexpr int NMAT = 22;

struct Params {
  const float *x, *c, *ctx, *c_ctx, *ada_w, *ada_b, *norm1_g, *norm2_g, *mlp_w1, *mlp_w2, *final_g;
  const float *hy_w_in, *hy_b_in, *hy_conv_w, *hy_conv_b, *hy_f_w1, *hy_f_b1, *hy_f_w2, *hy_f_b2, *hy_f_w3, *hy_f_b3, *hy_f_w4,
      *hy_freq, *hy_bias, *hy_w_out, *hy_b_out;
  const float *gla_w_in, *gla_gk_w2, *gla_gk_b, *gla_onorm, *gla_wo;
  const float *mla_w_down, *mla_qnorm, *mla_w_uq, *mla_kvnorm, *mla_w_ukv, *mla_wo;
  float* out;
  unsigned char* ws;
  MatDesc mats[NMAT];
  int total_mat_tiles;
  int ph_lo, ph_hi;
  int pad0;
};

DI u16 f2bf(float x) { unsigned u = __float_as_uint(x); u += 0x7fffu + ((u >> 16) & 1u); return (u16)(u >> 16); }
DI float bf2f(u16 v) { return __uint_as_float(((unsigned)v) << 16); }
typedef float f2v_t __attribute__((ext_vector_type(2)));
typedef __bf16 b2v_t __attribute__((ext_vector_type(2)));
DI unsigned pk2(float lo, float hi) { f2v_t v; v.x = lo; v.y = hi; return __builtin_bit_cast(unsigned, __builtin_convertvector(v, b2v_t)); }
DI float shx(float v, int mask, int lane) { return __int_as_float(__builtin_amdgcn_ds_bpermute((lane ^ mask) << 2, __float_as_int(v))); }
DI float wave_sum(float v, int lane) {
#pragma unroll
  for (int o = 32; o > 0; o >>= 1) v += shx(v, o, lane);
  return v;
}
DI int ltid() { int t = threadIdx.x; asm volatile("" : "+v"(t)); return t; }
DI unsigned char* lws(const Params& P) { unsigned char* w = P.ws; asm volatile("" : "+s"(w)); return w; }
DI float lzero() { float z; asm volatile("v_mov_b32 %0, 0" : "=v"(z)); return z; }
DI int crow(int reg, int h) { return (reg & 3) + 8 * (reg >> 2) + 4 * h; }
DI float silu(float x) { return x / (1.f + __expf(-x)); }
DI int mod_index(int row) { return row < NL ? (row >> 13) : 4; }

namespace pg8 {
#define PG8_LAS __attribute__((address_space(3)))
typedef unsigned short bf16_t;
typedef short bf16x8 __attribute__((ext_vector_type(8)));
typedef float f32x4 __attribute__((ext_vector_type(4)));
typedef unsigned u32x4 __attribute__((ext_vector_type(4)));
constexpr int BM = 256, BK = 64, HALF = 128, HTB = HALF * BK * 2  , STAGE_BYTES = 8 * HTB, NXCD = 8, WGM = 8;

__host__ __device__ __forceinline__ int lds_byte(int r, int c) { const int st = (r >> 4) * 2 + (c >> 5), rr = r & 15, cc = c & 31, ob = rr * 64 + cc * 2; return st * 1024 + (ob ^ (((ob >> 9) & 1) << 5)); }
__host__ __device__ __forceinline__ void stage_rc(int b, int& R, int& C) { const int st = b / 1024, sb = b % 1024, swz = sb ^ (((sb >> 9) & 1) << 5); R = (st >> 1) * 16 + swz / 64; C = (st & 1) * 32 + (swz % 64) / 2; }
__host__ __device__ __forceinline__ int perm32(int rho) { const int n = rho >> 4, i = rho & 15; return 8 * (i >> 2) + 4 * n + (i & 3); }

struct Unit { int pm, pn, koff; };
struct Gemm { const bf16_t* A; const bf16_t* Bt; int M, N, K, ld; };

struct StaticOrder {
    int nM, nN, nwg, G, c;
    __host__ __device__ void init(int M, int N, int G_, int c_) { nM = M / BM; nN = N / BM; nwg = nM * nN; G = G_; c = c_; }
    __host__ __device__ bool next(int i, Unit& u) const {
        const long L = (long)i * G + c; if (L >= nwg) return false;
        int wgid = (int)L; { const int q = nwg / NXCD, r = nwg % NXCD, xcd = wgid % NXCD, off = wgid / NXCD; wgid = (xcd < r ? xcd * (q + 1) : r * (q + 1) + (xcd - r) * q) + off; }
        const int nig = WGM * nN, gid = wgid / nig, fm = gid * WGM, gsz = (nM - fm) < WGM ? (nM - fm) : WGM;
        u.pm = fm + ((wgid % nig) % gsz); u.pn = (wgid % nig) / gsz; u.koff = 0; return true;
    }
    __device__ __forceinline__ void a_ready(const Unit&) const {}
    __device__ __forceinline__ void done(const Unit&) const {}
};

template <class Epi, class Sched, bool STAMP = false>
__device__ __forceinline__ void gemm_phase(PG8_LAS unsigned char* lds, const Gemm g, const Sched& S, const Epi& E, unsigned long long* stamps) {
    const int tid = ltid(), wid = __builtin_amdgcn_readfirstlane(tid >> 6), lane = tid & 63, wr = wid >> 2, wc = wid & 3, fr = lane & 15, fq = lane >> 4;
    const int K = g.ld, nt = g.K / BK;
    int ts_lo = 0, ts_hi = 0, nts = 0; const unsigned long long rt_entry = STAMP ? (unsigned long long)wall_clock64() : 0ull;
#define PG8_STAMP() do { if (STAMP && wid == 0 && nts < 64) { const unsigned long long _c = (unsigned long long)clock64(); \
        ts_lo = (lane == nts) ? (int)(unsigned)_c : ts_lo; ts_hi = (lane == nts) ? (int)(unsigned)(_c >> 32) : ts_hi; ++nts; } } while (0)
    PG8_STAMP();
    unsigned voffA[2], voffB[2];
#pragma unroll
    for (int i = 0; i < 2; ++i) { int R, C; stage_rc(tid * 16 + i * 8192, R, C); const int Rb = Epi::PERM ? ((R & ~31) + perm32(R & 31)) : R;
        voffA[i] = (unsigned)(R * K + C) * 2u; voffB[i] = (unsigned)(Rb * K + C) * 2u; }
    const size_t kstep = (size_t)(BK * 2);
    const size_t hstep = (size_t)HALF * K * 2;
    const size_t tstep = 2 * hstep;
    const unsigned ldsw = (unsigned)wid * 1024u;
    const int aoff = lds_byte(wr * 64 + fr, fq * 8), boff = lds_byte(wc * 32 + fr, fq * 8);
#define PG8_SA(b, h) (((b) * 2 + (h)) * HTB)
#define PG8_SB(b, h) ((4 + (b) * 2 + (h)) * HTB)
#define PG8_STAGE(bufoff, gbase, voff) do { _Pragma("unroll") for (int _i = 0; _i < 2; ++_i) \
        __builtin_amdgcn_global_load_lds((const unsigned*)((const char*)(gbase) + (voff)[_i]), (PG8_LAS unsigned*)(lds + (bufoff) + ldsw + _i * 8192), 16, 0, 0); } while (0)
#define PG8_LDA(dst, b, h) do { _Pragma("unroll") for (int m = 0; m < 4; ++m) _Pragma("unroll") for (int k = 0; k < 2; ++k) dst[m][k] = *(const PG8_LAS bf16x8*)(lds + PG8_SA(b, h) + aoff + m * 2048 + k * 1024); } while (0)
#define PG8_LDB(dst, b, h) do { _Pragma("unroll") for (int n = 0; n < 2; ++n) _Pragma("unroll") for (int k = 0; k < 2; ++k) dst[n][k] = *(const PG8_LAS bf16x8*)(lds + PG8_SB(b, h) + boff + n * 2048 + k * 1024); } while (0)
#define PG8_MMA(ai, bj, At, Bt) do { __builtin_amdgcn_s_setprio(1); _Pragma("unroll") for (int m = 0; m < 4; ++m) _Pragma("unroll") for (int n = 0; n < 2; ++n) _Pragma("unroll") for (int k = 0; k < 2; ++k) \
        acc[ai][bj][m][n] = __builtin_amdgcn_mfma_f32_16x16x32_bf16(Bt[n][k], At[m][k], acc[ai][bj][m][n], 0, 0, 0); __builtin_amdgcn_s_setprio(0); } while (0)
#define PG8_WAIT_V(n) asm volatile("s_waitcnt vmcnt(" #n ")" ::: "memory")
#define PG8_WAIT_L(n) asm volatile("s_waitcnt lgkmcnt(" #n ")" ::: "memory")
#define PG8_BAR __builtin_amdgcn_s_barrier()
#define PG8_SCHED __builtin_amdgcn_sched_barrier(0)
    Unit cur, nxt; int ui = 0;
    if (!S.next(0, cur)) return;
    f32x4 acc[2][2][4][2];
#pragma unroll
    for (int a = 0; a < 2; ++a)
#pragma unroll
        for (int b = 0; b < 2; ++b)
#pragma unroll
            for (int m = 0; m < 4; ++m)
#pragma unroll
                for (int n = 0; n < 2; ++n) acc[a][b][m][n] = (f32x4){0.f, 0.f, 0.f, 0.f};
    bf16x8 At[4][2], B0[2][2], B1[2][2];
    const char* cA = (const char*)g.A + (size_t)cur.pm * tstep + (size_t)cur.koff * 2; const char* cB = (const char*)g.Bt + (size_t)cur.pn * tstep + (size_t)cur.koff * 2;
    S.a_ready(cur);
    PG8_STAGE(PG8_SB(0, 0), cB, voffB); PG8_STAGE(PG8_SA(0, 0), cA, voffA); PG8_STAGE(PG8_SB(0, 1), cB + hstep, voffB); PG8_STAGE(PG8_SA(0, 1), cA + hstep, voffA);
    if (wr == 1) PG8_BAR;
    PG8_WAIT_V(4); PG8_BAR;
    PG8_STAGE(PG8_SB(1, 0), cB + kstep, voffB); PG8_STAGE(PG8_SA(1, 0), cA + kstep, voffA); PG8_STAGE(PG8_SB(1, 1), cB + hstep + kstep, voffB);
    PG8_WAIT_V(6); PG8_BAR;
    PG8_STAMP();
    for (;;) {
        const bool has_next = S.next(ui + 1, nxt);
        const char* nA = has_next ? (const char*)g.A + (size_t)nxt.pm * tstep + (size_t)nxt.koff * 2 : cA; const char* nB = has_next ? (const char*)g.Bt + (size_t)nxt.pn * tstep + (size_t)nxt.koff * 2 : cB;
        for (int t = 0; t < nt; t += 2) {
            const bool last = (t == nt - 2);
            const char* a1 = cA + (size_t)(t + 1) * kstep;
            const char* a2 = last ? nA : cA + (size_t)(t + 2) * kstep; const char* b2 = last ? nB : cB + (size_t)(t + 2) * kstep;
            const char* a3 = a2 + kstep; const char* b3 = b2 + kstep;
            if (last && has_next) S.a_ready(nxt);
            PG8_LDB(B0, 0, 0); PG8_SCHED; PG8_LDA(At, 0, 0); PG8_STAGE(PG8_SA(1, 1), a1 + hstep, voffA);
            PG8_WAIT_L(8); PG8_BAR; PG8_WAIT_L(0); PG8_MMA(0, 0, At, B0); PG8_BAR; PG8_SCHED;
            PG8_LDB(B1, 0, 1); PG8_STAGE(PG8_SB(0, 0), b2, voffB);
            PG8_BAR; PG8_WAIT_L(0); PG8_MMA(0, 1, At, B1); PG8_BAR;
            PG8_LDA(At, 0, 1); PG8_STAGE(PG8_SA(0, 0), a2, voffA);
            PG8_BAR; PG8_WAIT_L(0); PG8_MMA(1, 0, At, B0); PG8_BAR; PG8_SCHED;
            PG8_STAGE(PG8_SB(0, 1), b2 + hstep, voffB);
            PG8_WAIT_V(6); PG8_BAR; PG8_MMA(1, 1, At, B1); PG8_BAR;
            PG8_LDB(B0, 1, 0); PG8_SCHED; PG8_LDA(At, 1, 0); PG8_STAGE(PG8_SA(0, 1), a2 + hstep, voffA);
            PG8_WAIT_L(8); PG8_BAR; PG8_WAIT_L(0); PG8_MMA(0, 0, At, B0); PG8_BAR; PG8_SCHED;
            PG8_LDB(B1, 1, 1); PG8_STAGE(PG8_SB(1, 0), b3, voffB);
            PG8_BAR; PG8_WAIT_L(0); PG8_MMA(0, 1, At, B1); PG8_BAR;
            PG8_LDA(At, 1, 1); PG8_STAGE(PG8_SA(1, 0), a3, voffA);
            PG8_BAR; PG8_WAIT_L(0); PG8_MMA(1, 0, At, B0); PG8_BAR; PG8_SCHED;
            PG8_STAGE(PG8_SB(1, 1), b3 + hstep, voffB);
            PG8_WAIT_V(6); PG8_BAR; PG8_MMA(1, 1, At, B1); PG8_BAR;
        }
        PG8_STAMP();
        if constexpr (!Epi::AFTER_DRAIN) { E(acc, cur, wr, wc, fr, fq); S.done(cur); }
        PG8_STAMP();
        if (!has_next) break;
#pragma unroll
        for (int a = 0; a < 2; ++a)
#pragma unroll
            for (int b = 0; b < 2; ++b)
#pragma unroll
                for (int m = 0; m < 4; ++m)
#pragma unroll
                    for (int n = 0; n < 2; ++n) acc[a][b][m][n] = (f32x4){0.f, 0.f, 0.f, 0.f};
        cur = nxt; cA = nA; cB = nB; ++ui;
    }
    PG8_WAIT_V(0);
    if (wr == 0) PG8_BAR;
    PG8_BAR;
    if constexpr (Epi::AFTER_DRAIN) { E.fused(acc, cur, wr, wc, fr, fq, lds, wid, lane); S.done(cur); }
    PG8_STAMP();
    if (STAMP && wid == 0) { stamps[lane] = lane < nts ? (((unsigned long long)(unsigned)ts_hi << 32) | (unsigned)ts_lo) : 0ull;
        if (lane == 62) stamps[62] = rt_entry; if (lane == 63) stamps[63] = (unsigned long long)wall_clock64(); }
#undef PG8_STAMP
#undef PG8_SA
#undef PG8_SB
#undef PG8_STAGE
#undef PG8_LDA
#undef PG8_LDB
#undef PG8_MMA
#undef PG8_WAIT_V
#undef PG8_WAIT_L
#undef PG8_BAR
#undef PG8_SCHED
}
}

using pg8::f32x4; using pg8::u32x4;
#define EPI_ROWLOOP _Pragma("unroll") for (int ai = 0; ai < 2; ++ai) _Pragma("unroll") for (int m = 0; m < 4; ++m)
struct EHyIn {
  static constexpr bool PERM = true, AFTER_DRAIN = false;
  u16* o; const float* bias;
  DI void operator()(const f32x4 (&acc)[2][2][4][2], const pg8::Unit& u, int wr, int wc, int fr, int fq) const {
    const int row0 = u.pm * 256 + wr * 64 + fr, col0 = u.pn * 256 + wc * 32 + 8 * fq;
    EPI_ROWLOOP {
      const int row = row0 + ai * 128 + m * 16;
      const float bz = bias[row];
      u16* rp = o + (size_t)row * NTOK + col0;
#pragma unroll
      for (int bj = 0; bj < 2; ++bj) {
        const f32x4 v0 = acc[ai][bj][m][0], v1 = acc[ai][bj][m][1];
        u32x4 w; w.x = pk2(v0[0] + bz, v0[1] + bz); w.y = pk2(v0[2] + bz, v0[3] + bz); w.z = pk2(v1[0] + bz, v1[1] + bz); w.w = pk2(v1[2] + bz, v1[3] + bz);
        *(u32x4*)(rp + bj * 128) = w;
      }
    }
  }
};
struct ERes {
  static constexpr bool PERM = false, AFTER_DRAIN = false;
  const float* bias; const float* gate; int gofs; const float* xsl; const float* xsc; float* xdl; float* xdc;
  DI void operator()(const f32x4 (&acc)[2][2][4][2], const pg8::Unit& u, int wr, int wc, int fr, int fq) const {
    const int rowu = u.pm * 256;
    const int row0 = rowu + wr * 64 + fr, col0 = u.pn * 256 + wc * 32 + 4 * fq;
    const float* gp = gate + mod_index(rowu) * 6144 + gofs;
    const float* xs; float* xd;
    if (rowu < NL) { xs = xsl; xd = xdl; } else { xs = xsc - (size_t)NL * 1024; xd = xdc - (size_t)NL * 1024; }
#pragma unroll
    for (int bj = 0; bj < 2; ++bj)
#pragma unroll
      for (int n = 0; n < 2; ++n) {
        const f32x4 gv = *(const f32x4*)(gp + col0 + bj * 128 + n * 16);
        const f32x4 bv = bias ? *(const f32x4*)(bias + col0 + bj * 128 + n * 16) : (f32x4){0.f, 0.f, 0.f, 0.f};
        EPI_ROWLOOP {
          const size_t ro = (size_t)(row0 + ai * 128 + m * 16) * 1024 + col0 + bj * 128 + n * 16;
          const f32x4 xv = *(const f32x4*)(xs + ro);
          *(f32x4*)(xd + ro) = xv + gv * (acc[ai][bj][m][n] + bv);
        }
      }
  }
};
struct EResAtomic {
  static constexpr bool PERM = false, AFTER_DRAIN = false;
  const float* gate; float* xbase;
  DI void operator()(const f32x4 (&acc)[2][2][4][2], const pg8::Unit& u, int wr, int wc, int fr, int fq) const {
    const int row0 = u.pm * 256 + wr * 64 + fr, col0 = u.pn * 256 + wc * 32 + 4 * fq;
#pragma unroll
    for (int bj = 0; bj < 2; ++bj)
#pragma unroll
      for (int n = 0; n < 2; ++n) {
        const f32x4 gv = *(const f32x4*)(gate + col0 + bj * 128 + n * 16);
        EPI_ROWLOOP {
          float* xp = xbase + (size_t)(row0 + ai * 128 + m * 16) * 1024 + col0 + bj * 128 + n * 16;
          const f32x4 v = gv * acc[ai][bj][m][n];
          unsafeAtomicAdd(xp + 0, v[0]); unsafeAtomicAdd(xp + 1, v[1]); unsafeAtomicAdd(xp + 2, v[2]); unsafeAtomicAdd(xp + 3, v[3]);
        }
      }
  }
};
template <int MODE> struct EBf16 {
  static constexpr bool PERM = true, AFTER_DRAIN = false;
  u16* o; int ldc; int ncols;
  DI void operator()(const f32x4 (&acc)[2][2][4][2], const pg8::Unit& u, int wr, int wc, int fr, int fq) const {
    const int row0 = u.pm * 256 + wr * 64 + fr, col0 = u.pn * 256 + wc * 32 + 8 * fq;
    EPI_ROWLOOP {
      u16* rp = o + (size_t)(row0 + ai * 128 + m * 16) * ldc + col0;
#pragma unroll
      for (int bj = 0; bj < 2; ++bj) {
        f32x4 v0 = acc[ai][bj][m][0], v1 = acc[ai][bj][m][1];
        if (MODE == 1) {
#pragma unroll
          for (int j = 0; j < 4; ++j) { const float a = fmaxf(v0[j], 0.f), b = fmaxf(v1[j], 0.f); v0[j] = a * a; v1[j] = b * b; }
        }
        if (MODE == 2) { v0 = v0 * (0.07216878364870322f * 1.4426950408889634f); v1 = v1 * (0.07216878364870322f * 1.4426950408889634f); }
        u32x4 w; w.x = pk2(v0[0], v0[1]); w.y = pk2(v0[2], v0[3]); w.z = pk2(v1[0], v1[1]); w.w = pk2(v1[2], v1[3]);
        if (col0 + bj * 128 < ncols) *(u32x4*)(rp + bj * 128) = w;
      }
    }
  }
};
struct EMlaK {
  static constexpr bool PERM = true, AFTER_DRAIN = false;
  u16* o;
  DI void operator()(const f32x4 (&acc)[2][2][4][2], const pg8::Unit& u, int wr, int wc, int fr, int fq) const {
    const int row0 = u.pm * 256 + wr * 64 + fr, col0 = u.pn * 256 + wc * 32 + 8 * fq;
    EPI_ROWLOOP {
      const int row = row0 + ai * 128 + m * 16;
      int b, key;
      if (row < NL) { b = row >> 13; key = NCTX + (row & 8191); } else { b = (row - NL) >> 8; key = (row - NL) & 255; }
#pragma unroll
      for (int bj = 0; bj < 2; ++bj) {
        const int n = col0 + bj * 128, hd = n >> 7, c = n & 127;
        const f32x4 v0 = acc[ai][bj][m][0], v1 = acc[ai][bj][m][1];
        u32x4 w; w.x = pk2(v0[0], v0[1]); w.y = pk2(v0[2], v0[3]); w.z = pk2(v1[0], v1[1]); w.w = pk2(v1[2], v1[3]);
        *(u32x4*)(o + ((size_t)(b * 8 + hd) * NKEY + key) * 128 + c) = w;
      }
    }
  }
};
struct EMlaVT {
  static constexpr bool PERM = true, AFTER_DRAIN = false;
  u16* o;
  DI void operator()(const f32x4 (&acc)[2][2][4][2], const pg8::Unit& u, int wr, int wc, int fr, int fq) const {
    const int row0 = u.pm * 256 + wr * 64 + fr, col0 = u.pn * 256 + wc * 32 + 8 * fq;
#pragma unroll
    for (int bj = 0; bj < 2; ++bj) {
      const int tok = col0 + bj * 128;
      int b, key;
      if (tok < NL) { b = tok >> 13; key = NCTX + (tok & 8191); } else { b = (tok - NL) >> 8; key = (tok - NL) & 255; }
      EPI_ROWLOOP {
        const int vr = row0 + ai * 128 + m * 16, hd = vr >> 7, dv = vr & 127;
        const f32x4 v0 = acc[ai][bj][m][0], v1 = acc[ai][bj][m][1];
        u32x4 w; w.x = pk2(v0[0], v0[1]); w.y = pk2(v0[2], v0[3]); w.z = pk2(v1[0], v1[1]); w.w = pk2(v1[2], v1[3]);
        *(u32x4*)(o + ((size_t)(b * 8 + hd) * 128 + dv) * NKEY + key) = w;
      }
    }
  }
};
struct SplitKOrder {
  int nM, nN, nwg, G, c, klen;
  DI void init(int M, int N, int pieces, int klen_, int G_, int c_) { nM = M / 256; nN = N / 256; nwg = nM * nN * pieces; G = G_; c = c_; klen = klen_; }
  DI bool next(int i, pg8::Unit& u) const {
    const int L = i * G + c; if (L >= nwg) return false;
    const int t = L % (nM * nN), piece = L / (nM * nN);
    u.pm = t / nN; u.pn = t % nN; u.koff = piece * klen; return true;
  }
  DI void a_ready(const pg8::Unit&) const {}
  DI void done(const pg8::Unit&) const {}
};
template <class Epi>
DI void gemm8_splitk(const u16* A, const u16* Bt, int M, int N, int K, int pieces, const Epi& E, unsigned char* smem, int bid, int nblk) {
  asm volatile("" : "+s"(K));
  pg8::Gemm g; g.A = A; g.Bt = Bt; g.M = M; g.N = N; g.K = K / pieces; g.ld = K;
  SplitKOrder S; S.init(M, N, pieces, K / pieces, nblk, bid);
  __syncthreads();
  pg8::gemm_phase<Epi, SplitKOrder, false>((PG8_LAS unsigned char*)smem, g, S, E, nullptr);
  __syncthreads();
}
template <class Epi>
DI void gemm8(const u16* A, const u16* Bt, int M, int N, int K, const Epi& E, unsigned char* smem, int bid, int nblk) {
  asm volatile("" : "+s"(K));
  pg8::Gemm g; g.A = A; g.Bt = Bt; g.M = M; g.N = N; g.K = K; g.ld = K;
  pg8::StaticOrder S; S.init(M, N, nblk, bid);
  __syncthreads();
  pg8::gemm_phase<Epi, pg8::StaticOrder, false>((PG8_LAS unsigned char*)smem, g, S, E, nullptr);
  __syncthreads();
}

DI void pro_weights(const Params& P, unsigned char* smem, int bid, int nblk) {
  float* t = (float*)smem;
  const int tid = ltid();
  for (int tile = bid; tile < P.total_mat_tiles; tile += nblk) {
    int mi = 0, rem = tile;
    while (rem >= P.mats[mi].tiles) { rem -= P.mats[mi].tiles; ++mi; }
    const MatDesc md = P.mats[mi];
    const int ntn = md.Np / 256;
    const int k0 = (rem / ntn) * 64, n0 = (rem % ntn) * 256;
    u16* dst = (u16*)(lws(P) + OFF_WT) + md.dst;
    float4 v[8];
#pragma unroll
    for (int pass = 0; pass < 8; ++pass) {
      const int kr = (tid >> 6) + pass * 8, nc = (tid & 63) * 4;
      v[pass] = make_float4(0.f, 0.f, 0.f, 0.f);
      if (n0 + nc < md.N) v[pass] = *(const float4*)(md.src + (size_t)(k0 + kr) * md.N + n0 + nc);
    }
#pragma unroll
    for (int pass = 0; pass < 8; ++pass) {
      const int kr = (tid >> 6) + pass * 8, nc = (tid & 63) * 4;
      float* tp = t + kr * 257 + nc;
      tp[0] = v[pass].x; tp[1] = v[pass].y; tp[2] = v[pass].z; tp[3] = v[pass].w;
    }
    __syncthreads();
    {
      const int n = tid >> 1, kc = (tid & 1) * 32;
      int nr = n0 + n;
      if (md.perm) nr = ((nr & 255) < 128 ? 0 : 1024) + (nr >> 8) * 128 + (nr & 127);
      u16* dp = dst + (size_t)nr * md.K + k0 + kc;
#pragma unroll
      for (int g = 0; g < 4; ++g) {
        uint4 o;
        o.x = pk2(t[(kc + g * 8 + 0) * 257 + n], t[(kc + g * 8 + 1) * 257 + n]);
        o.y = pk2(t[(kc + g * 8 + 2) * 257 + n], t[(kc + g * 8 + 3) * 257 + n]);
        o.z = pk2(t[(kc + g * 8 + 4) * 257 + n], t[(kc + g * 8 + 5) * 257 + n]);
        o.w = pk2(t[(kc + g * 8 + 6) * 257 + n], t[(kc + g * 8 + 7) * 257 + n]);
        *(uint4*)(dp + g * 8) = o;
      }
    }
    __syncthreads();
  }
}

DI void pro_adaln(const Params& P, unsigned char* smem, int bid, int nblk) {
  float* sc = (float*)smem;
  float* red = sc + 5 * 1024;
  float* modw = (float*)(lws(P) + OFF_MOD);
  const int tid = ltid();
  for (int u = bid; u < 4 * 48; u += nblk) {
    const int li = u / 48, n0 = (u % 48) * 128;
    for (int e = tid; e < 5 * 1024; e += NT) {
      const int mi = e >> 10, k = e & 1023;
      const float v = mi < 4 ? P.c[mi * 1024 + k] : P.c_ctx[k];
      sc[e] = silu(v);
    }
    __syncthreads();
    const int nq = tid & 31, kg = tid >> 5;
    float acc[5][4];
#pragma unroll
    for (int a = 0; a < 5; ++a)
#pragma unroll
      for (int b = 0; b < 4; ++b) acc[a][b] = 0.f;
    const float* w = P.ada_w + (size_t)li * 1024 * 6144 + n0 + nq * 4;
    for (int kk = 0; kk < 64; ++kk) {
      const int k = kg * 64 + kk;
      const float4 wv = *(const float4*)(w + (size_t)k * 6144);
#pragma unroll
      for (int a = 0; a < 5; ++a) {
        const float s = sc[a * 1024 + k];
        acc[a][0] += s * wv.x; acc[a][1] += s * wv.y; acc[a][2] += s * wv.z; acc[a][3] += s * wv.w;
      }
    }
#pragma unroll
    for (int a = 0; a < 5; ++a)
#pragma unroll
      for (int b = 0; b < 4; ++b) red[(kg * 5 + a) * 128 + nq * 4 + b] = acc[a][b];
    __syncthreads();
    for (int e = tid; e < 5 * 128; e += NT) {
      const int a = e >> 7, n = e & 127;
      float s = P.ada_b[li * 6144 + n0 + n];
#pragma unroll
      for (int g = 0; g < 16; ++g) s += red[(g * 5 + a) * 128 + n];
      modw[(size_t)(li * 5 + a) * 6144 + n0 + n] = s;
    }
    __syncthreads();
  }
}

DI void pro_filter_mlp(const Params& P, int bid, int nblk) {
  const int lane = ltid() & 63, wv = ltid() >> 6;
  u16* h3 = (u16*)(lws(P) + OFF_H3);
  for (int task = bid * 8 + wv; task < 2 * KTL; task += nblk * 8) {
    const int j = task / KTL, row = task % KTL;
    const int L = row < SEQ ? SEQ : NCTX;
    const int l = row < SEQ ? row : row - SEQ;
    const float* w1 = P.hy_f_w1 + j * 33 * 64; const float* b1 = P.hy_f_b1 + j * 64;
    const float* w2 = P.hy_f_w2 + j * 64 * 64; const float* b2 = P.hy_f_b2 + j * 64;
    const float* w3 = P.hy_f_w3 + j * 64 * 64; const float* b3 = P.hy_f_b3 + j * 64;
    const float fr = P.hy_freq[j * 64 + lane];
    const float tl = (float)l / (float)(L - 1);
    const float w = 6.283185307179586f * (float)l / (float)L;
    float zf = 0.f;
    if (lane == 0) zf = tl;
    else if (lane <= 32) {
      const int bi = (lane - 1) & 15;
      const float f = 1e-4f + (float)bi * ((15.f - 1e-4f) / 15.f);
      const float a = f * w;
      zf = lane <= 16 ? cosf(a) : -sinf(a);
    }
    float acc = b1[lane];
#pragma unroll
    for (int k = 0; k < 33; ++k) acc += __int_as_float(__builtin_amdgcn_readlane(__float_as_int(zf), k)) * w1[k * 64 + lane];
    float h = sinf(fr * acc);
    acc = b2[lane];
#pragma unroll
    for (int k = 0; k < 64; ++k) acc += __int_as_float(__builtin_amdgcn_readlane(__float_as_int(h), k)) * w2[k * 64 + lane];
    h = sinf(fr * acc);
    acc = b3[lane];
#pragma unroll
    for (int k = 0; k < 64; ++k) acc += __int_as_float(__builtin_amdgcn_readlane(__float_as_int(h), k)) * w3[k * 64 + lane];
    h = sinf(fr * acc);
    h3[((size_t)j * KTL + row) * 64 + lane] = f2bf(h);
  }
}

DI void normmod_phase(const Params& P, int li, int which, int nrows, const float* xl, const float* xc, int bid, int nblk) {
  const int lane = ltid() & 63, wv = ltid() >> 6;
  u16* A = (u16*)(lws(P) + OFF_A);
  const float* g = (which ? P.norm2_g : P.norm1_g) + li * 1024;
  const float* modw = (const float*)(lws(P) + OFF_MOD) + (size_t)li * 5 * 6144;
  for (int row = (bid * 8 + wv) * 2; row < nrows; row += nblk * 16) {
    const float* xr = row < NL ? xl + (size_t)row * 1024 : xc + (size_t)(row - NL) * 1024;
    const float* md = modw + mod_index(row) * 6144 + (which ? 3 * 1024 : 0);
    float4 v0[4], v1[4];
#pragma unroll
    for (int j = 0; j < 4; ++j) { v0[j] = *(const float4*)(xr + j * 256 + lane * 4); v1[j] = *(const float4*)(xr + 1024 + j * 256 + lane * 4); }
    float s0 = 0.f, s1 = 0.f;
#pragma unroll
    for (int j = 0; j < 4; ++j) {
      s0 += v0[j].x * v0[j].x + v0[j].y * v0[j].y + v0[j].z * v0[j].z + v0[j].w * v0[j].w;
      s1 += v1[j].x * v1[j].x + v1[j].y * v1[j].y + v1[j].z * v1[j].z + v1[j].w * v1[j].w;
    }
    s0 = wave_sum(s0, lane); s1 = wave_sum(s1, lane);
    const float r0 = rsqrtf(s0 * (1.f / 1024.f) + EPS), r1 = rsqrtf(s1 * (1.f / 1024.f) + EPS);
#pragma unroll
    for (int j = 0; j < 4; ++j) {
      const int k = j * 256 + lane * 4;
      const float4 gg = *(const float4*)(g + k);
      const float4 sh = *(const float4*)(md + k);
      const float4 sc = *(const float4*)(md + 1024 + k);
      const float mx = gg.x * (1.f + sc.x), my = gg.y * (1.f + sc.y), mz = gg.z * (1.f + sc.z), mw = gg.w * (1.f + sc.w);
      uint2 o0, o1;
      o0.x = pk2(v0[j].x * r0 * mx + sh.x, v0[j].y * r0 * my + sh.y); o0.y = pk2(v0[j].z * r0 * mz + sh.z, v0[j].w * r0 * mw + sh.w);
      o1.x = pk2(v1[j].x * r1 * mx + sh.x, v1[j].y * r1 * my + sh.y); o1.y = pk2(v1[j].z * r1 * mz + sh.z, v1[j].w * r1 * mw + sh.w);
      *(uint2*)(A + (size_t)row * 1024 + k) = o0;
      *(uint2*)(A + (size_t)(row + 1) * 1024 + k) = o1;
    }
  }
}

DI void final_norm_phase(const Params& P, int bid, int nblk) {
  const int lane = ltid() & 63, wv = ltid() >> 6;
  for (int row = (bid * 8 + wv) * 2; row < NL; row += nblk * 16) {
    float* xr = P.out + (size_t)row * 1024;
    float4 v0[4], v1[4];
#pragma unroll
    for (int j = 0; j < 4; ++j) { v0[j] = *(const float4*)(xr + j * 256 + lane * 4); v1[j] = *(const float4*)(xr + 1024 + j * 256 + lane * 4); }
    float s0 = 0.f, s1 = 0.f;
#pragma unroll
    for (int j = 0; j < 4; ++j) {
      s0 += v0[j].x * v0[j].x + v0[j].y * v0[j].y + v0[j].z * v0[j].z + v0[j].w * v0[j].w;
      s1 += v1[j].x * v1[j].x + v1[j].y * v1[j].y + v1[j].z * v1[j].z + v1[j].w * v1[j].w;
    }
    s0 = wave_sum(s0, lane); s1 = wave_sum(s1, lane);
    const float r0 = rsqrtf(s0 * (1.f / 1024.f) + EPS), r1 = rsqrtf(s1 * (1.f / 1024.f) + EPS);
#pragma unroll
    for (int j = 0; j < 4; ++j) {
      const int k = j * 256 + lane * 4;
      const float4 gg = *(const float4*)(P.final_g + k);
      float4 o0, o1;
      o0.x = v0[j].x * r0 * gg.x; o0.y = v0[j].y * r0 * gg.y; o0.z = v0[j].z * r0 * gg.z; o0.w = v0[j].w * r0 * gg.w;
      o1.x = v1[j].x * r1 * gg.x; o1.y = v1[j].y * r1 * gg.y; o1.z = v1[j].z * r1 * gg.z; o1.w = v1[j].w * r1 * gg.w;
      *(float4*)(xr + k) = o0;
      *(float4*)(xr + 1024 + k) = o1;
    }
  }
}

enum { EPI_HYIN = 0, EPI_FILT, EPI_RES, EPI_MLP1, EPI_GLAIN, EPI_MLADN, EPI_MLAQ, EPI_MLAKV };
struct EpiArgs {
  const float* bias;
  const float* gate;
  int gofs;
  const float* xsl; const float* xsc;
  float* xdl; float* xdc;
  u16* o0; u16* o1;
  int mrow0;
  int L;
};

constexpr int GS = 72;

template <int EPI>
DI void epi_tile(const EpiArgs& ea, const f32x16& acc, int mb, int nb, int lane) {
  const int r = lane & 31, h = lane >> 5;
  if constexpr (EPI == EPI_HYIN) {
    u16* base = ea.o0 + (size_t)nb * NTOK + mb;
    const float* bp = ea.bias + nb;
    const int voff = 4 * h * NTOK + r;
#pragma unroll
    for (int i = 0; i < 16; ++i) {
      const int rc = (i & 3) + 8 * (i >> 2);
      base[rc * NTOK + voff] = f2bf(acc[i] + bp[rc + 4 * h]);
    }
  } else if constexpr (EPI == EPI_FILT) {
    const int l = mb + r;
    const float t = (float)l / (float)(ea.L - 1);
    u16* base = ea.o0 + (size_t)nb * KTL + ea.mrow0 + mb;
    const int voff = 4 * h * KTL + r;
#pragma unroll
    for (int i = 0; i < 16; ++i) {
      const int rc = (i & 3) + 8 * (i >> 2);
      const int d = (nb + rc + 4 * h) & 1023;
      const float mind = -3.0701134573253945f, maxd = -15.350567286626972f;
      const float delta = mind + (float)d * ((maxd - mind) / 1023.f);
      base[rc * KTL + voff] = f2bf(acc[i] * __expf(-t * fabsf(delta)));
    }
  } else if constexpr (EPI == EPI_RES) {
    const int n = nb + r;
    const float bz = ea.bias ? ea.bias[n] : 0.f;
    const float gt = ea.gate[mod_index(mb) * 6144 + ea.gofs + n];
    const float* xs; float* xd;
    if (mb < NL) { xs = ea.xsl + (size_t)mb * 1024 + nb; xd = ea.xdl + (size_t)mb * 1024 + nb; }
    else { xs = ea.xsc + (size_t)(mb - NL) * 1024 + nb; xd = ea.xdc + (size_t)(mb - NL) * 1024 + nb; }
    const int voff = 4 * h * 1024 + r;
#pragma unroll
    for (int i = 0; i < 16; ++i) {
      const int rc = (i & 3) + 8 * (i >> 2);
      xd[rc * 1024 + voff] = xs[rc * 1024 + voff] + gt * (acc[i] + bz);
    }
  } else if constexpr (EPI == EPI_MLP1) {
    u16* base = ea.o0 + (size_t)mb * HID + nb;
    const int voff = 4 * h * HID + r;
#pragma unroll
    for (int i = 0; i < 16; ++i) {
      const int rc = (i & 3) + 8 * (i >> 2);
      const float v = fmaxf(acc[i], 0.f);
      base[rc * HID + voff] = f2bf(v * v);
    }
  } else if constexpr (EPI == EPI_GLAIN) {
    if (nb < GLA_N) {
      u16* base = ea.o0 + (size_t)mb * GLA_N + nb;
      const int voff = 4 * h * GLA_N + r;
#pragma unroll
      for (int i = 0; i < 16; ++i) {
        const int rc = (i & 3) + 8 * (i >> 2);
        base[rc * GLA_N + voff] = f2bf(acc[i]);
      }
    }
  } else if constexpr (EPI == EPI_MLADN) {
    u16* base = ea.o0 + (size_t)mb * MLA_DNP + nb;
    const int voff = 4 * h * MLA_DNP + r;
#pragma unroll
    for (int i = 0; i < 16; ++i) {
      const int rc = (i & 3) + 8 * (i >> 2);
      base[rc * MLA_DNP + voff] = f2bf(acc[i]);
    }
  } else if constexpr (EPI == EPI_MLAQ) {
    const int n = nb + r;
    const int hd = n / 192, c = n % 192;
    const float qs = 0.07216878364870322f * 1.4426950408889634f;
    const bool isr = c >= 128;
    const int cc = c - 128;
    const int jj = cc & 15;
    const bool first = (cc & 31) < 16;
    const float invf = __expf(-(float)jj * (9.210340371976184f / 16.f));
#pragma unroll
    for (int i = 0; i < 16; ++i) {
      const int m = mb + crow(i, h);
      const int b = m >> 13, l = m & 8191;
      float v = acc[i];
      const float pv = shx(v, 16, lane);
      if (isr) {
        const float pos = (float)((cc < 32) ? (l >> 6) : (l & 63));
        const float ang = pos * invf;
        float sn, cs;
        __sincosf(ang, &sn, &cs);
        v = first ? (v * cs - pv * sn) : (pv * sn + v * cs);
      }
      ea.o0[((size_t)(b * 8 + hd) * SEQ + l) * 192 + c] = f2bf(v * qs);
    }
  } else if constexpr (EPI == EPI_MLAKV) {
    const int n = nb + r;
    const int hd = n >> 8, c = n & 255;
#pragma unroll
    for (int g = 0; g < 4; ++g) {
      const int m = mb + 8 * g + 4 * h;
      int b, key;
      if (m < NL) { b = m >> 13; key = NCTX + (m & 8191); } else { b = (m - NL) >> 8; key = (m - NL) & 255; }
      if (c < 128) {
#pragma unroll
        for (int q = 0; q < 4; ++q) ea.o0[((size_t)(b * 8 + hd) * NKEY + key + q) * 128 + c] = f2bf(acc[4 * g + q]);
      } else {
        u16x4 o;
#pragma unroll
        for (int q = 0; q < 4; ++q) o[q] = f2bf(acc[4 * g + q]);
        *(u16x4*)(ea.o1 + ((size_t)(b * 8 + hd) * 128 + (c - 128)) * NKEY + key) = o;
      }
    }
  }
}

template <int EPI>
DI void gemm_phase(const u16* __restrict__ A, int lda, const u16* __restrict__ WT, int K, int mtiles, int ntiles,
                   const EpiArgs& ea, unsigned char* smem, int bid, int nblk) {
  constexpr bool SWAP = (EPI == EPI_HYIN || EPI == EPI_FILT);
  u16* As = (u16*)smem;
  u16* Bs = As + 2 * 256 * GS;
  const int tid = ltid(), lane = tid & 63, wv = __builtin_amdgcn_readfirstlane(tid >> 6);
  const int wm = wv & 1, wn = wv >> 1;
  const int r = lane & 31, h = lane >> 5;
  const int nk = K / 64;
  const int lrow = tid >> 3, lcol = (tid & 7) * 8;
  for (int tile = bid; tile < mtiles * ntiles; tile += nblk) {
    const int mt = tile / ntiles, nt = tile % ntiles;
    const int m0 = mt * 256, n0 = nt * 256;
    const u16* Ag = A + (size_t)(m0 + lrow) * lda + lcol;
    const u16* Bg = WT + (size_t)(n0 + lrow) * K + lcol;
    f32x16 c00, c01, c10, c11, c20, c21, c30, c31;
#pragma unroll
    for (int q = 0; q < 16; ++q) { c00[q] = 0.f; c01[q] = 0.f; c10[q] = 0.f; c11[q] = 0.f; c20[q] = 0.f; c21[q] = 0.f; c30[q] = 0.f; c31[q] = 0.f; }
    uint4 r0, r1, r2, r3;
#define G_LDA(k0_)                                             \
    r0 = *(const uint4*)(Ag + (k0_));                              \
    r1 = *(const uint4*)(Ag + (size_t)64 * lda + (k0_));           \
    r2 = *(const uint4*)(Ag + (size_t)128 * lda + (k0_));          \
    r3 = *(const uint4*)(Ag + (size_t)192 * lda + (k0_));
#define G_LDB(k0_)                                             \
    r0 = *(const uint4*)(Bg + (k0_));                              \
    r1 = *(const uint4*)(Bg + (size_t)64 * K + (k0_));             \
    r2 = *(const uint4*)(Bg + (size_t)128 * K + (k0_));            \
    r3 = *(const uint4*)(Bg + (size_t)192 * K + (k0_));
#define G_STX(base_, buf_)                                                  \
    *(uint4*)(base_ + (buf_) * 256 * GS + (lrow) * GS + lcol) = r0;             \
    *(uint4*)(base_ + (buf_) * 256 * GS + (lrow + 64) * GS + lcol) = r1;        \
    *(uint4*)(base_ + (buf_) * 256 * GS + (lrow + 128) * GS + lcol) = r2;       \
    *(uint4*)(base_ + (buf_) * 256 * GS + (lrow + 192) * GS + lcol) = r3;
    __syncthreads();
    G_LDB(0)
    G_STX(Bs, 0)
    G_LDA(0)
    G_STX(As, 0)
    if (nk > 1) { G_LDB(64) }
    __syncthreads();
#pragma unroll 1
    for (int kt = 0; kt < nk; ++kt) {
      const int cur = kt & 1;
      if (kt + 1 < nk) { G_STX(Bs, cur ^ 1) G_LDA((kt + 1) * 64) }
      const u16* as = As + cur * 256 * GS + (wm * 128 + r) * GS + h * 8;
      const u16* bs = Bs + cur * 256 * GS + (wn * 64 + r) * GS + h * 8;
#pragma unroll
      for (int kk = 0; kk < 4; ++kk) {
        const bf16x8 a0 = *(const bf16x8*)(as + kk * 16);
        const bf16x8 a1 = *(const bf16x8*)(as + 32 * GS + kk * 16);
        const bf16x8 a2 = *(const bf16x8*)(as + 64 * GS + kk * 16);
        const bf16x8 a3 = *(const bf16x8*)(as + 96 * GS + kk * 16);
        const bf16x8 b0 = *(const bf16x8*)(bs + kk * 16);
        const bf16x8 b1 = *(const bf16x8*)(bs + 32 * GS + kk * 16);
        if constexpr (SWAP) {
          c00 = MFMA32(b0, a0, c00); c01 = MFMA32(b1, a0, c01); c10 = MFMA32(b0, a1, c10); c11 = MFMA32(b1, a1, c11);
          c20 = MFMA32(b0, a2, c20); c21 = MFMA32(b1, a2, c21); c30 = MFMA32(b0, a3, c30); c31 = MFMA32(b1, a3, c31);
        } else {
          c00 = MFMA32(a0, b0, c00); c01 = MFMA32(a0, b1, c01); c10 = MFMA32(a1, b0, c10); c11 = MFMA32(a1, b1, c11);
          c20 = MFMA32(a2, b0, c20); c21 = MFMA32(a2, b1, c21); c30 = MFMA32(a3, b0, c30); c31 = MFMA32(a3, b1, c31);
        }
        if (kk == 1 && kt + 1 < nk) {
          G_STX(As, cur ^ 1)
          if (kt + 2 < nk) { G_LDB((kt + 2) * 64) }
        }
      }
      __syncthreads();
    }
    const int mb = m0 + wm * 128, nb = n0 + wn * 64;
#define SB __builtin_amdgcn_sched_barrier(0);
    SB epi_tile<EPI>(ea, c00, mb, nb, lane);       SB epi_tile<EPI>(ea, c01, mb, nb + 32, lane);
    SB epi_tile<EPI>(ea, c10, mb + 32, nb, lane);  SB epi_tile<EPI>(ea, c11, mb + 32, nb + 32, lane);
    SB epi_tile<EPI>(ea, c20, mb + 64, nb, lane);  SB epi_tile<EPI>(ea, c21, mb + 64, nb + 32, lane);
    SB epi_tile<EPI>(ea, c30, mb + 96, nb, lane);  SB epi_tile<EPI>(ea, c31, mb + 96, nb + 32, lane); SB
  }
}

DI float2 cmul(float2 a, float2 b) { return make_float2(a.x * b.x - a.y * b.y, a.x * b.y + a.y * b.x); }
DI float2 cmulc(float2 a, float2 b) { return make_float2(a.x * b.x + a.y * b.y, a.y * b.x - a.x * b.y); }
DI float2 twid(float rev) { return make_float2(__builtin_amdgcn_cosf(rev), __builtin_amdgcn_sinf(rev)); }
typedef float f2r_t __attribute__((ext_vector_type(2)));
DI float2 cmulp(float2 y, float2 w) {
  f2r_t yy, ww, t, r; yy.x = y.x; yy.y = y.y; ww.x = w.x; ww.y = w.y;
  asm volatile("s_nop 0\n\tv_pk_mul_f32 %0, %2, %3 op_sel_hi:[1,0]\n\tv_pk_fma_f32 %1, %2, %3, %0 op_sel:[1,1,0] op_sel_hi:[0,1,1] neg_lo:[1,0,0]"
               : "=&v"(t), "=&v"(r) : "v"(yy), "v"(ww));
  return make_float2(r.x, r.y);
}
DI float2 cmulcp(float2 y, float2 w) {
  f2r_t yy, ww, t, r; yy.x = y.x; yy.y = y.y; ww.x = w.x; ww.y = w.y;
  asm volatile("s_nop 0\n\tv_pk_mul_f32 %0, %2, %3 op_sel_hi:[1,0]\n\tv_pk_fma_f32 %1, %2, %3, %0 op_sel:[1,1,0] op_sel_hi:[0,1,1] neg_hi:[1,0,0]"
               : "=&v"(t), "=&v"(r) : "v"(yy), "v"(ww));
  return make_float2(r.x, r.y);
}

#define FWD_BFLY(a0, a1, a2, a3, y0, y1, y2, y3)                                  \
  {                                                                               \
    const float2 t0 = make_float2(a0.x + a2.x, a0.y + a2.y);                      \
    const float2 t1 = make_float2(a0.x - a2.x, a0.y - a2.y);                      \
    const float2 t2 = make_float2(a1.x + a3.x, a1.y + a3.y);                      \
    const float2 t3 = make_float2(a1.y - a3.y, -(a1.x - a3.x));                   \
    y0 = make_float2(t0.x + t2.x, t0.y + t2.y);                                   \
    y1 = make_float2(t1.x + t3.x, t1.y + t3.y);                                   \
    y2 = make_float2(t0.x - t2.x, t0.y - t2.y);                                   \
    y3 = make_float2(t1.x - t3.x, t1.y - t3.y);                                   \
  }
#define INV_BFLY(b0, b1, b2, b3, y0, y1, y2, y3)                                  \
  {                                                                               \
    const float2 t0 = make_float2(b0.x + b2.x, b0.y + b2.y);                      \
    const float2 t1 = make_float2(b0.x - b2.x, b0.y - b2.y);                      \
    const float2 t2 = make_float2(b1.x + b3.x, b1.y + b3.y);                      \
    const float2 t3 = make_float2(-(b1.y - b3.y), b1.x - b3.x);                   \
    y0 = make_float2(t0.x + t2.x, t0.y + t2.y);                                   \
    y1 = make_float2(t1.x + t3.x, t1.y + t3.y);                                   \
    y2 = make_float2(t0.x - t2.x, t0.y - t2.y);                                   \
    y3 = make_float2(t1.x - t3.x, t1.y - t3.y);                                   \
  }

DI int PH(int i) { return i + ((i >> 6) << 2); }
constexpr int FFT_LDS_ELEMS = 16384 + 1024;
template <int QA>
DI void r16_fwd(float2 (&x)[16], int rp) {
  constexpr int QB = QA / 4;
#pragma unroll
  for (int m2 = 0; m2 < 4; ++m2) {
    float2 y0, y1, y2, y3;
    FWD_BFLY(x[0 + m2], x[4 + m2], x[8 + m2], x[12 + m2], y0, y1, y2, y3);
    const float2 w1 = twid(-(float)(m2 * QB + rp) * (1.f / (4.f * QA)));
    const float2 w2 = cmulp(w1, w1), w3 = cmulp(w2, w1);
    x[0 + m2] = y0; x[4 + m2] = cmulp(y1, w1); x[8 + m2] = cmulp(y2, w2); x[12 + m2] = cmulp(y3, w3);
  }
  const float2 v1 = twid(-(float)rp * (1.f / (4.f * QB)));
  const float2 v2 = cmulp(v1, v1), v3 = cmulp(v2, v1);
#pragma unroll
  for (int k1 = 0; k1 < 4; ++k1) {
    float2 y0, y1, y2, y3;
    FWD_BFLY(x[4 * k1 + 0], x[4 * k1 + 1], x[4 * k1 + 2], x[4 * k1 + 3], y0, y1, y2, y3);
    x[4 * k1 + 0] = y0; x[4 * k1 + 1] = cmulp(y1, v1); x[4 * k1 + 2] = cmulp(y2, v2); x[4 * k1 + 3] = cmulp(y3, v3);
  }
}
template <int QA>
DI void r16_inv(float2 (&x)[16], int rp) {
  constexpr int QB = QA / 4;
  const float2 v1 = twid(-(float)rp * (1.f / (4.f * QB)));
  const float2 v2 = cmulp(v1, v1), v3 = cmulp(v2, v1);
#pragma unroll
  for (int k1 = 0; k1 < 4; ++k1) {
    const float2 b0 = x[4 * k1 + 0], b1 = cmulcp(x[4 * k1 + 1], v1), b2 = cmulcp(x[4 * k1 + 2], v2), b3 = cmulcp(x[4 * k1 + 3], v3);
    float2 y0, y1, y2, y3;
    INV_BFLY(b0, b1, b2, b3, y0, y1, y2, y3);
    x[4 * k1 + 0] = y0; x[4 * k1 + 1] = y1; x[4 * k1 + 2] = y2; x[4 * k1 + 3] = y3;
  }
#pragma unroll
  for (int m2 = 0; m2 < 4; ++m2) {
    const float2 w1 = twid(-(float)(m2 * QB + rp) * (1.f / (4.f * QA)));
    const float2 w2 = cmulp(w1, w1), w3 = cmulp(w2, w1);
    const float2 b0 = x[0 + m2], b1 = cmulcp(x[4 + m2], w1), b2 = cmulcp(x[8 + m2], w2), b3 = cmulcp(x[12 + m2], w3);
    float2 y0, y1, y2, y3;
    INV_BFLY(b0, b1, b2, b3, y0, y1, y2, y3);
    x[0 + m2] = y0; x[4 + m2] = y1; x[8 + m2] = y2; x[12 + m2] = y3;
  }
}
template <int QA, bool INV>
DI void r16_pass(float2* buf, int tid) {
  constexpr int QB = QA / 4;
  asm volatile("" : "+v"(tid));
#pragma unroll
  for (int it = 0; it < 2; ++it) {
    const int U = tid + it * NT, rp = U & (QB - 1), ib = (U / QB) * (4 * QA) + rp;
    float2 x[16];
#pragma unroll
    for (int e = 0; e < 16; ++e) x[e] = buf[PH(ib + (e >> 2) * QA + (e & 3) * QB)];
    if (INV) r16_inv<QA>(x, rp); else r16_fwd<QA>(x, rp);
#pragma unroll
    for (int e = 0; e < 16; ++e) buf[PH(ib + (e >> 2) * QA + (e & 3) * QB)] = x[e];
  }
  __syncthreads();
}
DI float sconv(const u16* z, int t, int L, float w0, float w1, float w2, float cb) {
  const float c = bf2f(z[t]);
  const float a = bf2f(z[t > 0 ? t - 1 : 0]);
  const float b = bf2f(z[t < L - 1 ? t + 1 : L - 1]);
  return (t > 0 ? w0 : 0.f) * a + w1 * c + (t < L - 1 ? w2 : 0.f) * b + cb;
}
DI float block_sum(float v, float* red, int tid) {
  v = wave_sum(v, tid & 63);
  __syncthreads();
  if ((tid & 63) == 0) red[tid >> 6] = v;
  __syncthreads();
  float s = 0.f;
#pragma unroll
  for (int i = 0; i < 8; ++i) s += red[i];
  return s;
}

DI void fft_middle(float2* buf, const float2* Kg, int tid) {
#pragma unroll 4
  for (int j = tid; j < 4096; j += NT) {
    float4* p4 = (float4*)(buf + PH(4 * j));
    const float4* k4 = (const float4*)(Kg + 4 * j);
    const float4 u0 = p4[0], u1 = p4[1];
    const float4 k0 = k4[0], k1 = k4[1];
    const float2 a0 = make_float2(u0.x, u0.y), a1 = make_float2(u0.z, u0.w), a2 = make_float2(u1.x, u1.y), a3 = make_float2(u1.z, u1.w);
    float2 y0, y1, y2, y3;
    FWD_BFLY(a0, a1, a2, a3, y0, y1, y2, y3);
    const float2 b0 = cmulp(y0, make_float2(k0.x, k0.y)), b1 = cmulp(y1, make_float2(k0.z, k0.w));
    const float2 b2 = cmulp(y2, make_float2(k1.x, k1.y)), b3 = cmulp(y3, make_float2(k1.z, k1.w));
    float2 z0, z1, z2, z3;
    INV_BFLY(b0, b1, b2, b3, z0, z1, z2, z3);
    p4[0] = make_float4(z0.x, z0.y, z1.x, z1.y);
    p4[1] = make_float4(z2.x, z2.y, z3.x, z3.y);
  }
  __syncthreads();
}
DI void fft_filter_last(const float2* buf, float2* Kg, int tid, float scl, float skp) {
#pragma unroll 4
  for (int j = tid; j < 4096; j += NT) {
    const float4* p4 = (const float4*)(buf + PH(4 * j));
    float4* k4 = (float4*)(Kg + 4 * j);
    const float4 u0 = p4[0], u1 = p4[1];
    const float2 a0 = make_float2(u0.x, u0.y), a1 = make_float2(u0.z, u0.w), a2 = make_float2(u1.x, u1.y), a3 = make_float2(u1.z, u1.w);
    float2 y0, y1, y2, y3;
    FWD_BFLY(a0, a1, a2, a3, y0, y1, y2, y3);
    k4[0] = make_float4(y0.x * scl + skp, y0.y * scl, y1.x * scl + skp, y1.y * scl);
    k4[1] = make_float4(y2.x * scl + skp, y2.y * scl, y3.x * scl + skp, y3.y * scl);
  }
}

DI void hyena_lat_unit(const Params& P, int jl, int d, unsigned char* smem) {
  float2* buf = (float2*)smem;
  float* red = (float*)(smem + (size_t)FFT_LDS_ELEMS * 8);
  const int tid = ltid();
  const u16* zT = (const u16*)(lws(P) + OFF_BIG + B_ZT);
  const u16* kT = (const u16*)(lws(P) + OFF_BIG + B_KT);
  u16* yT = (u16*)(lws(P) + OFF_BIG + B_YT);
  float2* Kg = (float2*)(lws(P) + OFF_A) + (size_t)blockIdx.x * 32768;
#pragma unroll 1
  for (int n = 0; n < 2; ++n) {
    const u16* kf = kT + (size_t)((n * 2 + 0) * 1024 + d) * KTL;
    const u16* kb = kT + (size_t)((n * 2 + 1) * 1024 + d) * KTL;
    float s = 0.f;
#pragma unroll 4
    for (int t = tid; t < SEQ; t += NT) {
      const float f = bf2f(kf[t]);
      const float g = t >= 1 ? bf2f(kb[t]) : 0.f;
      buf[PH(t)] = make_float2(f, 0.f);
      buf[PH(t >= 1 ? 16384 - t : SEQ)] = make_float2(g, 0.f);
      s += fabsf(f) + fabsf(g);
    }
    const float S = block_sum(s, red, tid);
    r16_pass<4096, false>(buf, tid); r16_pass<256, false>(buf, tid); r16_pass<16, false>(buf, tid);
    const float scl = 1.f / (S * 16384.f);
    const float skp = P.hy_bias[(jl * 2 + n) * 1024 + d] * (1.f / 16384.f);
    fft_filter_last(buf, Kg + n * 16384, tid, scl, skp);
    __syncthreads();
  }
  const float* cw = P.hy_conv_w + (size_t)jl * 3 * 3072;
  const float* cbp = P.hy_conv_b + (size_t)jl * 3072;
  const float w00 = cw[d], w01 = cw[3072 + d], w02 = cw[2 * 3072 + d], cb0 = cbp[d];
  const float w10 = cw[1024 + d], w11 = cw[3072 + 1024 + d], w12 = cw[2 * 3072 + 1024 + d], cb1 = cbp[1024 + d];
  const float w20 = cw[2048 + d], w21 = cw[3072 + 2048 + d], w22 = cw[2 * 3072 + 2048 + d], cb2 = cbp[2048 + d];
  for (int pair = 0; pair < 2; ++pair) {
    const u16* za0 = zT + (size_t)d * NTOK + (size_t)(2 * pair) * SEQ;
    const u16* za1 = za0 + SEQ;
    const u16* zb0 = zT + (size_t)(1024 + d) * NTOK + (size_t)(2 * pair) * SEQ;
    const u16* zb1 = zb0 + SEQ;
    const u16* zc0 = zT + (size_t)(2048 + d) * NTOK + (size_t)(2 * pair) * SEQ;
    const u16* zc1 = zc0 + SEQ;
#pragma unroll 1
    for (int it = 0; it < 2; ++it) {
      const int rp = tid + it * NT;
      float2 x[16];
#pragma unroll
      for (int e = 0; e < 8; ++e) {
        const int t = (e >> 2) * 4096 + (e & 3) * 1024 + rp;
        x[e] = make_float2(sconv(za0, t, SEQ, w00, w01, w02, cb0), sconv(za1, t, SEQ, w00, w01, w02, cb0));
        if ((e & 3) == 3) __builtin_amdgcn_sched_barrier(0);
      }
#pragma unroll
      for (int e = 8; e < 16; ++e) x[e] = make_float2(0.f, 0.f);
      r16_fwd<4096>(x, rp);
#pragma unroll
      for (int e = 0; e < 16; ++e) buf[PH(rp + (e >> 2) * 4096 + (e & 3) * 1024)] = x[e];
    }
    __syncthreads();
    r16_pass<256, false>(buf, tid); r16_pass<16, false>(buf, tid);
    fft_middle(buf, Kg, tid);
    r16_pass<16, true>(buf, tid); r16_pass<256, true>(buf, tid);
#pragma unroll 1
    for (int it = 0; it < 2; ++it) {
      const int rp = tid + it * NT;
      float2 x[16];
#pragma unroll
      for (int e = 0; e < 16; ++e) x[e] = buf[PH(rp + (e >> 2) * 4096 + (e & 3) * 1024)];
      r16_inv<4096>(x, rp);
#pragma unroll
      for (int e = 0; e < 8; ++e) {
        const int t = (e >> 2) * 4096 + (e & 3) * 1024 + rp;
        const float g0 = sconv(zb0, t, SEQ, w10, w11, w12, cb1), g1 = sconv(zb1, t, SEQ, w10, w11, w12, cb1);
        buf[PH(t)] = make_float2(x[e].x * g0, x[e].y * g1);
        if ((e & 3) == 3) __builtin_amdgcn_sched_barrier(0);
      }
      const float z = lzero();
#pragma unroll
      for (int e = 8; e < 16; ++e) buf[PH(rp + (e >> 2) * 4096 + (e & 3) * 1024)] = make_float2(z, z);
    }
    __syncthreads();
    r16_pass<4096, false>(buf, tid); r16_pass<256, false>(buf, tid); r16_pass<16, false>(buf, tid);
    fft_middle(buf, Kg + 16384, tid);
    r16_pass<16, true>(buf, tid); r16_pass<256, true>(buf, tid);
#pragma unroll 1
    for (int it = 0; it < 2; ++it) {
      const int rp = tid + it * NT;
      float2 x[16];
#pragma unroll
      for (int e = 0; e < 16; ++e) x[e] = buf[PH(rp + (e >> 2) * 4096 + (e & 3) * 1024)];
      r16_inv<4096>(x, rp);
      u16* yo = yT + (size_t)d * NTOK + (size_t)(2 * pair) * SEQ;
#pragma unroll
      for (int e = 0; e < 8; ++e) {
        const int t = (e >> 2) * 4096 + (e & 3) * 1024 + rp;
        const float g0 = sconv(zc0, t, SEQ, w20, w21, w22, cb2), g1 = sconv(zc1, t, SEQ, w20, w21, w22, cb2);
        yo[t] = f2bf(x[e].x * g0); yo[SEQ + t] = f2bf(x[e].y * g1);
        if ((e & 3) == 3) __builtin_amdgcn_sched_barrier(0);
      }
    }
    __syncthreads();
  }
}

DI void hyena_ctx_unit(const Params& P, int jl, int d, unsigned char* smem) {
  float* kk = (float*)smem;
  float* ya = kk + 1024;
  float* yb = ya + 1024;
  float* red = yb + 1024;
  const int tid = ltid();
  const u16* zT = (const u16*)(lws(P) + OFF_BIG + B_ZT);
  const u16* kT = (const u16*)(lws(P) + OFF_BIG + B_KT);
  u16* yT = (u16*)(lws(P) + OFF_BIG + B_YT);
  const float* cw = P.hy_conv_w + (size_t)jl * 3 * 3072;
  const float* cbp = P.hy_conv_b + (size_t)jl * 3072;
#pragma unroll
  for (int n = 0; n < 2; ++n) {
    const u16* kf = kT + (size_t)((n * 2 + 0) * 1024 + d) * KTL + SEQ;
    const u16* kb = kT + (size_t)((n * 2 + 1) * 1024 + d) * KTL + SEQ;
    float s = 0.f, f = 0.f, g = 0.f;
    if (tid < 256) { f = bf2f(kf[tid]); s = fabsf(f); }
    else if (tid > 256) { g = bf2f(kb[tid - 256]); s = fabsf(g); }
    const float S = block_sum(s, red, tid);
    if (tid < 256) kk[n * 512 + 256 + tid] = f / S;
    else if (tid > 256) kk[n * 512 + 256 - (tid - 256)] = g / S;
    else kk[n * 512 + 0] = 0.f;
  }
  for (int e = tid; e < 1024; e += NT) {
    const int b = e >> 8, t = e & 255;
    const u16* z0 = zT + (size_t)d * NTOK + NL + b * 256;
    ya[e] = sconv(z0, t, NCTX, cw[d], cw[3072 + d], cw[2 * 3072 + d], cbp[d]);
  }
  __syncthreads();
#pragma unroll
  for (int n = 0; n < 2; ++n) {
    const float* src = n == 0 ? ya : yb;
    float* dst = n == 0 ? yb : ya;
    const int ch = (n + 1) * 1024 + d;
    const float skp = P.hy_bias[(jl * 2 + n) * 1024 + d];
    {
      const int t = tid & 255, bh = tid >> 8;
      const float* kp = kk + n * 512 + 256 + t;
      const float* s0 = src + (2 * bh) * 256;
      const float* s1 = s0 + 256;
      float acc0 = 0.f, acc1 = 0.f;
#pragma unroll 4
      for (int s = 0; s < 256; s += 4) {
        const float4 x0 = *(const float4*)(s0 + s), x1 = *(const float4*)(s1 + s);
        const float k0 = kp[-s], k1 = kp[-s - 1], k2 = kp[-s - 2], k3 = kp[-s - 3];
        acc0 += k0 * x0.x + k1 * x0.y + k2 * x0.z + k3 * x0.w;
        acc1 += k0 * x1.x + k1 * x1.y + k2 * x1.z + k3 * x1.w;
      }
#pragma unroll
      for (int q = 0; q < 2; ++q) {
        const int b = 2 * bh + q, e = b * 256 + t;
        const float acc = (q == 0 ? acc0 : acc1) + skp * src[e];
        const u16* zg = zT + (size_t)ch * NTOK + NL + b * 256;
        const float gate = sconv(zg, t, NCTX, cw[ch], cw[3072 + ch], cw[2 * 3072 + ch], cbp[ch]);
        const float o = acc * gate;
        if (n == 0) dst[e] = o;
        else yT[(size_t)d * NTOK + NL + e] = f2bf(o);
      }
    }
    __syncthreads();
  }
}

DI void hyena_conv_phase(const Params& P, int jl, bool with_ctx, unsigned char* smem, int bid, int nblk) {
  for (int u = bid; u < 1024; u += nblk) hyena_lat_unit(P, jl, u, smem);
  if (with_ctx) {
    __syncthreads();
    for (int u = bid; u < 1024; u += nblk) hyena_ctx_unit(P, jl, u, smem);
  }
}

DI void transpose_phase(const Params& P, int ncols, unsigned char* smem, int bid, int nblk) {
  u16* t = (u16*)smem;
  const u16* yT = (const u16*)(lws(P) + OFF_BIG + B_YT);
  u16* A = (u16*)(lws(P) + OFF_A);
  const int tid = ltid();
  const int tcols = ncols / 64;
  for (int tile = bid; tile < 16 * tcols; tile += nblk) {
    const int d0 = (tile / tcols) * 64, m0 = (tile % tcols) * 64;
    {
      const int rr = tid >> 3, ch = tid & 7;
      *(uint4*)(t + rr * 72 + ch * 8) = *(const uint4*)(yT + (size_t)(d0 + rr) * NTOK + m0 + ch * 8);
    }
    __syncthreads();
    {
      const int m = tid >> 3, dc = (tid & 7) * 8;
      u16x8 o;
#pragma unroll
      for (int j = 0; j < 8; ++j) o[j] = t[(dc + j) * 72 + m];
      *(u16x8*)(A + (size_t)(m0 + m) * 1024 + d0 + dc) = o;
    }
    __syncthreads();
  }
}

DI float logsigmoid(float x) { return fminf(x, 0.f) - __logf(1.f + __expf(-fabsf(x))); }

DI void gla_prep_phase(const Params& P, unsigned char* smem, int bid, int nblk) {
  u16* qraw = (u16*)smem;
  u16* kraw = qraw + 64 * 136;
  u16* vt = kraw + 64 * 136;
  u16* qt = vt + 256 * 72;
  u16* kt = qt + 64 * 136;
  u16* ps = kt + 64 * 136;
  float* rs = (float*)(ps + 64 * 72);
  float* segt = rs + 2 * 64 * 16;
  const int tid = ltid(), lane = tid & 63, wv = tid >> 6;
  const int r = lane & 31, h = lane >> 5;
  u16* Z = (u16*)(lws(P) + OFF_BIG + B_GZ);
  u16* G2 = (u16*)(lws(P) + OFF_BIG + B_G2);
  float* DEC = (float*)(lws(P) + OFF_BIG + B_DEC);
  for (int u = bid; u < 528 * 4; u += nblk) {
    const int c = u >> 2, hd = u & 3;
    const int row0 = c < 512 ? c * 64 : NL + (c - 512) * 64;
    u16* Zr = Z + (size_t)row0 * GLA_N;
    __syncthreads();
    {
      const int rr0 = tid >> 4, cc0 = (tid & 15) * 8;
      *(uint4*)(qraw + rr0 * 136 + cc0) = *(const uint4*)(Zr + (size_t)rr0 * GLA_N + hd * 128 + cc0);
      *(uint4*)(qraw + (rr0 + 32) * 136 + cc0) = *(const uint4*)(Zr + (size_t)(rr0 + 32) * GLA_N + hd * 128 + cc0);
      *(uint4*)(kraw + rr0 * 136 + cc0) = *(const uint4*)(Zr + (size_t)rr0 * GLA_N + 512 + hd * 128 + cc0);
      *(uint4*)(kraw + (rr0 + 32) * 136 + cc0) = *(const uint4*)(Zr + (size_t)(rr0 + 32) * GLA_N + 512 + hd * 128 + cc0);
    }
#pragma unroll
    for (int i = 0; i < 4; ++i) {
      const int cidx = tid + i * NT, rr = cidx >> 5, cc = (cidx & 31) * 8;
      const u16x8 v = *(const u16x8*)(Zr + (size_t)rr * GLA_N + 1024 + hd * 256 + cc);
#pragma unroll
      for (int j = 0; j < 8; ++j) vt[(cc + j) * 72 + rr] = v[j];
    }
    if (tid < 256) {
      const int rr = tid >> 2, cc = (tid & 3) * 8;
      const u16x8 v = *(const u16x8*)(Zr + (size_t)rr * GLA_N + 3072 + cc);
#pragma unroll
      for (int j = 0; j < 8; ++j) rs[((cc + j) >> 4) * 1024 + rr * 16 + ((cc + j) & 15)] = bf2f(v[j]);
    }
    __syncthreads();
#pragma unroll 1
    for (int dir = 0; dir < 2; ++dir) {
      const int dk = tid & 127, seg = tid >> 7;
      float vv[16];
      {
        const float* w2p = P.gla_gk_w2 + (size_t)(dir * 16) * 512 + hd * 128 + dk;
        float wq[16];
#pragma unroll
        for (int q = 0; q < 16; ++q) wq[q] = w2p[q * 512];
        const float gb = P.gla_gk_b[dir * 512 + hd * 128 + dk];
#pragma unroll
        for (int m = 0; m < 16; ++m) {
          const float4* rp = (const float4*)(rs + dir * 1024 + (seg * 16 + m) * 16);
          const float4 r0 = rp[0], r1 = rp[1], r2 = rp[2], r3 = rp[3];
          float a = gb;
          a += r0.x * wq[0] + r0.y * wq[1] + r0.z * wq[2] + r0.w * wq[3];
          a += r1.x * wq[4] + r1.y * wq[5] + r1.z * wq[6] + r1.w * wq[7];
          a += r2.x * wq[8] + r2.y * wq[9] + r2.z * wq[10] + r2.w * wq[11];
          a += r3.x * wq[12] + r3.y * wq[13] + r3.z * wq[14] + r3.w * wq[15];
          vv[m] = logsigmoid(a) * (1.f / 16.f);
        }
      }
      if (dir == 0) {
#pragma unroll
        for (int i = 1; i < 16; ++i) vv[i] += vv[i - 1];
        segt[seg * 128 + dk] = vv[15];
      } else {
#pragma unroll
        for (int i = 14; i >= 0; --i) vv[i] += vv[i + 1];
        segt[seg * 128 + dk] = vv[0];
      }
      __syncthreads();
      const float t0 = segt[dk], t1 = segt[128 + dk], t2 = segt[256 + dk], t3 = segt[384 + dk];
      float off;
      if (dir == 0) off = (seg > 0 ? t0 : 0.f) + (seg > 1 ? t1 : 0.f) + (seg > 2 ? t2 : 0.f);
      else off = (seg < 3 ? t3 : 0.f) + (seg < 2 ? t2 : 0.f) + (seg < 1 ? t1 : 0.f);
      const float tot = (t0 + t1) + (t2 + t3);
      if (seg == 0) DEC[((size_t)(c * 4 + hd) * 2 + dir) * 128 + dk] = __expf(tot);
      unsigned kw[8];
#pragma unroll
      for (int m = 0; m < 16; m += 2) {
        const int i0 = seg * 16 + m;
        const float b0 = vv[m] + off, b1 = vv[m + 1] + off;
        const float q0 = bf2f(qraw[i0 * 136 + dk]), q1 = bf2f(qraw[(i0 + 1) * 136 + dk]);
        const float k0 = bf2f(kraw[i0 * 136 + dk]), k1 = bf2f(kraw[(i0 + 1) * 136 + dk]);
        const unsigned qp = pk2(q0 * __expf(b0) * 0.08838834764831845f, q1 * __expf(b1) * 0.08838834764831845f);
        const unsigned kp = pk2(k0 * __expf(-b0), k1 * __expf(-b1));
        qt[i0 * 136 + dk] = (u16)(qp & 0xffffu); qt[(i0 + 1) * 136 + dk] = (u16)(qp >> 16);
        kt[i0 * 136 + dk] = (u16)(kp & 0xffffu); kt[(i0 + 1) * 136 + dk] = (u16)(kp >> 16);
        kw[m >> 1] = pk2(k0 * __expf(tot - b0), k1 * __expf(tot - b1));
      }
      {
        u16* slot = (dir == 0 ? Zr + 512 + hd * 128 : G2 + (size_t)row0 * 1024 + 512 + hd * 128);
        const size_t rstride = dir == 0 ? GLA_N : 1024;
        uint4* dp = (uint4*)(slot + (size_t)(dk >> 1) * rstride + (dk & 1) * 64 + seg * 16);
        dp[0] = make_uint4(kw[0], kw[1], kw[2], kw[3]); dp[1] = make_uint4(kw[4], kw[5], kw[6], kw[7]);
      }
      __syncthreads();
      if (wv < 4) {
        const int ti = wv & 1, tj = wv >> 1;
        f32x16 at;
#pragma unroll
        for (int i = 0; i < 16; ++i) at[i] = 0.f;
#pragma unroll
        for (int kk = 0; kk < 8; ++kk) {
          const bf16x8 a = *(const bf16x8*)(qt + (ti * 32 + r) * 136 + kk * 16 + h * 8);
          const bf16x8 bv = *(const bf16x8*)(kt + (tj * 32 + r) * 136 + kk * 16 + h * 8);
          at = MFMA32(a, bv, at);
        }
#pragma unroll
        for (int i = 0; i < 16; ++i) {
          const int ii = ti * 32 + crow(i, h), sj = tj * 32 + r;
          const bool keep = dir == 0 ? (sj <= ii) : (sj >= ii);
          ps[ii * 72 + sj] = f2bf(keep ? at[i] : 0.f);
        }
      } else {
        u16* slot = (dir == 0 ? Zr + hd * 128 : G2 + (size_t)row0 * 1024 + hd * 128);
        const size_t rstride = dir == 0 ? GLA_N : 1024;
        const int t4 = tid - 256;
#pragma unroll
        for (int i = 0; i < 4; ++i) {
          const int cidx = t4 + i * 256, rr = cidx >> 4, cc = (cidx & 15) * 8;
          *(uint4*)(slot + (size_t)rr * rstride + cc) = *(const uint4*)(qt + rr * 136 + cc);
        }
      }
      __syncthreads();
      {
        u16* O = dir == 0 ? (u16*)(lws(P) + OFF_A) : (u16*)(lws(P) + OFF_BIG + B_GOB);
        f32x16 o0, o1;
#pragma unroll
        for (int i = 0; i < 16; ++i) { o0[i] = 0.f; o1[i] = 0.f; }
#pragma unroll
        for (int ss = 0; ss < 4; ++ss) {
          const bf16x8 bv = *(const bf16x8*)(vt + (wv * 32 + r) * 72 + ss * 16 + h * 8);
          const bf16x8 a0 = *(const bf16x8*)(ps + r * 72 + ss * 16 + h * 8);
          const bf16x8 a1 = *(const bf16x8*)(ps + (32 + r) * 72 + ss * 16 + h * 8);
          o0 = MFMA32(a0, bv, o0); o1 = MFMA32(a1, bv, o1);
        }
        u16* ob = O + (size_t)row0 * 1024 + hd * 256 + wv * 32 + r;
#pragma unroll
        for (int i = 0; i < 16; ++i) {
          const int ii = crow(i, h);
          ob[(size_t)ii * 1024] = f2bf(o0[i]);
          ob[(size_t)(32 + ii) * 1024] = f2bf(o1[i]);
        }
      }
      __syncthreads();
    }
  }
}

DI void gla_scan_phase(const Params& P, unsigned char* smem, int bid, int nblk) {
  u16* qs = (u16*)smem;
  u16* ket = qs + 64 * 136;
  u16* vt = ket + 128 * 72;
  u16* sb = vt + 32 * 72;
  float* decs = (float*)(sb + 32 * 136);
  const int tid = ltid(), lane = tid & 63, wv = tid >> 6;
  const int r = lane & 31, h = lane >> 5;
  const u16* Z = (const u16*)(lws(P) + OFF_BIG + B_GZ);
  const u16* G2 = (const u16*)(lws(P) + OFF_BIG + B_G2);
  const float* DEC = (const float*)(lws(P) + OFF_BIG + B_DEC);
  for (int u0 = bid; u0 < 256; u0 += nblk) {
    int u = u0;
    if (nblk == 256) { const int xc = u0 & 7, sl = u0 >> 3; u = ((xc + 8 * (sl >> 3)) << 3) + (sl & 7); }
    const int vs = u & 7, dir = (u >> 3) & 1, hd = (u >> 4) & 3, b = u >> 6;
    u16* O = dir == 0 ? (u16*)(lws(P) + OFF_A) : (u16*)(lws(P) + OFF_BIG + B_GOB);
    const u16* TB = dir == 0 ? Z : G2;
    const size_t rst = dir == 0 ? GLA_N : 1024;
    __syncthreads();
    for (int e = tid; e < 32 * 136; e += NT) sb[e] = 0;
    f32x16 S;
#pragma unroll
    for (int i = 0; i < 16; ++i) S[i] = 0.f;
    uint4 pq0, pq1, pk0, pk1; u16x8 pv; float pd = 0.f;
#define GLA_ROW0(ci_) ((ci_) < 4 ? NL + b * 256 + (dir == 0 ? (ci_) : 3 - (ci_)) * 64 : b * SEQ + (dir == 0 ? (ci_) - 4 : 131 - (ci_)) * 64)
#define GLA_PREFETCH(ci_)                                                                                         \
    { const int rw = GLA_ROW0(ci_);                                                                               \
      const u16* Tq = TB + (size_t)rw * rst + hd * 128;                                                           \
      const u16* Tk = Tq + 512;                                                                                   \
      pq0 = *(const uint4*)(Tq + (size_t)(tid >> 4) * rst + (tid & 15) * 8);                                      \
      pq1 = *(const uint4*)(Tq + (size_t)((tid >> 4) + 32) * rst + (tid & 15) * 8);                               \
      pk0 = *(const uint4*)(Tk + (size_t)(tid >> 4) * rst + (tid & 15) * 8);             \
      pk1 = *(const uint4*)(Tk + (size_t)((tid >> 4) + 32) * rst + (tid & 15) * 8);                               \
      if (tid < 256) pv = *(const u16x8*)(Z + (size_t)(rw + (tid >> 2)) * GLA_N + 1024 + hd * 256 + vs * 32 + (tid & 3) * 8); \
      else if (tid < 384) { const int cidx = rw < NL ? (rw >> 6) : 512 + ((rw - NL) >> 6);                         \
        pd = DEC[((size_t)(cidx * 4 + hd) * 2 + dir) * 128 + (tid - 256)]; } }
    GLA_PREFETCH(0)
    __syncthreads();
    for (int ci = 0; ci < 132; ++ci) {
      const int row0 = GLA_ROW0(ci);
      {
        const int rr0 = tid >> 4, cc0 = (tid & 15) * 8;
        *(uint4*)(qs + rr0 * 136 + cc0) = pq0; *(uint4*)(qs + (rr0 + 32) * 136 + cc0) = pq1;
        const int d0 = 2 * rr0 + (cc0 >> 6), s0 = cc0 & 63;
        *(uint4*)(ket + d0 * 72 + s0) = pk0; *(uint4*)(ket + (d0 + 64) * 72 + s0) = pk1;
      }
      if (tid < 256) {
        const int rr = tid >> 2, cc = (tid & 3) * 8;
#pragma unroll
        for (int j = 0; j < 8; ++j) vt[(cc + j) * 72 + rr] = pv[j];
      } else if (tid < 384) decs[tid - 256] = pd;
      if (ci + 1 < 132) GLA_PREFETCH(ci + 1)
      __syncthreads();
      f32x16 Sn;
      if (wv < 4) {
#pragma unroll
        for (int i = 0; i < 16; ++i) Sn[i] = S[i] * decs[wv * 32 + crow(i, h)];
#pragma unroll
        for (int ss = 0; ss < 4; ++ss) {
          const bf16x8 a = *(const bf16x8*)(ket + (wv * 32 + r) * 72 + ss * 16 + h * 8);
          const bf16x8 bv = *(const bf16x8*)(vt + r * 72 + ss * 16 + h * 8);
          Sn = MFMA32(a, bv, Sn);
        }
      } else if (wv < 6) {
        const int ti = wv - 4;
        u16* ob = O + (size_t)(row0 + ti * 32) * 1024 + hd * 256 + vs * 32 + r;
        float oin[16];
#pragma unroll
        for (int i = 0; i < 16; ++i) oin[i] = bf2f(ob[(size_t)crow(i, h) * 1024]);
        f32x16 o;
#pragma unroll
        for (int i = 0; i < 16; ++i) o[i] = 0.f;
#pragma unroll
        for (int kk = 0; kk < 8; ++kk) {
          const bf16x8 a = *(const bf16x8*)(qs + (ti * 32 + r) * 136 + kk * 16 + h * 8);
          const bf16x8 bv = *(const bf16x8*)(sb + r * 136 + kk * 16 + h * 8);
          o = MFMA32(a, bv, o);
        }
#pragma unroll
        for (int i = 0; i < 16; ++i) ob[(size_t)crow(i, h) * 1024] = f2bf(o[i] + oin[i]);
      }
      __syncthreads();
      if (wv < 4) {
        S = Sn;
#pragma unroll
        for (int g = 0; g < 4; ++g) {
          u16x4 o;
#pragma unroll
          for (int q = 0; q < 4; ++q) o[q] = f2bf(S[4 * g + q]);
          *(u16x4*)(sb + r * 136 + wv * 32 + 8 * g + 4 * h) = o;
        }
      }
    }
  }
}

DI void gla_out_phase(const Params& P, int bid, int nblk) {
  const int lane = ltid() & 63, wv = ltid() >> 6;
  u16* A = (u16*)(lws(P) + OFF_A);
  const u16* Ob = (const u16*)(lws(P) + OFF_BIG + B_GOB);
  const u16* Z = (const u16*)(lws(P) + OFF_BIG + B_GZ);
  const float4 on4 = *(const float4*)(P.gla_onorm + lane * 4);
  for (int row = bid * 8 + wv; row < NTOK; row += nblk * 8) {
    u16x4 a[4], bq[4], og[4];
#pragma unroll
    for (int hd = 0; hd < 4; ++hd) {
      const size_t o = (size_t)row * 1024 + hd * 256 + lane * 4;
      a[hd] = *(const u16x4*)(A + o); bq[hd] = *(const u16x4*)(Ob + o);
      og[hd] = *(const u16x4*)(Z + (size_t)row * GLA_N + 2048 + hd * 256 + lane * 4);
    }
#pragma unroll
    for (int hd = 0; hd < 4; ++hd) {
      float v[4];
      float ss = 0.f;
#pragma unroll
      for (int j = 0; j < 4; ++j) { v[j] = bf2f(a[hd][j]) + bf2f(bq[hd][j]); ss += v[j] * v[j]; }
      ss = wave_sum(ss, lane);
      const float rstd = rsqrtf(ss * (1.f / 256.f) + EPS);
      uint2 res;
      res.x = pk2(v[0] * rstd * on4.x * silu(bf2f(og[hd][0])), v[1] * rstd * on4.y * silu(bf2f(og[hd][1])));
      res.y = pk2(v[2] * rstd * on4.z * silu(bf2f(og[hd][2])), v[3] * rstd * on4.w * silu(bf2f(og[hd][3])));
      *(uint2*)(A + (size_t)row * 1024 + hd * 256 + lane * 4) = res;
    }
  }
}

DI void mla_prep_phase(const Params& P, int bid, int nblk) {
  const int lane = ltid() & 63, wv = ltid() >> 6;
  const u16* Cd = (const u16*)(lws(P) + OFF_BIG + B_CD);
  u16* CQN = (u16*)(lws(P) + OFF_A + A_CQN);
  u16* CKVN = (u16*)(lws(P) + OFF_A + A_CKVN);
  u16* KR = (u16*)(lws(P) + OFF_BIG + B_KR);
  for (int row = bid * 8 + wv; row < NTOK; row += nblk * 8) {
    const u16* cr = Cd + (size_t)row * MLA_DNP;
    if (row < NL) {
      float v[6], ss = 0.f;
#pragma unroll
      for (int j = 0; j < 6; ++j) { v[j] = bf2f(cr[lane + 64 * j]); ss += v[j] * v[j]; }
      ss = wave_sum(ss, lane);
      const float rstd = rsqrtf(ss * (1.f / 384.f) + EPS);
#pragma unroll
      for (int j = 0; j < 6; ++j) CQN[(size_t)row * 384 + lane + 64 * j] = f2bf(v[j] * rstd * P.mla_qnorm[lane + 64 * j]);
    }
    {
      float v[4], ss = 0.f;
#pragma unroll
      for (int j = 0; j < 4; ++j) { v[j] = bf2f(cr[384 + lane + 64 * j]); ss += v[j] * v[j]; }
      ss = wave_sum(ss, lane);
      const float rstd = rsqrtf(ss * (1.f / 256.f) + EPS);
#pragma unroll
      for (int j = 0; j < 4; ++j) CKVN[(size_t)row * 256 + lane + 64 * j] = f2bf(v[j] * rstd * P.mla_kvnorm[lane + 64 * j]);
    }
    {
      float x = bf2f(cr[640 + lane]);
      const float px = shx(x, 16, lane);
      int b, key;
      if (row < NL) {
        b = row >> 13; const int l = row & 8191; key = NCTX + l;
        const int jj = lane & 15;
        const bool first = (lane & 31) < 16;
        const float invf = __expf(-(float)jj * (9.210340371976184f / 16.f));
        const float pos = (float)(lane < 32 ? (l >> 6) : (l & 63));
        float sn, cs;
        __sincosf(pos * invf, &sn, &cs);
        x = first ? (x * cs - px * sn) : (px * sn + x * cs);
      } else { b = (row - NL) >> 8; key = (row - NL) & 255; }
      KR[((size_t)b * NKEY + key) * 64 + lane] = f2bf(x);
    }
  }
}

constexpr int KS_STRIDE = 200;
constexpr int VS_STRIDE = 68;
DI void mla_attn_phase(const Params& P, unsigned char* smem, int bid, int nblk) {
  u16* Ks = (u16*)smem;
  u16* Vs = Ks + 2 * 64 * KS_STRIDE;
  const int tid = ltid(), lane = tid & 63, wv = tid >> 6;
  const int r = lane & 31, h = lane >> 5;
  const u16* Qg = (const u16*)(lws(P) + OFF_BIG + B_Q);
  const u16* Kn = (const u16*)(lws(P) + OFF_BIG + B_KN);
  const u16* VT = (const u16*)(lws(P) + OFF_BIG + B_VT);
  const u16* KR = (const u16*)(lws(P) + OFF_BIG + B_KR);
  u16* O = (u16*)(lws(P) + OFF_A);
  for (int u0 = bid; u0 < 1024; u0 += nblk) {
    int u = u0;
    if (nblk == 256) { const int rnd = u0 >> 8, c = u0 & 255; u = ((rnd * 8 + (c & 7)) << 5) + (c >> 3); }
    const int bh = u >> 5, qb = u & 31, b = bh >> 3, hd = bh & 7;
    const int l = qb * 256 + wv * 32 + r;
    bf16x8 qf[12];
    {
      const u16* qp = Qg + (size_t)(b * SEQ + l) * 1536 + hd * 192 + h * 8;
#pragma unroll
      for (int s = 0; s < 12; ++s) qf[s] = *(const bf16x8*)(qp + s * 16);
#pragma unroll
      for (int j = 0; j < 8; ++j) {
        const float invf = __expf(-(float)(8 * h + j) * (9.210340371976184f / 16.f));
        float sn, cs;
        __sincosf((float)(l >> 6) * invf, &sn, &cs);
        float x1 = bf2f((u16)qf[8][j]), x2 = bf2f((u16)qf[9][j]);
        qf[8][j] = (short)f2bf(x1 * cs - x2 * sn); qf[9][j] = (short)f2bf(x1 * sn + x2 * cs);
        __sincosf((float)(l & 63) * invf, &sn, &cs);
        x1 = bf2f((u16)qf[10][j]); x2 = bf2f((u16)qf[11][j]);
        qf[10][j] = (short)f2bf(x1 * cs - x2 * sn); qf[11][j] = (short)f2bf(x1 * sn + x2 * cs);
      }
    }
    f32x16 oacc[4];
#pragma unroll
    for (int d = 0; d < 4; ++d)
#pragma unroll
      for (int i = 0; i < 16; ++i) oacc[d][i] = 0.f;
    float mrun = -1e30f, lrun = 0.f;
    const u16* Kb = Kn + (size_t)bh * NKEY * 128;
    const u16* Rb = KR + (size_t)b * NKEY * 64;
    const u16* Vb = VT + (size_t)bh * 128 * NKEY;
    uint4 rk0, rk1, rk2, rv0, rv1;
#define ATT_GLOAD(kt_)                                                                                      \
    { const int key0 = (kt_) * 64;                                                                          \
      rk0 = *(const uint4*)(Kb + (size_t)(key0 + (tid >> 4)) * 128 + (tid & 15) * 8);                       \
      rk1 = *(const uint4*)(Kb + (size_t)(key0 + 32 + (tid >> 4)) * 128 + (tid & 15) * 8);                  \
      rk2 = *(const uint4*)(Rb + (size_t)(key0 + (tid >> 3)) * 64 + (tid & 7) * 8);                         \
      rv0 = *(const uint4*)(Vb + (size_t)(tid >> 3) * NKEY + key0 + (tid & 7) * 8);                         \
      rv1 = *(const uint4*)(Vb + (size_t)(64 + (tid >> 3)) * NKEY + key0 + (tid & 7) * 8); }
#define ATT_STV(src_, row_, buf_)                                                                           \
    { uint2* dp = (uint2*)(Vs + (buf_) * 128 * VS_STRIDE + (row_) * VS_STRIDE + (tid & 7) * 8);                \
      dp[0] = make_uint2(src_.x, src_.y); dp[1] = make_uint2(src_.z, src_.w); }
#define ATT_SSTORE(buf_)                                                                                    \
    { *(uint4*)(Ks + (buf_) * 64 * KS_STRIDE + (tid >> 4) * KS_STRIDE + (tid & 15) * 8) = rk0;                \
      *(uint4*)(Ks + (buf_) * 64 * KS_STRIDE + (32 + (tid >> 4)) * KS_STRIDE + (tid & 15) * 8) = rk1;         \
      *(uint4*)(Ks + (buf_) * 64 * KS_STRIDE + (tid >> 3) * KS_STRIDE + 128 + (tid & 7) * 8) = rk2;           \
      ATT_STV(rv0, (tid >> 3), buf_) ATT_STV(rv1, (64 + (tid >> 3)), buf_) }
    ATT_GLOAD(0);
    __syncthreads();
    ATT_SSTORE(0);
    __syncthreads();
    for (int kt = 0; kt < 132; ++kt) {
      const int cur = kt & 1;
      if (kt + 1 < 132) ATT_GLOAD(kt + 1);
      const u16* kc = Ks + cur * 64 * KS_STRIDE;
      const u16* vc = Vs + cur * 128 * VS_STRIDE;
#pragma unroll
      for (int t2 = 0; t2 < 2; ++t2) {
        f32x16 st;
#pragma unroll
        for (int i = 0; i < 16; ++i) st[i] = 0.f;
#pragma unroll
        for (int s = 0; s < 12; ++s) {
          const bf16x8 a = *(const bf16x8*)(kc + (t2 * 32 + r) * KS_STRIDE + s * 16 + h * 8);
          st = MFMA32(a, qf[s], st);
        }
        const float m0 = fmaxf(fmaxf(st[0], st[1]), st[2]), m1 = fmaxf(fmaxf(st[3], st[4]), st[5]);
        const float m2 = fmaxf(fmaxf(st[6], st[7]), st[8]), m3 = fmaxf(fmaxf(st[9], st[10]), st[11]);
        const float m4 = fmaxf(fmaxf(st[12], st[13]), st[14]);
        float mx = fmaxf(fmaxf(fmaxf(m0, m1), m2), fmaxf(fmaxf(m3, m4), st[15]));
        mx = fmaxf(mx, shx(mx, 32, lane));
        if (__builtin_amdgcn_ballot_w64(mx > mrun + 8.f) != 0ull) {
          const float mnew = fmaxf(mrun, mx);
          const float alpha = __builtin_amdgcn_exp2f(mrun - mnew);
          lrun *= alpha;
#pragma unroll
          for (int d = 0; d < 4; ++d)
#pragma unroll
            for (int i = 0; i < 16; ++i) oacc[d][i] *= alpha;
          mrun = mnew;
        }
        float ls = 0.f;
#pragma unroll
        for (int i = 0; i < 16; ++i) { const float p = __builtin_amdgcn_exp2f(st[i] - mrun); st[i] = p; ls += p; }
        lrun += ls;
        if (t2 == 0 && kt + 1 < 132) ATT_SSTORE(cur ^ 1);
#pragma unroll
        for (int s2 = 0; s2 < 2; ++s2) {
          uint4 pw;
          pw.x = pk2(st[8 * s2 + 0], st[8 * s2 + 1]); pw.y = pk2(st[8 * s2 + 2], st[8 * s2 + 3]);
          pw.z = pk2(st[8 * s2 + 4], st[8 * s2 + 5]); pw.w = pk2(st[8 * s2 + 6], st[8 * s2 + 7]);
          const bf16x8 pf = __builtin_bit_cast(bf16x8, pw);
#pragma unroll
          for (int d = 0; d < 4; ++d) {
            const u16* vp = vc + (d * 32 + r) * VS_STRIDE + t2 * 32 + 16 * s2 + 4 * h;
            const uint2 lo = *(const uint2*)vp, hi = *(const uint2*)(vp + 8);
            uint4 av = make_uint4(lo.x, lo.y, hi.x, hi.y);
            oacc[d] = MFMA32(__builtin_bit_cast(bf16x8, av), pf, oacc[d]);
          }
        }
      }
      __syncthreads();
    }
    lrun += shx(lrun, 32, lane);
    const float inv = 1.f / lrun;
    u16* op = O + (size_t)(b * SEQ + l) * 1024 + hd * 128;
#pragma unroll
    for (int d = 0; d < 4; ++d)
#pragma unroll
      for (int g = 0; g < 4; ++g) {
        u16x4 o;
#pragma unroll
        for (int q = 0; q < 4; ++q) o[q] = f2bf(oacc[d][4 * g + q] * inv);
        *(u16x4*)(op + d * 32 + 8 * g + 4 * h) = o;
      }
  }
}

constexpr int NPHASE = 36;

DI void run_phase(const Params& P, int ph, unsigned char* smem, int bid, int nblk) {
  u16* WT = (u16*)(lws(P) + OFF_WT);
  u16* A = (u16*)(lws(P) + OFF_A);
  unsigned char* BIG = lws(P) + OFF_BIG;
  float* XC = (float*)(lws(P) + OFF_XC);
  const float* MOD = (const float*)(lws(P) + OFF_MOD);
  EpiArgs ea{};
  if (ph == 0) {
    pro_weights(P, smem, bid, nblk);
    __syncthreads();
    pro_adaln(P, smem, bid, nblk);
    pro_filter_mlp(P, bid, nblk);
    return;
  }
  if (ph == 35) { final_norm_phase(P, bid, nblk); return; }
  int li, sub;
  if (ph <= 8) { li = 0; sub = ph - 1; }
  else if (ph <= 17) { li = 1; sub = ph - 9; }
  else if (ph <= 26) { li = 2; sub = ph - 18; }
  else { li = 3; sub = ph - 27; }
  const bool ctx_on = li <= 1;
  const int rows_all = ctx_on ? NTOK : NL;
  const int mt_all = rows_all / 256;
  const float* xl = li == 0 ? P.x : P.out;
  const float* xc = li == 0 ? P.ctx : XC;
  const int nsub = (li == 1 || li == 2) ? 9 : 8;
  if (sub == nsub - 3) { normmod_phase(P, li, 1, rows_all, P.out, XC, bid, nblk); return; }
  if (sub == nsub - 2) {
    EBf16<1> e{(u16*)(BIG + B_HID), HID, HID};
    gemm8(A, WT + W_MLP1(li), rows_all, HID, 1024, e, smem, bid, nblk);
    return;
  }
  if (sub == nsub - 1) {
    ea.gate = MOD + (size_t)li * 5 * 6144; ea.gofs = 5 * 1024;
    ea.xsl = P.out; ea.xsc = XC; ea.xdl = P.out; ea.xdc = XC;
    ERes e{nullptr, ea.gate, ea.gofs, ea.xsl, ea.xsc, ea.xdl, ea.xdc};
    gemm8((const u16*)(BIG + B_HID), WT + W_MLP2(li), NL, 1024, HID, e, smem, bid, nblk);
    if (ctx_on) {
      EResAtomic e2{ea.gate + 4 * 6144 + ea.gofs, XC};
      gemm8_splitk((const u16*)(BIG + B_HID) + (size_t)NL * HID, WT + W_MLP2(li), NTOK - NL, 1024, HID, 4, e2, smem, bid, nblk);
    }
    return;
  }
  ea.gate = MOD + (size_t)li * 5 * 6144; ea.gofs = 2 * 1024;
  ea.xsl = xl; ea.xsc = xc; ea.xdl = P.out; ea.xdc = XC;
  if (li == 0 || li == 3) {
    const int jl = li == 0 ? 0 : 1;
    switch (sub) {
      case 0: normmod_phase(P, li, 0, rows_all, xl, xc, bid, nblk); break;
      case 1: {
        EHyIn e1{(u16*)(BIG + B_ZT), P.hy_b_in + jl * 3072};
        gemm8(WT + W_HYIN(jl), A, 3072, rows_all, 1024, e1, smem, bid, nblk);
        EpiArgs e2{};
        e2.o0 = (u16*)(BIG + B_KT); e2.mrow0 = 0; e2.L = SEQ;
        const u16* h3 = (const u16*)(lws(P) + OFF_H3) + (size_t)jl * KTL * 64;
        gemm_phase<EPI_FILT>(h3, 64, WT + W_HYF4(jl), 64, 32, 16, e2, smem, bid, nblk);
        if (ctx_on) {
          e2.mrow0 = SEQ; e2.L = NCTX;
          gemm_phase<EPI_FILT>(h3 + (size_t)SEQ * 64, 64, WT + W_HYF4(jl), 64, 1, 16, e2, smem, bid, nblk);
        }
      } break;
      case 2: hyena_conv_phase(P, jl, ctx_on, smem, bid, nblk); break;
      case 3: transpose_phase(P, rows_all, smem, bid, nblk); break;
      case 4:
        { ERes e{P.hy_b_out + jl * 1024, ea.gate, ea.gofs, ea.xsl, ea.xsc, ea.xdl, ea.xdc};
          gemm8(A, WT + W_HYOUT(jl), rows_all, 1024, 1024, e, smem, bid, nblk); }
        break;
    }
    return;
  }
  if (li == 1) {
    switch (sub) {
      case 0: normmod_phase(P, li, 0, NTOK, xl, xc, bid, nblk); break;
      case 1: {
        EBf16<0> e1{(u16*)(BIG + B_GZ), GLA_N, GLA_N};
        gemm8(A, WT + W_GLAIN, NTOK, GLA_NP, 1024, e1, smem, bid, nblk);
      } break;
      case 2: gla_prep_phase(P, smem, bid, nblk); break;
      case 3: gla_scan_phase(P, smem, bid, nblk); break;
      case 4: gla_out_phase(P, bid, nblk); break;
      case 5: { ERes e{nullptr, ea.gate, ea.gofs, ea.xsl, ea.xsc, ea.xdl, ea.xdc};
        gemm8(A, WT + W_GLAWO, NTOK, 1024, 1024, e, smem, bid, nblk); } break;
    }
    return;
  }
  switch (sub) {
    case 0: normmod_phase(P, li, 0, NTOK, xl, xc, bid, nblk); break;
    case 1: {
      EBf16<0> e1{(u16*)(BIG + B_CD), MLA_DNP, MLA_DNP};
      gemm8(A, WT + W_MLADN, NTOK, MLA_DNP, 1024, e1, smem, bid, nblk);
    } break;
    case 2: mla_prep_phase(P, bid, nblk); break;
    case 3: {
      EBf16<2> e1{(u16*)(BIG + B_Q), 1536, 1536};
      gemm8((const u16*)(lws(P) + OFF_A + A_CQN), WT + W_MLAUQ, NL, 1536, 384, e1, smem, bid, nblk);
      EMlaK e2{(u16*)(BIG + B_KN)};
      gemm8((const u16*)(lws(P) + OFF_A + A_CKVN), WT + W_MLAUKV, NTOK, 1024, 256, e2, smem, bid, nblk);
      EMlaVT e3{(u16*)(BIG + B_VT)};
      gemm8(WT + W_MLAUKV + (size_t)1024 * 256, (const u16*)(lws(P) + OFF_A + A_CKVN), 1024, NTOK, 256, e3, smem, bid, nblk);
    } break;
    case 4: mla_attn_phase(P, smem, bid, nblk); break;
    case 5: { ERes e{nullptr, ea.gate, ea.gofs, ea.xsl, ea.xsc, ea.xdl, ea.xdc};
      gemm8(A, WT + W_MLAWO, NL, 1024, 1024, e, smem, bid, nblk); } break;
  }
}

#define XB_TMO      128
#define XB_XCNT(j)  (256  + 64 * (j))
#define XB_XSUB(j)  (1280 + 64 * (j))
#define XB_XGEN(j)  (2304 + 64 * (j))
#define XB_TOP      3328
#define XB_TOPGEN   3392
#define XCD_BAR_WORDS 3456
#define XB_SPIN_CAP (1u << 18)
#define LAS __attribute__((address_space(3)))

__device__ __forceinline__ unsigned xb_ld(unsigned* p)              { return __hip_atomic_load(p, __ATOMIC_RELAXED, __HIP_MEMORY_SCOPE_AGENT); }
__device__ __forceinline__ unsigned xb_add(unsigned* p, unsigned v) { return __hip_atomic_fetch_add(p, v, __ATOMIC_RELAXED, __HIP_MEMORY_SCOPE_AGENT); }
__device__ __forceinline__ unsigned xb_xcc_id() { return (unsigned)__builtin_amdgcn_s_getreg((3 << 11) | 20) & 0xFu; }
#define XB_SPIN(cond, bar) do { unsigned _sp = 0; while (cond) { __builtin_amdgcn_s_sleep(1); \
    if ((++_sp & 255u) == 0u) { if (xb_ld(&(bar)[XB_TMO])) break; if (_sp > XB_SPIN_CAP) { atomicAdd(&(bar)[XB_TMO], 1u); break; } } } } while (0)

struct XcdBarrier {
    unsigned* bar; unsigned x;
    volatile LAS unsigned* st;
};

__device__ __forceinline__ XcdBarrier xcd_barrier_post(unsigned* bar, volatile LAS unsigned* st) {
    XcdBarrier b; b.bar = bar; b.x = xb_xcc_id(); b.st = st;
    if (threadIdx.x == 0) (void)xb_add(&bar[XB_XCNT(b.x)], 1u);
    return b;
}
__device__ __forceinline__ void xcd_barrier_complete(unsigned* bar, unsigned x, unsigned& nloc, unsigned& nx) {
    const unsigned G = gridDim.x * gridDim.y * gridDim.z;
    unsigned sum, cnt, mine, sp = 0u;
    for (;;) {
        sum = 0u; cnt = 0u; mine = 0u;
#pragma unroll
        for (unsigned j = 0; j < 16; ++j) { const unsigned c = xb_ld(&bar[XB_XCNT(j)]); sum += c; cnt += (c > 0u) ? 1u : 0u; mine = (j == x) ? c : mine; }
        if (sum == G) break;
        __builtin_amdgcn_s_sleep(1);
        if ((++sp & 255u) == 0u) { if (xb_ld(&bar[XB_TMO])) break; if (sp > XB_SPIN_CAP) { atomicAdd(&bar[XB_TMO], 1u); break; } }
    }
    nloc = mine > 0u ? mine : 1u; nx = cnt > 0u ? cnt : 1u;
}

__device__ __forceinline__ void xcd_barrier(const XcdBarrier& b) {
    asm volatile("s_waitcnt vmcnt(0)" ::: "memory");
    __syncthreads();
    if (threadIdx.x == 0) {
        unsigned* bar = b.bar;
        __builtin_amdgcn_s_waitcnt(0);
        unsigned nloc = b.st[0], nx = b.st[1];
        if (nloc == 0u) { xcd_barrier_complete(bar, b.x, nloc, nx); b.st[0] = nloc; b.st[1] = nx; }
        const unsigned old = xb_add(&bar[XB_XSUB(b.x)], 1u);
        const unsigned gen = old / nloc;
        if (old + 1u == (gen + 1u) * nloc) {
            __builtin_amdgcn_fence(__ATOMIC_RELEASE, "agent");
            asm volatile("s_waitcnt vmcnt(0)" ::: "memory");
            const unsigned og = xb_add(&bar[XB_TOP], 1u);
            const unsigned tg = og / nx;
            if (og + 1u == (tg + 1u) * nx) xb_add(&bar[XB_TOPGEN], 1u);
            else XB_SPIN(xb_ld(&bar[XB_TOPGEN]) == tg, bar);
            __builtin_amdgcn_fence(__ATOMIC_ACQUIRE, "agent");
            xb_add(&bar[XB_XGEN(b.x)], 1u);
            asm volatile("s_waitcnt vmcnt(0)" ::: "memory");
        } else {
            XB_SPIN(xb_ld(&bar[XB_XGEN(b.x)]) == gen, bar);
            __builtin_amdgcn_fence(__ATOMIC_ACQUIRE, "agent");
            asm volatile("s_waitcnt vmcnt(0)" ::: "memory");
        }
    }
    __syncthreads();
}

DI void gbar(unsigned* ctr, unsigned nblk) {
  __syncthreads();
  if (threadIdx.x == 0) {
    __hip_atomic_fetch_add(ctr, 1u, __ATOMIC_RELEASE, __HIP_MEMORY_SCOPE_AGENT);
    while (__hip_atomic_load(ctr, __ATOMIC_RELAXED, __HIP_MEMORY_SCOPE_AGENT) < nblk) __builtin_amdgcn_s_sleep(1);
    __builtin_amdgcn_fence(__ATOMIC_ACQUIRE, "agent");
  }
  __syncthreads();
}

__global__ void __launch_bounds__(NT) mega(Params P) {
  extern __shared__ __attribute__((aligned(16))) unsigned char smem[];
  const int bid = blockIdx.x, nblk = gridDim.x;
  volatile LAS unsigned* xst = (volatile LAS unsigned*)(LAS unsigned char*)(smem + LDS_BYTES - 16);
  if (threadIdx.x == 0) { xst[0] = 0u; xst[1] = 0u; }
  __syncthreads();
  const XcdBarrier xb = xcd_barrier_post((unsigned*)(P.ws + OFF_ERR), xst);
  for (int ph = P.ph_lo; ph < P.ph_hi; ++ph) {
    int lb = bid, ln = nblk;
    asm volatile("" : "+s"(lb), "+s"(ln));
#ifdef PROBE_PH
    if (ph == PROBE_PH) { run_phase(P, ph, smem, lb, ln); cg::this_grid().sync(); }
#endif
    run_phase(P, ph, smem, lb, ln);
    if (ph + 1 < P.ph_hi) {
      if (P.ph_hi < 0) cg::this_grid().sync();
      xcd_barrier(xb);
    }
  }
}

extern "C" void kernel_launch(void* const* d_in, const int* in_sizes, int n_in, void* d_out, int out_size, void* d_ws, size_t ws_size,
                              hipStream_t stream) {
  static int grid = 0;
  if (grid == 0) {
    if (n_in != 37 || ws_size < WS_NEED) { fprintf(stderr, "kernel_launch: bad n_in %d / ws %zu\n", n_in, ws_size); grid = -1; return; }
    int dev = 0, cus = 0, per_cu = 0;
    hipGetDevice(&dev);
    hipDeviceGetAttribute(&cus, hipDeviceAttributeMultiprocessorCount, dev);
    if (hipFuncSetAttribute((const void*)mega, hipFuncAttributeMaxDynamicSharedMemorySize, LDS_BYTES) != hipSuccess) { fprintf(stderr, "hipFuncSetAttribute failed\n"); grid = -1; return; }
    hipOccupancyMaxActiveBlocksPerMultiprocessor(&per_cu, (const void*)mega, NT, LDS_BYTES);
    (void)hipGetLastError();
    if (per_cu < 1) per_cu = 1;
    grid = cus * per_cu;
  }
  if (grid < 0) return;
  Params p{};
  const float** fp = (const float**)&p;
  for (int i = 0; i < 37; ++i) fp[i] = (const float*)d_in[i];
  p.out = (float*)d_out;
  p.ws = (unsigned char*)d_ws;
  {
    int m = 0, tot = 0;
    auto add = [&](const float* src, size_t dst, int K, int N, int Np) {
      p.mats[m].src = src; p.mats[m].dst = dst; p.mats[m].K = K; p.mats[m].N = N; p.mats[m].Np = Np; p.mats[m].perm = (src == p.mla_w_ukv) ? 1 : 0;
      p.mats[m].tiles = (K / 64) * (Np / 256); tot += p.mats[m].tiles; ++m;
    };
    for (int i = 0; i < 4; ++i) {
      add(p.mlp_w1 + (size_t)i * 1024 * 4096, W_MLP1(i), 1024, 4096, 4096);
      add(p.mlp_w2 + (size_t)i * 4096 * 1024, W_MLP2(i), 4096, 1024, 1024);
    }
    for (int j = 0; j < 2; ++j) {
      add(p.hy_w_in + (size_t)j * 1024 * 3072, W_HYIN(j), 1024, 3072, 3072);
      add(p.hy_w_out + (size_t)j * 1024 * 1024, W_HYOUT(j), 1024, 1024, 1024);
      add(p.hy_f_w4 + (size_t)j * 64 * 4096, W_HYF4(j), 64, 4096, 4096);
    }
    add(p.gla_w_in, W_GLAIN, 1024, GLA_N, GLA_NP);
    add(p.gla_wo, W_GLAWO, 1024, 1024, 1024);
    add(p.mla_w_down, W_MLADN, 1024, MLA_DN, MLA_DNP);
    add(p.mla_w_uq, W_MLAUQ, 384, 1536, 1536);
    add(p.mla_w_ukv, W_MLAUKV, 256, 2048, 2048);
    add(p.mla_wo, W_MLAWO, 1024, 1024, 1024);
    for (; m < NMAT; ++m) { p.mats[m].tiles = 0; }
    p.total_mat_tiles = tot;
  }
  (void)hipMemsetAsync((unsigned char*)d_ws + OFF_ERR, 0, 16384, stream);
#if MULTI
  for (int ph = 0; ph < NPHASE; ++ph) {
    p.ph_lo = ph; p.ph_hi = ph + 1;
    hipLaunchKernelGGL(mega, dim3(grid), dim3(NT), LDS_BYTES, stream, p);
  }
#else
  p.ph_lo = 0; p.ph_hi = NPHASE;
  void* args[] = {&p};
  hipError_t e = hipLaunchCooperativeKernel((const void*)mega, dim3(grid), dim3(NT), args, LDS_BYTES, stream);
  if (e != hipSuccess) fprintf(stderr, "cooperative launch failed: %s (grid %d)\n", hipGetErrorString(e), grid);
#endif
}
```

```cpp
#include <hip/hip_runtime.h>
#include <hip/hip_cooperative_groups.h>
#include <cstdio>
#include <cstdint>
namespace cg = cooperative_groups;

#ifndef MULTI
#define MULTI 0
#endif
#ifndef CHECKS
#define CHECKS 0
#endif

typedef unsigned short u16;
using bf16x8 = __attribute__((ext_vector_type(8))) short;
using u16x4  = __attribute__((ext_vector_type(4))) unsigned short;
using u16x8  = __attribute__((ext_vector_type(8))) unsigned short;
using f32x16 = __attribute__((ext_vector_type(16))) float;
#define DI __device__ __forceinline__
#define MFMA32(a, b, c) __builtin_amdgcn_mfma_f32_32x32x16_bf16((a), (b), (c), 0, 0, 0)

constexpr int DM = 1024, NB = 4, SEQ = 8192, NCTX = 256;
constexpr int NL = NB * SEQ;
constexpr int NTOK = NL + NB * NCTX;
constexpr int HID = 4096;
constexpr int NT = 512;
constexpr int GLA_N = 3104, GLA_NP = 3328;
constexpr int MLA_DN = 704, MLA_DNP = 768;
constexpr int KTL = SEQ + NCTX;
constexpr int NKEY = SEQ + NCTX;
constexpr float EPS = 1e-6f;

constexpr size_t MiB = 1048576;
constexpr size_t OFF_MOD = 0;
constexpr size_t OFF_ERR = 512 * 1024;
constexpr size_t OFF_XC  = 1 * MiB;
constexpr size_t OFF_H3  = 5 * MiB;
constexpr size_t OFF_WT  = 8 * MiB;
constexpr size_t OFF_A   = 104 * MiB;
constexpr size_t OFF_BIG = 170 * MiB;
constexpr size_t WS_NEED = 510 * MiB;
constexpr size_t W_MLP1(int i) { return (size_t)i * 8388608; }
constexpr size_t W_MLP2(int i) { return (size_t)i * 8388608 + 4194304; }
constexpr size_t W_HY0 = 33554432;
constexpr size_t W_HYIN(int j)  { return W_HY0 + (size_t)j * 4456448; }
constexpr size_t W_HYOUT(int j) { return W_HYIN(j) + 3145728; }
constexpr size_t W_HYF4(int j)  { return W_HYOUT(j) + 1048576; }
constexpr size_t W_GLAIN = W_HY0 + 2 * 4456448;
constexpr size_t W_GLAWO = W_GLAIN + (size_t)GLA_NP * 1024;
constexpr size_t W_MLADN = W_GLAWO + 1048576;
constexpr size_t W_MLAUQ = W_MLADN + (size_t)MLA_DNP * 1024;
constexpr size_t W_MLAUKV = W_MLAUQ + 1536 * 384;
constexpr size_t W_MLAWO = W_MLAUKV + 2048 * 256;
constexpr size_t W_END = W_MLAWO + 1048576;
static_assert(W_END * 2 <= 96 * MiB, "wt");
constexpr size_t B_ZT = 0;
constexpr size_t B_YT = (size_t)3072 * NTOK * 2;
constexpr size_t B_KT = B_YT + (size_t)1024 * NTOK * 2;
constexpr size_t B_HID = 0;
constexpr size_t B_GZ = 0;
constexpr size_t B_GOB = (size_t)NTOK * GLA_N * 2;
constexpr size_t B_G2 = B_GOB + (size_t)NTOK * 1024 * 2;
constexpr size_t B_DEC = B_G2 + (size_t)NTOK * 1024 * 2;
constexpr size_t B_Q = 0;
constexpr size_t B_KN = (size_t)NL * 1536 * 2;
constexpr size_t B_VT = B_KN + (size_t)NTOK * 1024 * 2;
constexpr size_t B_KR = B_VT + (size_t)NTOK * 1024 * 2;
constexpr size_t B_CD = B_KR + (size_t)NTOK * 64 * 2;
static_assert(B_KT + (size_t)4096 * KTL * 2 <= 330 * MiB, "big");
static_assert(B_CD + (size_t)NTOK * 768 * 2 <= 330 * MiB, "big2");
static_assert(B_DEC + (size_t)528 * 4 * 2 * 128 * 4 <= 340 * MiB, "big3");
constexpr size_t A_CQN = 0;
constexpr size_t A_CKVN = (size_t)NL * 384 * 2;

constexpr int LDS_BYTES = 148 * 1024;

struct MatDesc { const float* src; unsigned long long dst; int K, N, Np, tiles, perm, pad; };
constexpr int NMAT = 22;

struct Params {
  const float *x, *c, *ctx, *c_ctx, *ada_w, *ada_b, *norm1_g, *norm2_g, *mlp_w1, *mlp_w2, *final_g;
  const float *hy_w_in, *hy_b_in, *hy_conv_w, *hy_conv_b, *hy_f_w1, *hy_f_b1, *hy_f_w2, *hy_f_b2, *hy_f_w3, *hy_f_b3, *hy_f_w4,
      *hy_freq, *hy_bias, *hy_w_out, *hy_b_out;
  const float *gla_w_in, *gla_gk_w2, *gla_gk_b, *gla_onorm, *gla_wo;
  const float *mla_w_down, *mla_qnorm, *mla_w_uq, *mla_kvnorm, *mla_w_ukv, *mla_wo;
  float* out;
  unsigned char* ws;
  MatDesc mats[NMAT];
  int total_mat_tiles;
  int ph_lo, ph_hi;
  int pad0;
};

DI u16 f2bf(float x) { unsigned u = __float_as_uint(x); u += 0x7fffu + ((u >> 16) & 1u); return (u16)(u >> 16); }
DI float bf2f(u16 v) { return __uint_as_float(((unsigned)v) << 16); }
typedef float f2v_t __attribute__((ext_vector_type(2)));
typedef __bf16 b2v_t __attribute__((ext_vector_type(2)));
DI unsigned pk2(float lo, float hi) { f2v_t v; v.x = lo; v.y = hi; return __builtin_bit_cast(unsigned, __builtin_convertvector(v, b2v_t)); }
DI float shx(float v, int mask, int lane) { return __int_as_float(__builtin_amdgcn_ds_bpermute((lane ^ mask) << 2, __float_as_int(v))); }
DI float wave_sum(float v, int lane) {
#pragma unroll
  for (int o = 32; o > 0; o >>= 1) v += shx(v, o, lane);
  return v;
}
DI int ltid() { int t = threadIdx.x; asm volatile("" : "+v"(t)); return t; }
DI unsigned char* lws(const Params& P) { unsigned char* w = P.ws; asm volatile("" : "+s"(w)); return w; }
DI float lzero() { float z; asm volatile("v_mov_b32 %0, 0" : "=v"(z)); return z; }
DI int crow(int reg, int h) { return (reg & 3) + 8 * (reg >> 2) + 4 * h; }
DI float silu(float x) { return x / (1.f + __expf(-x)); }
DI int mod_index(int row) { return row < NL ? (row >> 13) : 4; }

namespace pg8 {
#define PG8_LAS __attribute__((address_space(3)))
typedef unsigned short bf16_t;
typedef short bf16x8 __attribute__((ext_vector_type(8)));
typedef float f32x4 __attribute__((ext_vector_type(4)));
typedef unsigned u32x4 __attribute__((ext_vector_type(4)));
constexpr int BM = 256, BK = 64, HALF = 128, HTB = HALF * BK * 2  , STAGE_BYTES = 8 * HTB, NXCD = 8, WGM = 8;

__host__ __device__ __forceinline__ int lds_byte(int r, int c) { const int st = (r >> 4) * 2 + (c >> 5), rr = r & 15, cc = c & 31, ob = rr * 64 + cc * 2; return st * 1024 + (ob ^ (((ob >> 9) & 1) << 5)); }
__host__ __device__ __forceinline__ void stage_rc(int b, int& R, int& C) { const int st = b / 1024, sb = b % 1024, swz = sb ^ (((sb >> 9) & 1) << 5); R = (st >> 1) * 16 + swz / 64; C = (st & 1) * 32 + (swz % 64) / 2; }
__host__ __device__ __forceinline__ int perm32(int rho) { const int n = rho >> 4, i = rho & 15; return 8 * (i >> 2) + 4 * n + (i & 3); }

struct Unit { int pm, pn, koff; };
struct Gemm { const bf16_t* A; const bf16_t* Bt; int M, N, K, ld; };

struct StaticOrder {
    int nM, nN, nwg, G, c;
    __host__ __device__ void init(int M, int N, int G_, int c_) { nM = M / BM; nN = N / BM; nwg = nM * nN; G = G_; c = c_; }
    __host__ __device__ bool next(int i, Unit& u) const {
        const long L = (long)i * G + c; if (L >= nwg) return false;
        int wgid = (int)L; { const int q = nwg / NXCD, r = nwg % NXCD, xcd = wgid % NXCD, off = wgid / NXCD; wgid = (xcd < r ? xcd * (q + 1) : r * (q + 1) + (xcd - r) * q) + off; }
        const int nig = WGM * nN, gid = wgid / nig, fm = gid * WGM, gsz = (nM - fm) < WGM ? (nM - fm) : WGM;
        u.pm = fm + ((wgid % nig) % gsz); u.pn = (wgid % nig) / gsz; u.koff = 0; return true;
    }
    __device__ __forceinline__ void a_ready(const Unit&) const {}
    __device__ __forceinline__ void done(const Unit&) const {}
};

template <class Epi, class Sched, bool STAMP = false>
__device__ __forceinline__ void gemm_phase(PG8_LAS unsigned char* lds, const Gemm g, const Sched& S, const Epi& E, unsigned long long* stamps) {
    const int tid = ltid(), wid = __builtin_amdgcn_readfirstlane(tid >> 6), lane = tid & 63, wr = wid >> 2, wc = wid & 3, fr = lane & 15, fq = lane >> 4;
    const int K = g.ld, nt = g.K / BK;
    int ts_lo = 0, ts_hi = 0, nts = 0; const unsigned long long rt_entry = STAMP ? (unsigned long long)wall_clock64() : 0ull;
#define PG8_STAMP() do { if (STAMP && wid == 0 && nts < 64) { const unsigned long long _c = (unsigned long long)clock64(); \
        ts_lo = (lane == nts) ? (int)(unsigned)_c : ts_lo; ts_hi = (lane == nts) ? (int)(unsigned)(_c >> 32) : ts_hi; ++nts; } } while (0)
    PG8_STAMP();
    unsigned voffA[2], voffB[2];
#pragma unroll
    for (int i = 0; i < 2; ++i) { int R, C; stage_rc(tid * 16 + i * 8192, R, C); const int Rb = Epi::PERM ? ((R & ~31) + perm32(R & 31)) : R;
        voffA[i] = (unsigned)(R * K + C) * 2u; voffB[i] = (unsigned)(Rb * K + C) * 2u; }
    const size_t kstep = (size_t)(BK * 2);
    const size_t hstep = (size_t)HALF * K * 2;
    const size_t tstep = 2 * hstep;
    const unsigned ldsw = (unsigned)wid * 1024u;
    const int aoff = lds_byte(wr * 64 + fr, fq * 8), boff = lds_byte(wc * 32 + fr, fq * 8);
#define PG8_SA(b, h) (((b) * 2 + (h)) * HTB)
#define PG8_SB(b, h) ((4 + (b) * 2 + (h)) * HTB)
#define PG8_STAGE(bufoff, gbase, voff) do { _Pragma("unroll") for (int _i = 0; _i < 2; ++_i) \
        __builtin_amdgcn_global_load_lds((const unsigned*)((const char*)(gbase) + (voff)[_i]), (PG8_LAS unsigned*)(lds + (bufoff) + ldsw + _i * 8192), 16, 0, 0); } while (0)
#define PG8_LDA(dst, b, h) do { _Pragma("unroll") for (int m = 0; m < 4; ++m) _Pragma("unroll") for (int k = 0; k < 2; ++k) dst[m][k] = *(const PG8_LAS bf16x8*)(lds + PG8_SA(b, h) + aoff + m * 2048 + k * 1024); } while (0)
#define PG8_LDB(dst, b, h) do { _Pragma("unroll") for (int n = 0; n < 2; ++n) _Pragma("unroll") for (int k = 0; k < 2; ++k) dst[n][k] = *(const PG8_LAS bf16x8*)(lds + PG8_SB(b, h) + boff + n * 2048 + k * 1024); } while (0)
#define PG8_MMA(ai, bj, At, Bt) do { __builtin_amdgcn_s_setprio(1); _Pragma("unroll") for (int m = 0; m < 4; ++m) _Pragma("unroll") for (int n = 0; n < 2; ++n) _Pragma("unroll") for (int k = 0; k < 2; ++k) \
        acc[ai][bj][m][n] = __builtin_amdgcn_mfma_f32_16x16x32_bf16(Bt[n][k], At[m][k], acc[ai][bj][m][n], 0, 0, 0); __builtin_amdgcn_s_setprio(0); } while (0)
#define PG8_WAIT_V(n) asm volatile("s_waitcnt vmcnt(" #n ")" ::: "memory")
#define PG8_WAIT_L(n) asm volatile("s_waitcnt lgkmcnt(" #n ")" ::: "memory")
#define PG8_BAR __builtin_amdgcn_s_barrier()
#define PG8_SCHED __builtin_amdgcn_sched_barrier(0)
    Unit cur, nxt; int ui = 0;
    if (!S.next(0, cur)) return;
    f32x4 acc[2][2][4][2];
#pragma unroll
    for (int a = 0; a < 2; ++a)
#pragma unroll
        for (int b = 0; b < 2; ++b)
#pragma unroll
            for (int m = 0; m < 4; ++m)
#pragma unroll
                for (int n = 0; n < 2; ++n) acc[a][b][m][n] = (f32x4){0.f, 0.f, 0.f, 0.f};
    bf16x8 At[4][2], B0[2][2], B1[2][2];
    const char* cA = (const char*)g.A + (size_t)cur.pm * tstep + (size_t)cur.koff * 2; const char* cB = (const char*)g.Bt + (size_t)cur.pn * tstep + (size_t)cur.koff * 2;
    S.a_ready(cur);
    PG8_STAGE(PG8_SB(0, 0), cB, voffB); PG8_STAGE(PG8_SA(0, 0), cA, voffA); PG8_STAGE(PG8_SB(0, 1), cB + hstep, voffB); PG8_STAGE(PG8_SA(0, 1), cA + hstep, voffA);
    if (wr == 1) PG8_BAR;
    PG8_WAIT_V(4); PG8_BAR;
    PG8_STAGE(PG8_SB(1, 0), cB + kstep, voffB); PG8_STAGE(PG8_SA(1, 0), cA + kstep, voffA); PG8_STAGE(PG8_SB(1, 1), cB + hstep + kstep, voffB);
    PG8_WAIT_V(6); PG8_BAR;
    PG8_STAMP();
    for (;;) {
        const bool has_next = S.next(ui + 1, nxt);
        const char* nA = has_next ? (const char*)g.A + (size_t)nxt.pm * tstep + (size_t)nxt.koff * 2 : cA; const char* nB = has_next ? (const char*)g.Bt + (size_t)nxt.pn * tstep + (size_t)nxt.koff * 2 : cB;
        for (int t = 0; t < nt; t += 2) {
            const bool last = (t == nt - 2);
            const char* a1 = cA + (size_t)(t + 1) * kstep;
            const char* a2 = last ? nA : cA + (size_t)(t + 2) * kstep; const char* b2 = last ? nB : cB + (size_t)(t + 2) * kstep;
            const char* a3 = a2 + kstep; const char* b3 = b2 + kstep;
            if (last && has_next) S.a_ready(nxt);
            PG8_LDB(B0, 0, 0); PG8_SCHED; PG8_LDA(At, 0, 0); PG8_STAGE(PG8_SA(1, 1), a1 + hstep, voffA);
            PG8_WAIT_L(8); PG8_BAR; PG8_WAIT_L(0); PG8_MMA(0, 0, At, B0); PG8_BAR; PG8_SCHED;
            PG8_LDB(B1, 0, 1); PG8_STAGE(PG8_SB(0, 0), b2, voffB);
            PG8_BAR; PG8_WAIT_L(0); PG8_MMA(0, 1, At, B1); PG8_BAR;
            PG8_LDA(At, 0, 1); PG8_STAGE(PG8_SA(0, 0), a2, voffA);
            PG8_BAR; PG8_WAIT_L(0); PG8_MMA(1, 0, At, B0); PG8_BAR; PG8_SCHED;
            PG8_STAGE(PG8_SB(0, 1), b2 + hstep, voffB);
            PG8_WAIT_V(6); PG8_BAR; PG8_MMA(1, 1, At, B1); PG8_BAR;
            PG8_LDB(B0, 1, 0); PG8_SCHED; PG8_LDA(At, 1, 0); PG8_STAGE(PG8_SA(0, 1), a2 + hstep, voffA);
            PG8_WAIT_L(8); PG8_BAR; PG8_WAIT_L(0); PG8_MMA(0, 0, At, B0); PG8_BAR; PG8_SCHED;
            PG8_LDB(B1, 1, 1); PG8_STAGE(PG8_SB(1, 0), b3, voffB);
            PG8_BAR; PG8_WAIT_L(0); PG8_MMA(0, 1, At, B1); PG8_BAR;
            PG8_LDA(At, 1, 1); PG8_STAGE(PG8_SA(1, 0), a3, voffA);
            PG8_BAR; PG8_WAIT_L(0); PG8_MMA(1, 0, At, B0); PG8_BAR; PG8_SCHED;
            PG8_STAGE(PG8_SB(1, 1), b3 + hstep, voffB);
            PG8_WAIT_V(6); PG8_BAR; PG8_MMA(1, 1, At, B1); PG8_BAR;
        }
        PG8_STAMP();
        if constexpr (!Epi::AFTER_DRAIN) { E(acc, cur, wr, wc, fr, fq); S.done(cur); }
        PG8_STAMP();
        if (!has_next) break;
#pragma unroll
        for (int a = 0; a < 2; ++a)
#pragma unroll
            for (int b = 0; b < 2; ++b)
#pragma unroll
                for (int m = 0; m < 4; ++m)
#pragma unroll
                    for (int n = 0; n < 2; ++n) acc[a][b][m][n] = (f32x4){0.f, 0.f, 0.f, 0.f};
        cur = nxt; cA = nA; cB = nB; ++ui;
    }
    PG8_WAIT_V(0);
    if (wr == 0) PG8_BAR;
    PG8_BAR;
    if constexpr (Epi::AFTER_DRAIN) { E.fused(acc, cur, wr, wc, fr, fq, lds, wid, lane); S.done(cur); }
    PG8_STAMP();
    if (STAMP && wid == 0) { stamps[lane] = lane < nts ? (((unsigned long long)(unsigned)ts_hi << 32) | (unsigned)ts_lo) : 0ull;
        if (lane == 62) stamps[62] = rt_entry; if (lane == 63) stamps[63] = (unsigned long long)wall_clock64(); }
#undef PG8_STAMP
#undef PG8_SA
#undef PG8_SB
#undef PG8_STAGE
#undef PG8_LDA
#undef PG8_LDB
#undef PG8_MMA
#undef PG8_WAIT_V
#undef PG8_WAIT_L
#undef PG8_BAR
#undef PG8_SCHED
}
}

using pg8::f32x4; using pg8::u32x4;
#define EPI_ROWLOOP _Pragma("unroll") for (int ai = 0; ai < 2; ++ai) _Pragma("unroll") for (int m = 0; m < 4; ++m)
struct EHyIn {
  static constexpr bool PERM = true, AFTER_DRAIN = false;
  u16* o; const float* bias;
  DI void operator()(const f32x4 (&acc)[2][2][4][2], const pg8::Unit& u, int wr, int wc, int fr, int fq) const {
    const int row0 = u.pm * 256 + wr * 64 + fr, col0 = u.pn * 256 + wc * 32 + 8 * fq;
    EPI_ROWLOOP {
      const int row = row0 + ai * 128 + m * 16;
      const float bz = bias[row];
      u16* rp = o + (size_t)row * NTOK + col0;
#pragma unroll
      for (int bj = 0; bj < 2; ++bj) {
        const f32x4 v0 = acc[ai][bj][m][0], v1 = acc[ai][bj][m][1];
        u32x4 w; w.x = pk2(v0[0] + bz, v0[1] + bz); w.y = pk2(v0[2] + bz, v0[3] + bz); w.z = pk2(v1[0] + bz, v1[1] + bz); w.w = pk2(v1[2] + bz, v1[3] + bz);
        *(u32x4*)(rp + bj * 128) = w;
      }
    }
  }
};
struct ERes {
  static constexpr bool PERM = false, AFTER_DRAIN = false;
  const float* bias; const float* gate; int gofs; const float* xsl; const float* xsc; float* xdl; float* xdc;
  DI void operator()(const f32x4 (&acc)[2][2][4][2], const pg8::Unit& u, int wr, int wc, int fr, int fq) const {
    const int rowu = u.pm * 256;
    const int row0 = rowu + wr * 64 + fr, col0 = u.pn * 256 + wc * 32 + 4 * fq;
    const float* gp = gate + mod_index(rowu) * 6144 + gofs;
    const float* xs; float* xd;
    if (rowu < NL) { xs = xsl; xd = xdl; } else { xs = xsc - (size_t)NL * 1024; xd = xdc - (size_t)NL * 1024; }
#pragma unroll
    for (int bj = 0; bj < 2; ++bj)
#pragma unroll
      for (int n = 0; n < 2; ++n) {
        const f32x4 gv = *(const f32x4*)(gp + col0 + bj * 128 + n * 16);
        const f32x4 bv = bias ? *(const f32x4*)(bias + col0 + bj * 128 + n * 16) : (f32x4){0.f, 0.f, 0.f, 0.f};
        EPI_ROWLOOP {
          const size_t ro = (size_t)(row0 + ai * 128 + m * 16) * 1024 + col0 + bj * 128 + n * 16;
          const f32x4 xv = *(const f32x4*)(xs + ro);
          *(f32x4*)(xd + ro) = xv + gv * (acc[ai][bj][m][n] + bv);
        }
      }
  }
};
struct EResAtomic {
  static constexpr bool PERM = false, AFTER_DRAIN = false;
  const float* gate; float* xbase;
  DI void operator()(const f32x4 (&acc)[2][2][4][2], const pg8::Unit& u, int wr, int wc, int fr, int fq) const {
    const int row0 = u.pm * 256 + wr * 64 + fr, col0 = u.pn * 256 + wc * 32 + 4 * fq;
#pragma unroll
    for (int bj = 0; bj < 2; ++bj)
#pragma unroll
      for (int n = 0; n < 2; ++n) {
        const f32x4 gv = *(const f32x4*)(gate + col0 + bj * 128 + n * 16);
        EPI_ROWLOOP {
          float* xp = xbase + (size_t)(row0 + ai * 128 + m * 16) * 1024 + col0 + bj * 128 + n * 16;
          const f32x4 v = gv * acc[ai][bj][m][n];
          unsafeAtomicAdd(xp + 0, v[0]); unsafeAtomicAdd(xp + 1, v[1]); unsafeAtomicAdd(xp + 2, v[2]); unsafeAtomicAdd(xp + 3, v[3]);
        }
      }
  }
};
template <int MODE> struct EBf16 {
  static constexpr bool PERM = true, AFTER_DRAIN = false;
  u16* o; int ldc; int ncols;
  DI void operator()(const f32x4 (&acc)[2][2][4][2], const pg8::Unit& u, int wr, int wc, int fr, int fq) const {
    const int row0 = u.pm * 256 + wr * 64 + fr, col0 = u.pn * 256 + wc * 32 + 8 * fq;
    EPI_ROWLOOP {
      u16* rp = o + (size_t)(row0 + ai * 128 + m * 16) * ldc + col0;
#pragma unroll
      for (int bj = 0; bj < 2; ++bj) {
        f32x4 v0 = acc[ai][bj][m][0], v1 = acc[ai][bj][m][1];
        if (MODE == 1) {
#pragma unroll
          for (int j = 0; j < 4; ++j) { const float a = fmaxf(v0[j], 0.f), b = fmaxf(v1[j], 0.f); v0[j] = a * a; v1[j] = b * b; }
        }
        if (MODE == 2) { v0 = v0 * (0.07216878364870322f * 1.4426950408889634f); v1 = v1 * (0.07216878364870322f * 1.4426950408889634f); }
        u32x4 w; w.x = pk2(v0[0], v0[1]); w.y = pk2(v0[2], v0[3]); w.z = pk2(v1[0], v1[1]); w.w = pk2(v1[2], v1[3]);
        if (col0 + bj * 128 < ncols) *(u32x4*)(rp + bj * 128) = w;
      }
    }
  }
};
struct EMlaK {
  static constexpr bool PERM = true, AFTER_DRAIN = false;
  u16* o;
  DI void operator()(const f32x4 (&acc)[2][2][4][2], const pg8::Unit& u, int wr, int wc, int fr, int fq) const {
    const int row0 = u.pm * 256 + wr * 64 + fr, col0 = u.pn * 256 + wc * 32 + 8 * fq;
    EPI_ROWLOOP {
      const int row = row0 + ai * 128 + m * 16;
      int b, key;
      if (row < NL) { b = row >> 13; key = NCTX + (row & 8191); } else { b = (row - NL) >> 8; key = (row - NL) & 255; }
#pragma unroll
      for (int bj = 0; bj < 2; ++bj) {
        const int n = col0 + bj * 128, hd = n >> 7, c = n & 127;
        const f32x4 v0 = acc[ai][bj][m][0], v1 = acc[ai][bj][m][1];
        u32x4 w; w.x = pk2(v0[0], v0[1]); w.y = pk2(v0[2], v0[3]); w.z = pk2(v1[0], v1[1]); w.w = pk2(v1[2], v1[3]);
        *(u32x4*)(o + ((size_t)(b * 8 + hd) * NKEY + key) * 128 + c) = w;
      }
    }
  }
};
struct EMlaVT {
  static constexpr bool PERM = true, AFTER_DRAIN = false;
  u16* o;
  DI void operator()(const f32x4 (&acc)[2][2][4][2], const pg8::Unit& u, int wr, int wc, int fr, int fq) const {
    const int row0 = u.pm * 256 + wr * 64 + fr, col0 = u.pn * 256 + wc * 32 + 8 * fq;
#pragma unroll
    for (int bj = 0; bj < 2; ++bj) {
      const int tok = col0 + bj * 128;
      int b, key;
      if (tok < NL) { b = tok >> 13; key = NCTX + (tok & 8191); } else { b = (tok - NL) >> 8; key = (tok - NL) & 255; }
      EPI_ROWLOOP {
        const int vr = row0 + ai * 128 + m * 16, hd = vr >> 7, dv = vr & 127;
        const f32x4 v0 = acc[ai][bj][m][0], v1 = acc[ai][bj][m][1];
        u32x4 w; w.x = pk2(v0[0], v0[1]); w.y = pk2(v0[2], v0[3]); w.z = pk2(v1[0], v1[1]); w.w = pk2(v1[2], v1[3]);
        *(u32x4*)(o + ((size_t)(b * 8 + hd) * 128 + dv) * NKEY + key) = w;
      }
    }
  }
};
struct SplitKOrder {
  int nM, nN, nwg, G, c, klen;
  DI void init(int M, int N, int pieces, int klen_, int G_, int c_) { nM = M / 256; nN = N / 256; nwg = nM * nN * pieces; G = G_; c = c_; klen = klen_; }
  DI bool next(int i, pg8::Unit& u) const {
    const int L = i * G + c; if (L >= nwg) return false;
    const int t = L % (nM * nN), piece = L / (nM * nN);
    u.pm = t / nN; u.pn = t % nN; u.koff = piece * klen; return true;
  }
  DI void a_ready(const pg8::Unit&) const {}
  DI void done(const pg8::Unit&) const {}
};
template <class Epi>
DI void gemm8_splitk(const u16* A, const u16* Bt, int M, int N, int K, int pieces, const Epi& E, unsigned char* smem, int bid, int nblk) {
  asm volatile("" : "+s"(K));
  pg8::Gemm g; g.A = A; g.Bt = Bt; g.M = M; g.N = N; g.K = K / pieces; g.ld = K;
  SplitKOrder S; S.init(M, N, pieces, K / pieces, nblk, bid);
  __syncthreads();
  pg8::gemm_phase<Epi, SplitKOrder, false>((PG8_LAS unsigned char*)smem, g, S, E, nullptr);
  __syncthreads();
}
template <class Epi>
DI void gemm8(const u16* A, const u16* Bt, int M, int N, int K, const Epi& E, unsigned char* smem, int bid, int nblk) {
  asm volatile("" : "+s"(K));
  pg8::Gemm g; g.A = A; g.Bt = Bt; g.M = M; g.N = N; g.K = K; g.ld = K;
  pg8::StaticOrder S; S.init(M, N, nblk, bid);
  __syncthreads();
  pg8::gemm_phase<Epi, pg8::StaticOrder, false>((PG8_LAS unsigned char*)smem, g, S, E, nullptr);
  __syncthreads();
}

DI void pro_weights(const Params& P, unsigned char* smem, int bid, int nblk) {
  float* t = (float*)smem;
  const int tid = ltid();
  for (int tile = bid; tile < P.total_mat_tiles; tile += nblk) {
    int mi = 0, rem = tile;
    while (rem >= P.mats[mi].tiles) { rem -= P.mats[mi].tiles; ++mi; }
    const MatDesc md = P.mats[mi];
    const int ntn = md.Np / 256;
    const int k0 = (rem / ntn) * 64, n0 = (rem % ntn) * 256;
    u16* dst = (u16*)(lws(P) + OFF_WT) + md.dst;
    float4 v[8];
#pragma unroll
    for (int pass = 0; pass < 8; ++pass) {
      const int kr = (tid >> 6) + pass * 8, nc = (tid & 63) * 4;
      v[pass] = make_float4(0.f, 0.f, 0.f, 0.f);
      if (n0 + nc < md.N) v[pass] = *(const float4*)(md.src + (size_t)(k0 + kr) * md.N + n0 + nc);
    }
#pragma unroll
    for (int pass = 0; pass < 8; ++pass) {
      const int kr = (tid >> 6) + pass * 8, nc = (tid & 63) * 4;
      float* tp = t + kr * 257 + nc;
      tp[0] = v[pass].x; tp[1] = v[pass].y; tp[2] = v[pass].z; tp[3] = v[pass].w;
    }
    __syncthreads();
    {
      const int n = tid >> 1, kc = (tid & 1) * 32;
      int nr = n0 + n;
      if (md.perm) nr = ((nr & 255) < 128 ? 0 : 1024) + (nr >> 8) * 128 + (nr & 127);
      u16* dp = dst + (size_t)nr * md.K + k0 + kc;
#pragma unroll
      for (int g = 0; g < 4; ++g) {
        uint4 o;
        o.x = pk2(t[(kc + g * 8 + 0) * 257 + n], t[(kc + g * 8 + 1) * 257 + n]);
        o.y = pk2(t[(kc + g * 8 + 2) * 257 + n], t[(kc + g * 8 + 3) * 257 + n]);
        o.z = pk2(t[(kc + g * 8 + 4) * 257 + n], t[(kc + g * 8 + 5) * 257 + n]);
        o.w = pk2(t[(kc + g * 8 + 6) * 257 + n], t[(kc + g * 8 + 7) * 257 + n]);
        *(uint4*)(dp + g * 8) = o;
      }
    }
    __syncthreads();
  }
}

DI void pro_adaln(const Params& P, unsigned char* smem, int bid, int nblk) {
  float* sc = (float*)smem;
  float* red = sc + 5 * 1024;
  float* modw = (float*)(lws(P) + OFF_MOD);
  const int tid = ltid();
  for (int u = bid; u < 4 * 48; u += nblk) {
    const int li = u / 48, n0 = (u % 48) * 128;
    for (int e = tid; e < 5 * 1024; e += NT) {
      const int mi = e >> 10, k = e & 1023;
      const float v = mi < 4 ? P.c[mi * 1024 + k] : P.c_ctx[k];
      sc[e] = silu(v);
    }
    __syncthreads();
    const int nq = tid & 31, kg = tid >> 5;
    float acc[5][4];
#pragma unroll
    for (int a = 0; a < 5; ++a)
#pragma unroll
      for (int b = 0; b < 4; ++b) acc[a][b] = 0.f;
    const float* w = P.ada_w + (size_t)li * 1024 * 6144 + n0 + nq * 4;
    for (int kk = 0; kk < 64; ++kk) {
      const int k = kg * 64 + kk;
      const float4 wv = *(const float4*)(w + (size_t)k * 6144);
#pragma unroll
      for (int a = 0; a < 5; ++a) {
        const float s = sc[a * 1024 + k];
        acc[a][0] += s * wv.x; acc[a][1] += s * wv.y; acc[a][2] += s * wv.z; acc[a][3] += s * wv.w;
      }
    }
#pragma unroll
    for (int a = 0; a < 5; ++a)
#pragma unroll
      for (int b = 0; b < 4; ++b) red[(kg * 5 + a) * 128 + nq * 4 + b] = acc[a][b];
    __syncthreads();
    for (int e = tid; e < 5 * 128; e += NT) {
      const int a = e >> 7, n = e & 127;
      float s = P.ada_b[li * 6144 + n0 + n];
#pragma unroll
      for (int g = 0; g < 16; ++g) s += red[(g * 5 + a) * 128 + n];
      modw[(size_t)(li * 5 + a) * 6144 + n0 + n] = s;
    }
    __syncthreads();
  }
}

DI void pro_filter_mlp(const Params& P, int bid, int nblk) {
  const int lane = ltid() & 63, wv = ltid() >> 6;
  u16* h3 = (u16*)(lws(P) + OFF_H3);
  for (int task = bid * 8 + wv; task < 2 * KTL; task += nblk * 8) {
    const int j = task / KTL, row = task % KTL;
    const int L = row < SEQ ? SEQ : NCTX;
    const int l = row < SEQ ? row : row - SEQ;
    const float* w1 = P.hy_f_w1 + j * 33 * 64; const float* b1 = P.hy_f_b1 + j * 64;
    const float* w2 = P.hy_f_w2 + j * 64 * 64; const float* b2 = P.hy_f_b2 + j * 64;
    const float* w3 = P.hy_f_w3 + j * 64 * 64; const float* b3 = P.hy_f_b3 + j * 64;
    const float fr = P.hy_freq[j * 64 + lane];
    const float tl = (float)l / (float)(L - 1);
    const float w = 6.283185307179586f * (float)l / (float)L;
    float zf = 0.f;
    if (lane == 0) zf = tl;
    else if (lane <= 32) {
      const int bi = (lane - 1) & 15;
      const float f = 1e-4f + (float)bi * ((15.f - 1e-4f) / 15.f);
      const float a = f * w;
      zf = lane <= 16 ? cosf(a) : -sinf(a);
    }
    float acc = b1[lane];
#pragma unroll
    for (int k = 0; k < 33; ++k) acc += __int_as_float(__builtin_amdgcn_readlane(__float_as_int(zf), k)) * w1[k * 64 + lane];
    float h = sinf(fr * acc);
    acc = b2[lane];
#pragma unroll
    for (int k = 0; k < 64; ++k) acc += __int_as_float(__builtin_amdgcn_readlane(__float_as_int(h), k)) * w2[k * 64 + lane];
    h = sinf(fr * acc);
    acc = b3[lane];
#pragma unroll
    for (int k = 0; k < 64; ++k) acc += __int_as_float(__builtin_amdgcn_readlane(__float_as_int(h), k)) * w3[k * 64 + lane];
    h = sinf(fr * acc);
    h3[((size_t)j * KTL + row) * 64 + lane] = f2bf(h);
  }
}

DI void normmod_phase(const Params& P, int li, int which, int nrows, const float* xl, const float* xc, int bid, int nblk) {
  const int lane = ltid() & 63, wv = ltid() >> 6;
  u16* A = (u16*)(lws(P) + OFF_A);
  const float* g = (which ? P.norm2_g : P.norm1_g) + li * 1024;
  const float* modw = (const float*)(lws(P) + OFF_MOD) + (size_t)li * 5 * 6144;
  for (int row = (bid * 8 + wv) * 2; row < nrows; row += nblk * 16) {
    const float* xr = row < NL ? xl + (size_t)row * 1024 : xc + (size_t)(row - NL) * 1024;
    const float* md = modw + mod_index(row) * 6144 + (which ? 3 * 1024 : 0);
    float4 v0[4], v1[4];
#pragma unroll
    for (int j = 0; j < 4; ++j) { v0[j] = *(const float4*)(xr + j * 256 + lane * 4); v1[j] = *(const float4*)(xr + 1024 + j * 256 + lane * 4); }
    float s0 = 0.f, s1 = 0.f;
#pragma unroll
    for (int j = 0; j < 4; ++j) {
      s0 += v0[j].x * v0[j].x + v0[j].y * v0[j].y + v0[j].z * v0[j].z + v0[j].w * v0[j].w;
      s1 += v1[j].x * v1[j].x + v1[j].y * v1[j].y + v1[j].z * v1[j].z + v1[j].w * v1[j].w;
    }
    s0 = wave_sum(s0, lane); s1 = wave_sum(s1, lane);
    const float r0 = rsqrtf(s0 * (1.f / 1024.f) + EPS), r1 = rsqrtf(s1 * (1.f / 1024.f) + EPS);
#pragma unroll
    for (int j = 0; j < 4; ++j) {
      const int k = j * 256 + lane * 4;
      const float4 gg = *(const float4*)(g + k);
      const float4 sh = *(const float4*)(md + k);
      const float4 sc = *(const float4*)(md + 1024 + k);
      const float mx = gg.x * (1.f + sc.x), my = gg.y * (1.f + sc.y), mz = gg.z * (1.f + sc.z), mw = gg.w * (1.f + sc.w);
      uint2 o0, o1;
      o0.x = pk2(v0[j].x * r0 * mx + sh.x, v0[j].y * r0 * my + sh.y); o0.y = pk2(v0[j].z * r0 * mz + sh.z, v0[j].w * r0 * mw + sh.w);
      o1.x = pk2(v1[j].x * r1 * mx + sh.x, v1[j].y * r1 * my + sh.y); o1.y = pk2(v1[j].z * r1 * mz + sh.z, v1[j].w * r1 * mw + sh.w);
      *(uint2*)(A + (size_t)row * 1024 + k) = o0;
      *(uint2*)(A + (size_t)(row + 1) * 1024 + k) = o1;
    }
  }
}

DI void final_norm_phase(const Params& P, int bid, int nblk) {
  const int lane = ltid() & 63, wv = ltid() >> 6;
  for (int row = (bid * 8 + wv) * 2; row < NL; row += nblk * 16) {
    float* xr = P.out + (size_t)row * 1024;
    float4 v0[4], v1[4];
#pragma unroll
    for (int j = 0; j < 4; ++j) { v0[j] = *(const float4*)(xr + j * 256 + lane * 4); v1[j] = *(const float4*)(xr + 1024 + j * 256 + lane * 4); }
    float s0 = 0.f, s1 = 0.f;
#pragma unroll
    for (int j = 0; j < 4; ++j) {
      s0 += v0[j].x * v0[j].x + v0[j].y * v0[j].y + v0[j].z * v0[j].z + v0[j].w * v0[j].w;
      s1 += v1[j].x * v1[j].x + v1[j].y * v1[j].y + v1[j].z * v1[j].z + v1[j].w * v1[j].w;
    }
    s0 = wave_sum(s0, lane); s1 = wave_sum(s1, lane);
    const float r0 = rsqrtf(s0 * (1.f / 1024.f) + EPS), r1 = rsqrtf(s1 * (1.f / 1024.f) + EPS);
#pragma unroll
    for (int j = 0; j < 4; ++j) {
      const int k = j * 256 + lane * 4;
      const float4 gg = *(const float4*)(P.final_g + k);
      float4 o0, o1;
      o0.x = v0[j].x * r0 * gg.x; o0.y = v0[j].y * r0 * gg.y; o0.z = v0[j].z * r0 * gg.z; o0.w = v0[j].w * r0 * gg.w;
      o1.x = v1[j].x * r1 * gg.x; o1.y = v1[j].y * r1 * gg.y; o1.z = v1[j].z * r1 * gg.z; o1.w = v1[j].w * r1 * gg.w;
      *(float4*)(xr + k) = o0;
      *(float4*)(xr + 1024 + k) = o1;
    }
  }
}

enum { EPI_HYIN = 0, EPI_FILT, EPI_RES, EPI_MLP1, EPI_GLAIN, EPI_MLADN, EPI_MLAQ, EPI_MLAKV };
struct EpiArgs {
  const float* bias;
  const float* gate;
  int gofs;
  const float* xsl; const float* xsc;
  float* xdl; float* xdc;
  u16* o0; u16* o1;
  int mrow0;
  int L;
};

constexpr int GS = 72;

template <int EPI>
DI void epi_tile(const EpiArgs& ea, const f32x16& acc, int mb, int nb, int lane) {
  const int r = lane & 31, h = lane >> 5;
  if constexpr (EPI == EPI_HYIN) {
    u16* base = ea.o0 + (size_t)nb * NTOK + mb;
    const float* bp = ea.bias + nb;
    const int voff = 4 * h * NTOK + r;
#pragma unroll
    for (int i = 0; i < 16; ++i) {
      const int rc = (i & 3) + 8 * (i >> 2);
      base[rc * NTOK + voff] = f2bf(acc[i] + bp[rc + 4 * h]);
    }
  } else if constexpr (EPI == EPI_FILT) {
    const int l = mb + r;
    const float t = (float)l / (float)(ea.L - 1);
    u16* base = ea.o0 + (size_t)nb * KTL + ea.mrow0 + mb;
    const int voff = 4 * h * KTL + r;
#pragma unroll
    for (int i = 0; i < 16; ++i) {
      const int rc = (i & 3) + 8 * (i >> 2);
      const int d = (nb + rc + 4 * h) & 1023;
      const float mind = -3.0701134573253945f, maxd = -15.350567286626972f;
      const float delta = mind + (float)d * ((maxd - mind) / 1023.f);
      base[rc * KTL + voff] = f2bf(acc[i] * __expf(-t * fabsf(delta)));
    }
  } else if constexpr (EPI == EPI_RES) {
    const int n = nb + r;
    const float bz = ea.bias ? ea.bias[n] : 0.f;
    const float gt = ea.gate[mod_index(mb) * 6144 + ea.gofs + n];
    const float* xs; float* xd;
    if (mb < NL) { xs = ea.xsl + (size_t)mb * 1024 + nb; xd = ea.xdl + (size_t)mb * 1024 + nb; }
    else { xs = ea.xsc + (size_t)(mb - NL) * 1024 + nb; xd = ea.xdc + (size_t)(mb - NL) * 1024 + nb; }
    const int voff = 4 * h * 1024 + r;
#pragma unroll
    for (int i = 0; i < 16; ++i) {
      const int rc = (i & 3) + 8 * (i >> 2);
      xd[rc * 1024 + voff] = xs[rc * 1024 + voff] + gt * (acc[i] + bz);
    }
  } else if constexpr (EPI == EPI_MLP1) {
    u16* base = ea.o0 + (size_t)mb * HID + nb;
    const int voff = 4 * h * HID + r;
#pragma unroll
    for (int i = 0; i < 16; ++i) {
      const int rc = (i & 3) + 8 * (i >> 2);
      const float v = fmaxf(acc[i], 0.f);
      base[rc * HID + voff] = f2bf(v * v);
    }
  } else if constexpr (EPI == EPI_GLAIN) {
    if (nb < GLA_N) {
      u16* base = ea.o0 + (size_t)mb * GLA_N + nb;
      const int voff = 4 * h * GLA_N + r;
#pragma unroll
      for (int i = 0; i < 16; ++i) {
        const int rc = (i & 3) + 8 * (i >> 2);
        base[rc * GLA_N + voff] = f2bf(acc[i]);
      }
    }
  } else if constexpr (EPI == EPI_MLADN) {
    u16* base = ea.o0 + (size_t)mb * MLA_DNP + nb;
    const int voff = 4 * h * MLA_DNP + r;
#pragma unroll
    for (int i = 0; i < 16; ++i) {
      const int rc = (i & 3) + 8 * (i >> 2);
      base[rc * MLA_DNP + voff] = f2bf(acc[i]);
    }
  } else if constexpr (EPI == EPI_MLAQ) {
    const int n = nb + r;
    const int hd = n / 192, c = n % 192;
    const float qs = 0.07216878364870322f * 1.4426950408889634f;
    const bool isr = c >= 128;
    const int cc = c - 128;
    const int jj = cc & 15;
    const bool first = (cc & 31) < 16;
    const float invf = __expf(-(float)jj * (9.210340371976184f / 16.f));
#pragma unroll
    for (int i = 0; i < 16; ++i) {
      const int m = mb + crow(i, h);
      const int b = m >> 13, l = m & 8191;
      float v = acc[i];
      const float pv = shx(v, 16, lane);
      if (isr) {
        const float pos = (float)((cc < 32) ? (l >> 6) : (l & 63));
        const float ang = pos * invf;
        float sn, cs;
        __sincosf(ang, &sn, &cs);
        v = first ? (v * cs - pv * sn) : (pv * sn + v * cs);
      }
      ea.o0[((size_t)(b * 8 + hd) * SEQ + l) * 192 + c] = f2bf(v * qs);
    }
  } else if constexpr (EPI == EPI_MLAKV) {
    const int n = nb + r;
    const int hd = n >> 8, c = n & 255;
#pragma unroll
    for (int g = 0; g < 4; ++g) {
      const int m = mb + 8 * g + 4 * h;
      int b, key;
      if (m < NL) { b = m >> 13; key = NCTX + (m & 8191); } else { b = (m - NL) >> 8; key = (m - NL) & 255; }
      if (c < 128) {
#pragma unroll
        for (int q = 0; q < 4; ++q) ea.o0[((size_t)(b * 8 + hd) * NKEY + key + q) * 128 + c] = f2bf(acc[4 * g + q]);
      } else {
        u16x4 o;
#pragma unroll
        for (int q = 0; q < 4; ++q) o[q] = f2bf(acc[4 * g + q]);
        *(u16x4*)(ea.o1 + ((size_t)(b * 8 + hd) * 128 + (c - 128)) * NKEY + key) = o;
      }
    }
  }
}

template <int EPI>
DI void gemm_phase(const u16* __restrict__ A, int lda, const u16* __restrict__ WT, int K, int mtiles, int ntiles,
                   const EpiArgs& ea, unsigned char* smem, int bid, int nblk) {
  constexpr bool SWAP = (EPI == EPI_HYIN || EPI == EPI_FILT);
  u16* As = (u16*)smem;
  u16* Bs = As + 2 * 256 * GS;
  const int tid = ltid(), lane = tid & 63, wv = __builtin_amdgcn_readfirstlane(tid >> 6);
  const int wm = wv & 1, wn = wv >> 1;
  const int r = lane & 31, h = lane >> 5;
  const int nk = K / 64;
  const int lrow = tid >> 3, lcol = (tid & 7) * 8;
  for (int tile = bid; tile < mtiles * ntiles; tile += nblk) {
    const int mt = tile / ntiles, nt = tile % ntiles;
    const int m0 = mt * 256, n0 = nt * 256;
    const u16* Ag = A + (size_t)(m0 + lrow) * lda + lcol;
    const u16* Bg = WT + (size_t)(n0 + lrow) * K + lcol;
    f32x16 c00, c01, c10, c11, c20, c21, c30, c31;
#pragma unroll
    for (int q = 0; q < 16; ++q) { c00[q] = 0.f; c01[q] = 0.f; c10[q] = 0.f; c11[q] = 0.f; c20[q] = 0.f; c21[q] = 0.f; c30[q] = 0.f; c31[q] = 0.f; }
    uint4 r0, r1, r2, r3;
#define G_LDA(k0_)                                             \
    r0 = *(const uint4*)(Ag + (k0_));                              \
    r1 = *(const uint4*)(Ag + (size_t)64 * lda + (k0_));           \
    r2 = *(const uint4*)(Ag + (size_t)128 * lda + (k0_));          \
    r3 = *(const uint4*)(Ag + (size_t)192 * lda + (k0_));
#define G_LDB(k0_)                                             \
    r0 = *(const uint4*)(Bg + (k0_));                              \
    r1 = *(const uint4*)(Bg + (size_t)64 * K + (k0_));             \
    r2 = *(const uint4*)(Bg + (size_t)128 * K + (k0_));            \
    r3 = *(const uint4*)(Bg + (size_t)192 * K + (k0_));
#define G_STX(base_, buf_)                                                  \
    *(uint4*)(base_ + (buf_) * 256 * GS + (lrow) * GS + lcol) = r0;             \
    *(uint4*)(base_ + (buf_) * 256 * GS + (lrow + 64) * GS + lcol) = r1;        \
    *(uint4*)(base_ + (buf_) * 256 * GS + (lrow + 128) * GS + lcol) = r2;       \
    *(uint4*)(base_ + (buf_) * 256 * GS + (lrow + 192) * GS + lcol) = r3;
    __syncthreads();
    G_LDB(0)
    G_STX(Bs, 0)
    G_LDA(0)
    G_STX(As, 0)
    if (nk > 1) { G_LDB(64) }
    __syncthreads();
#pragma unroll 1
    for (int kt = 0; kt < nk; ++kt) {
      const int cur = kt & 1;
      if (kt + 1 < nk) { G_STX(Bs, cur ^ 1) G_LDA((kt + 1) * 64) }
      const u16* as = As + cur * 256 * GS + (wm * 128 + r) * GS + h * 8;
      const u16* bs = Bs + cur * 256 * GS + (wn * 64 + r) * GS + h * 8;
#pragma unroll
      for (int kk = 0; kk < 4; ++kk) {
        const bf16x8 a0 = *(const bf16x8*)(as + kk * 16);
        const bf16x8 a1 = *(const bf16x8*)(as + 32 * GS + kk * 16);
        const bf16x8 a2 = *(const bf16x8*)(as + 64 * GS + kk * 16);
        const bf16x8 a3 = *(const bf16x8*)(as + 96 * GS + kk * 16);
        const bf16x8 b0 = *(const bf16x8*)(bs + kk * 16);
        const bf16x8 b1 = *(const bf16x8*)(bs + 32 * GS + kk * 16);
        if constexpr (SWAP) {
          c00 = MFMA32(b0, a0, c00); c01 = MFMA32(b1, a0, c01); c10 = MFMA32(b0, a1, c10); c11 = MFMA32(b1, a1, c11);
          c20 = MFMA32(b0, a2, c20); c21 = MFMA32(b1, a2, c21); c30 = MFMA32(b0, a3, c30); c31 = MFMA32(b1, a3, c31);
        } else {
          c00 = MFMA32(a0, b0, c00); c01 = MFMA32(a0, b1, c01); c10 = MFMA32(a1, b0, c10); c11 = MFMA32(a1, b1, c11);
          c20 = MFMA32(a2, b0, c20); c21 = MFMA32(a2, b1, c21); c30 = MFMA32(a3, b0, c30); c31 = MFMA32(a3, b1, c31);
        }
        if (kk == 1 && kt + 1 < nk) {
          G_STX(As, cur ^ 1)
          if (kt + 2 < nk) { G_LDB((kt + 2) * 64) }
        }
      }
      __syncthreads();
    }
    const int mb = m0 + wm * 128, nb = n0 + wn * 64;
#define SB __builtin_amdgcn_sched_barrier(0);
    SB epi_tile<EPI>(ea, c00, mb, nb, lane);       SB epi_tile<EPI>(ea, c01, mb, nb + 32, lane);
    SB epi_tile<EPI>(ea, c10, mb + 32, nb, lane);  SB epi_tile<EPI>(ea, c11, mb + 32, nb + 32, lane);
    SB epi_tile<EPI>(ea, c20, mb + 64, nb, lane);  SB epi_tile<EPI>(ea, c21, mb + 64, nb + 32, lane);
    SB epi_tile<EPI>(ea, c30, mb + 96, nb, lane);  SB epi_tile<EPI>(ea, c31, mb + 96, nb + 32, lane); SB
  }
}

DI float2 cmul(float2 a, float2 b) { return make_float2(a.x * b.x - a.y * b.y, a.x * b.y + a.y * b.x); }
DI float2 cmulc(float2 a, float2 b) { return make_float2(a.x * b.x + a.y * b.y, a.y * b.x - a.x * b.y); }
DI float2 twid(float rev) { return make_float2(__builtin_amdgcn_cosf(rev), __builtin_amdgcn_sinf(rev)); }
typedef float f2r_t __attribute__((ext_vector_type(2)));
DI float2 cmulp(float2 y, float2 w) {
  f2r_t yy, ww, t, r; yy.x = y.x; yy.y = y.y; ww.x = w.x; ww.y = w.y;
  asm volatile("s_nop 0\n\tv_pk_mul_f32 %0, %2, %3 op_sel_hi:[1,0]\n\tv_pk_fma_f32 %1, %2, %3, %0 op_sel:[1,1,0] op_sel_hi:[0,1,1] neg_lo:[1,0,0]"
               : "=&v"(t), "=&v"(r) : "v"(yy), "v"(ww));
  return make_float2(r.x, r.y);
}
DI float2 cmulcp(float2 y, float2 w) {
  f2r_t yy, ww, t, r; yy.x = y.x; yy.y = y.y; ww.x = w.x; ww.y = w.y;
  asm volatile("s_nop 0\n\tv_pk_mul_f32 %0, %2, %3 op_sel_hi:[1,0]\n\tv_pk_fma_f32 %1, %2, %3, %0 op_sel:[1,1,0] op_sel_hi:[0,1,1] neg_hi:[1,0,0]"
               : "=&v"(t), "=&v"(r) : "v"(yy), "v"(ww));
  return make_float2(r.x, r.y);
}

#define FWD_BFLY(a0, a1, a2, a3, y0, y1, y2, y3)                                  \
  {                                                                               \
    const float2 t0 = make_float2(a0.x + a2.x, a0.y + a2.y);                      \
    const float2 t1 = make_float2(a0.x - a2.x, a0.y - a2.y);                      \
    const float2 t2 = make_float2(a1.x + a3.x, a1.y + a3.y);                      \
    const float2 t3 = make_float2(a1.y - a3.y, -(a1.x - a3.x));                   \
    y0 = make_float2(t0.x + t2.x, t0.y + t2.y);                                   \
    y1 = make_float2(t1.x + t3.x, t1.y + t3.y);                                   \
    y2 = make_float2(t0.x - t2.x, t0.y - t2.y);                                   \
    y3 = make_float2(t1.x - t3.x, t1.y - t3.y);                                   \
  }
#define INV_BFLY(b0, b1, b2, b3, y0, y1, y2, y3)                                  \
  {                                                                               \
    const float2 t0 = make_float2(b0.x + b2.x, b0.y + b2.y);                      \
    const float2 t1 = make_float2(b0.x - b2.x, b0.y - b2.y);                      \
    const float2 t2 = make_float2(b1.x + b3.x, b1.y + b3.y);                      \
    const float2 t3 = make_float2(-(b1.y - b3.y), b1.x - b3.x);                   \
    y0 = make_float2(t0.x + t2.x, t0.y + t2.y);                                   \
    y1 = make_float2(t1.x + t3.x, t1.y + t3.y);                                   \
    y2 = make_float2(t0.x - t2.x, t0.y - t2.y);                                   \
    y3 = make_float2(t1.x - t3.x, t1.y - t3.y);                                   \
  }

DI int PH(int i) { return i + ((i >> 6) << 2); }
constexpr int FFT_LDS_ELEMS = 16384 + 1024;
template <int QA>
DI void r16_fwd(float2 (&x)[16], int rp) {
  constexpr int QB = QA / 4;
#pragma unroll
  for (int m2 = 0; m2 < 4; ++m2) {
    float2 y0, y1, y2, y3;
    FWD_BFLY(x[0 + m2], x[4 + m2], x[8 + m2], x[12 + m2], y0, y1, y2, y3);
    const float2 w1 = twid(-(float)(m2 * QB + rp) * (1.f / (4.f * QA)));
    const float2 w2 = cmulp(w1, w1), w3 = cmulp(w2, w1);
    x[0 + m2] = y0; x[4 + m2] = cmulp(y1, w1); x[8 + m2] = cmulp(y2, w2); x[12 + m2] = cmulp(y3, w3);
  }
  const float2 v1 = twid(-(float)rp * (1.f / (4.f * QB)));
  const float2 v2 = cmulp(v1, v1), v3 = cmulp(v2, v1);
#pragma unroll
  for (int k1 = 0; k1 < 4; ++k1) {
    float2 y0, y1, y2, y3;
    FWD_BFLY(x[4 * k1 + 0], x[4 * k1 + 1], x[4 * k1 + 2], x[4 * k1 + 3], y0, y1, y2, y3);
    x[4 * k1 + 0] = y0; x[4 * k1 + 1] = cmulp(y1, v1); x[4 * k1 + 2] = cmulp(y2, v2); x[4 * k1 + 3] = cmulp(y3, v3);
  }
}
template <int QA>
DI void r16_inv(float2 (&x)[16], int rp) {
  constexpr int QB = QA / 4;
  const float2 v1 = twid(-(float)rp * (1.f / (4.f * QB)));
  const float2 v2 = cmulp(v1, v1), v3 = cmulp(v2, v1);
#pragma unroll
  for (int k1 = 0; k1 < 4; ++k1) {
    const float2 b0 = x[4 * k1 + 0], b1 = cmulcp(x[4 * k1 + 1], v1), b2 = cmulcp(x[4 * k1 + 2], v2), b3 = cmulcp(x[4 * k1 + 3], v3);
    float2 y0, y1, y2, y3;
    INV_BFLY(b0, b1, b2, b3, y0, y1, y2, y3);
    x[4 * k1 + 0] = y0; x[4 * k1 + 1] = y1; x[4 * k1 + 2] = y2; x[4 * k1 + 3] = y3;
  }
#pragma unroll
  for (int m2 = 0; m2 < 4; ++m2) {
    const float2 w1 = twid(-(float)(m2 * QB + rp) * (1.f / (4.f * QA)));
    const float2 w2 = cmulp(w1, w1), w3 = cmulp(w2, w1);
    const float2 b0 = x[0 + m2], b1 = cmulcp(x[4 + m2], w1), b2 = cmulcp(x[8 + m2], w2), b3 = cmulcp(x[12 + m2], w3);
    float2 y0, y1, y2, y3;
    INV_BFLY(b0, b1, b2, b3, y0, y1, y2, y3);
    x[0 + m2] = y0; x[4 + m2] = y1; x[8 + m2] = y2; x[12 + m2] = y3;
  }
}
template <int QA, bool INV>
DI void r16_pass(float2* buf, int tid) {
  constexpr int QB = QA / 4;
  asm volatile("" : "+v"(tid));
#pragma unroll
  for (int it = 0; it < 2; ++it) {
    const int U = tid + it * NT, rp = U & (QB - 1), ib = (U / QB) * (4 * QA) + rp;
    float2 x[16];
#pragma unroll
    for (int e = 0; e < 16; ++e) x[e] = buf[PH(ib + (e >> 2) * QA + (e & 3) * QB)];
    if (INV) r16_inv<QA>(x, rp); else r16_fwd<QA>(x, rp);
#pragma unroll
    for (int e = 0; e < 16; ++e) buf[PH(ib + (e >> 2) * QA + (e & 3) * QB)] = x[e];
  }
  __syncthreads();
}
DI float sconv(const u16* z, int t, int L, float w0, float w1, float w2, float cb) {
  const float c = bf2f(z[t]);
  const float a = bf2f(z[t > 0 ? t - 1 : 0]);
  const float b = bf2f(z[t < L - 1 ? t + 1 : L - 1]);
  return (t > 0 ? w0 : 0.f) * a + w1 * c + (t < L - 1 ? w2 : 0.f) * b + cb;
}
DI float block_sum(float v, float* red, int tid) {
  v = wave_sum(v, tid & 63);
  __syncthreads();
  if ((tid & 63) == 0) red[tid >> 6] = v;
  __syncthreads();
  float s = 0.f;
#pragma unroll
  for (int i = 0; i < 8; ++i) s += red[i];
  return s;
}

DI void fft_middle(float2* buf, const float2* Kg, int tid) {
#pragma unroll 4
  for (int j = tid; j < 4096; j += NT) {
    float4* p4 = (float4*)(buf + PH(4 * j));
    const float4* k4 = (const float4*)(Kg + 4 * j);
    const float4 u0 = p4[0], u1 = p4[1];
    const float4 k0 = k4[0], k1 = k4[1];
    const float2 a0 = make_float2(u0.x, u0.y), a1 = make_float2(u0.z, u0.w), a2 = make_float2(u1.x, u1.y), a3 = make_float2(u1.z, u1.w);
    float2 y0, y1, y2, y3;
    FWD_BFLY(a0, a1, a2, a3, y0, y1, y2, y3);
    const float2 b0 = cmulp(y0, make_float2(k0.x, k0.y)), b1 = cmulp(y1, make_float2(k0.z, k0.w));
    const float2 b2 = cmulp(y2, make_float2(k1.x, k1.y)), b3 = cmulp(y3, make_float2(k1.z, k1.w));
    float2 z0, z1, z2, z3;
    INV_BFLY(b0, b1, b2, b3, z0, z1, z2, z3);
    p4[0] = make_float4(z0.x, z0.y, z1.x, z1.y);
    p4[1] = make_float4(z2.x, z2.y, z3.x, z3.y);
  }
  __syncthreads();
}
DI void fft_filter_last(const float2* buf, float2* Kg, int tid, float scl, float skp) {
#pragma unroll 4
  for (int j = tid; j < 4096; j += NT) {
    const float4* p4 = (const float4*)(buf + PH(4 * j));
    float4* k4 = (float4*)(Kg + 4 * j);
    const float4 u0 = p4[0], u1 = p4[1];
    const float2 a0 = make_float2(u0.x, u0.y), a1 = make_float2(u0.z, u0.w), a2 = make_float2(u1.x, u1.y), a3 = make_float2(u1.z, u1.w);
    float2 y0, y1, y2, y3;
    FWD_BFLY(a0, a1, a2, a3, y0, y1, y2, y3);
    k4[0] = make_float4(y0.x * scl + skp, y0.y * scl, y1.x * scl + skp, y1.y * scl);
    k4[1] = make_float4(y2.x * scl + skp, y2.y * scl, y3.x * scl + skp, y3.y * scl);
  }
}

DI void hyena_lat_unit(const Params& P, int jl, int d, unsigned char* smem) {
  float2* buf = (float2*)smem;
  float* red = (float*)(smem + (size_t)FFT_LDS_ELEMS * 8);
  const int tid = ltid();
  const u16* zT = (const u16*)(lws(P) + OFF_BIG + B_ZT);
  const u16* kT = (const u16*)(lws(P) + OFF_BIG + B_KT);
  u16* yT = (u16*)(lws(P) + OFF_BIG + B_YT);
  float2* Kg = (float2*)(lws(P) + OFF_A) + (size_t)blockIdx.x * 32768;
#pragma unroll 1
  for (int n = 0; n < 2; ++n) {
    const u16* kf = kT + (size_t)((n * 2 + 0) * 1024 + d) * KTL;
    const u16* kb = kT + (size_t)((n * 2 + 1) * 1024 + d) * KTL;
    float s = 0.f;
#pragma unroll 4
    for (int t = tid; t < SEQ; t += NT) {
      const float f = bf2f(kf[t]);
      const float g = t >= 1 ? bf2f(kb[t]) : 0.f;
      buf[PH(t)] = make_float2(f, 0.f);
      buf[PH(t >= 1 ? 16384 - t : SEQ)] = make_float2(g, 0.f);
      s += fabsf(f) + fabsf(g);
    }
    const float S = block_sum(s, red, tid);
    r16_pass<4096, false>(buf, tid); r16_pass<256, false>(buf, tid); r16_pass<16, false>(buf, tid);
    const float scl = 1.f / (S * 16384.f);
    const float skp = P.hy_bias[(jl * 2 + n) * 1024 + d] * (1.f / 16384.f);
    fft_filter_last(buf, Kg + n * 16384, tid, scl, skp);
    __syncthreads();
  }
  const float* cw = P.hy_conv_w + (size_t)jl * 3 * 3072;
  const float* cbp = P.hy_conv_b + (size_t)jl * 3072;
  const float w00 = cw[d], w01 = cw[3072 + d], w02 = cw[2 * 3072 + d], cb0 = cbp[d];
  const float w10 = cw[1024 + d], w11 = cw[3072 + 1024 + d], w12 = cw[2 * 3072 + 1024 + d], cb1 = cbp[1024 + d];
  const float w20 = cw[2048 + d], w21 = cw[3072 + 2048 + d], w22 = cw[2 * 3072 + 2048 + d], cb2 = cbp[2048 + d];
  for (int pair = 0; pair < 2; ++pair) {
    const u16* za0 = zT + (size_t)d * NTOK + (size_t)(2 * pair) * SEQ;
    const u16* za1 = za0 + SEQ;
    const u16* zb0 = zT + (size_t)(1024 + d) * NTOK + (size_t)(2 * pair) * SEQ;
    const u16* zb1 = zb0 + SEQ;
    const u16* zc0 = zT + (size_t)(2048 + d) * NTOK + (size_t)(2 * pair) * SEQ;
    const u16* zc1 = zc0 + SEQ;
#pragma unroll 1
    for (int it = 0; it < 2; ++it) {
      const int rp = tid + it * NT;
      float2 x[16];
#pragma unroll
      for (int e = 0; e < 8; ++e) {
        const int t = (e >> 2) * 4096 + (e & 3) * 1024 + rp;
        x[e] = make_float2(sconv(za0, t, SEQ, w00, w01, w02, cb0), sconv(za1, t, SEQ, w00, w01, w02, cb0));
        if ((e & 3) == 3) __builtin_amdgcn_sched_barrier(0);
      }
#pragma unroll
      for (int e = 8; e < 16; ++e) x[e] = make_float2(0.f, 0.f);
      r16_fwd<4096>(x, rp);
#pragma unroll
      for (int e = 0; e < 16; ++e) buf[PH(rp + (e >> 2) * 4096 + (e & 3) * 1024)] = x[e];
    }
    __syncthreads();
    r16_pass<256, false>(buf, tid); r16_pass<16, false>(buf, tid);
    fft_middle(buf, Kg, tid);
    r16_pass<16, true>(buf, tid); r16_pass<256, true>(buf, tid);
#pragma unroll 1
    for (int it = 0; it < 2; ++it) {
      const int rp = tid + it * NT;
      float2 x[16];
#pragma unroll
      for (int e = 0; e < 16; ++e) x[e] = buf[PH(rp + (e >> 2) * 4096 + (e & 3) * 1024)];
      r16_inv<4096>(x, rp);
#pragma unroll
      for (int e = 0; e < 8; ++e) {
        const int t = (e >> 2) * 4096 + (e & 3) * 1024 + rp;
        const float g0 = sconv(zb0, t, SEQ, w10, w11, w12, cb1), g1 = sconv(zb1, t, SEQ, w10, w11, w12, cb1);
        buf[PH(t)] = make_float2(x[e].x * g0, x[e].y * g1);
        if ((e & 3) == 3) __builtin_amdgcn_sched_barrier(0);
      }
      const float z = lzero();
#pragma unroll
      for (int e = 8; e < 16; ++e) buf[PH(rp + (e >> 2) * 4096 + (e & 3) * 1024)] = make_float2(z, z);
    }
    __syncthreads();
    r16_pass<4096, false>(buf, tid); r16_pass<256, false>(buf, tid); r16_pass<16, false>(buf, tid);
    fft_middle(buf, Kg + 16384, tid);
    r16_pass<16, true>(buf, tid); r16_pass<256, true>(buf, tid);
#pragma unroll 1
    for (int it = 0; it < 2; ++it) {
      const int rp = tid + it * NT;
      float2 x[16];
#pragma unroll
      for (int e = 0; e < 16; ++e) x[e] = buf[PH(rp + (e >> 2) * 4096 + (e & 3) * 1024)];
      r16_inv<4096>(x, rp);
      u16* yo = yT + (size_t)d * NTOK + (size_t)(2 * pair) * SEQ;
#pragma unroll
      for (int e = 0; e < 8; ++e) {
        const int t = (e >> 2) * 4096 + (e & 3) * 1024 + rp;
        const float g0 = sconv(zc0, t, SEQ, w20, w21, w22, cb2), g1 = sconv(zc1, t, SEQ, w20, w21, w22, cb2);
        yo[t] = f2bf(x[e].x * g0); yo[SEQ + t] = f2bf(x[e].y * g1);
        if ((e & 3) == 3) __builtin_amdgcn_sched_barrier(0);
      }
    }
    __syncthreads();
  }
}

DI void hyena_ctx_unit(const Params& P, int jl, int d, unsigned char* smem) {
  float* kk = (float*)smem;
  float* ya = kk + 1024;
  float* yb = ya + 1024;
  float* red = yb + 1024;
  const int tid = ltid();
  const u16* zT = (const u16*)(lws(P) + OFF_BIG + B_ZT);
  const u16* kT = (const u16*)(lws(P) + OFF_BIG + B_KT);
  u16* yT = (u16*)(lws(P) + OFF_BIG + B_YT);
  const float* cw = P.hy_conv_w + (size_t)jl * 3 * 3072;
  const float* cbp = P.hy_conv_b + (size_t)jl * 3072;
#pragma unroll
  for (int n = 0; n < 2; ++n) {
    const u16* kf = kT + (size_t)((n * 2 + 0) * 1024 + d) * KTL + SEQ;
    const u16* kb = kT + (size_t)((n * 2 + 1) * 1024 + d) * KTL + SEQ;
    float s = 0.f, f = 0.f, g = 0.f;
    if (tid < 256) { f = bf2f(kf[tid]); s = fabsf(f); }
    else if (tid > 256) { g = bf2f(kb[tid - 256]); s = fabsf(g); }
    const float S = block_sum(s, red, tid);
    if (tid < 256) kk[n * 512 + 256 + tid] = f / S;
    else if (tid > 256) kk[n * 512 + 256 - (tid - 256)] = g / S;
    else kk[n * 512 + 0] = 0.f;
  }
  for (int e = tid; e < 1024; e += NT) {
    const int b = e >> 8, t = e & 255;
    const u16* z0 = zT + (size_t)d * NTOK + NL + b * 256;
    ya[e] = sconv(z0, t, NCTX, cw[d], cw[3072 + d], cw[2 * 3072 + d], cbp[d]);
  }
  __syncthreads();
#pragma unroll
  for (int n = 0; n < 2; ++n) {
    const float* src = n == 0 ? ya : yb;
    float* dst = n == 0 ? yb : ya;
    const int ch = (n + 1) * 1024 + d;
    const float skp = P.hy_bias[(jl * 2 + n) * 1024 + d];
    {
      const int t = tid & 255, bh = tid >> 8;
      const float* kp = kk + n * 512 + 256 + t;
      const float* s0 = src + (2 * bh) * 256;
      const float* s1 = s0 + 256;
      float acc0 = 0.f, acc1 = 0.f;
#pragma unroll 4
      for (int s = 0; s < 256; s += 4) {
        const float4 x0 = *(const float4*)(s0 + s), x1 = *(const float4*)(s1 + s);
        const float k0 = kp[-s], k1 = kp[-s - 1], k2 = kp[-s - 2], k3 = kp[-s - 3];
        acc0 += k0 * x0.x + k1 * x0.y + k2 * x0.z + k3 * x0.w;
        acc1 += k0 * x1.x + k1 * x1.y + k2 * x1.z + k3 * x1.w;
      }
#pragma unroll
      for (int q = 0; q < 2; ++q) {
        const int b = 2 * bh + q, e = b * 256 + t;
        const float acc = (q == 0 ? acc0 : acc1) + skp * src[e];
        const u16* zg = zT + (size_t)ch * NTOK + NL + b * 256;
        const float gate = sconv(zg, t, NCTX, cw[ch], cw[3072 + ch], cw[2 * 3072 + ch], cbp[ch]);
        const float o = acc * gate;
        if (n == 0) dst[e] = o;
        else yT[(size_t)d * NTOK + NL + e] = f2bf(o);
      }
    }
    __syncthreads();
  }
}

DI void hyena_conv_phase(const Params& P, int jl, bool with_ctx, unsigned char* smem, int bid, int nblk) {
  for (int u = bid; u < 1024; u += nblk) hyena_lat_unit(P, jl, u, smem);
  if (with_ctx) {
    __syncthreads();
    for (int u = bid; u < 1024; u += nblk) hyena_ctx_unit(P, jl, u, smem);
  }
}

DI void transpose_phase(const Params& P, int ncols, unsigned char* smem, int bid, int nblk) {
  u16* t = (u16*)smem;
  const u16* yT = (const u16*)(lws(P) + OFF_BIG + B_YT);
  u16* A = (u16*)(lws(P) + OFF_A);
  const int tid = ltid();
  const int tcols = ncols / 64;
  for (int tile = bid; tile < 16 * tcols; tile += nblk) {
    const int d0 = (tile / tcols) * 64, m0 = (tile % tcols) * 64;
    {
      const int rr = tid >> 3, ch = tid & 7;
      *(uint4*)(t + rr * 72 + ch * 8) = *(const uint4*)(yT + (size_t)(d0 + rr) * NTOK + m0 + ch * 8);
    }
    __syncthreads();
    {
      const int m = tid >> 3, dc = (tid & 7) * 8;
      u16x8 o;
#pragma unroll
      for (int j = 0; j < 8; ++j) o[j] = t[(dc + j) * 72 + m];
      *(u16x8*)(A + (size_t)(m0 + m) * 1024 + d0 + dc) = o;
    }
    __syncthreads();
  }
}

DI float logsigmoid(float x) { return fminf(x, 0.f) - __logf(1.f + __expf(-fabsf(x))); }

DI void gla_prep_phase(const Params& P, unsigned char* smem, int bid, int nblk) {
  u16* qraw = (u16*)smem;
  u16* kraw = qraw + 64 * 136;
  u16* vt = kraw + 64 * 136;
  u16* qt = vt + 256 * 72;
  u16* kt = qt + 64 * 136;
  u16* ps = kt + 64 * 136;
  float* rs = (float*)(ps + 64 * 72);
  float* segt = rs + 2 * 64 * 16;
  const int tid = ltid(), lane = tid & 63, wv = tid >> 6;
  const int r = lane & 31, h = lane >> 5;
  u16* Z = (u16*)(lws(P) + OFF_BIG + B_GZ);
  u16* G2 = (u16*)(lws(P) + OFF_BIG + B_G2);
  float* DEC = (float*)(lws(P) + OFF_BIG + B_DEC);
  for (int u = bid; u < 528 * 4; u += nblk) {
    const int c = u >> 2, hd = u & 3;
    const int row0 = c < 512 ? c * 64 : NL + (c - 512) * 64;
    u16* Zr = Z + (size_t)row0 * GLA_N;
    __syncthreads();
    {
      const int rr0 = tid >> 4, cc0 = (tid & 15) * 8;
      *(uint4*)(qraw + rr0 * 136 + cc0) = *(const uint4*)(Zr + (size_t)rr0 * GLA_N + hd * 128 + cc0);
      *(uint4*)(qraw + (rr0 + 32) * 136 + cc0) = *(const uint4*)(Zr + (size_t)(rr0 + 32) * GLA_N + hd * 128 + cc0);
      *(uint4*)(kraw + rr0 * 136 + cc0) = *(const uint4*)(Zr + (size_t)rr0 * GLA_N + 512 + hd * 128 + cc0);
      *(uint4*)(kraw + (rr0 + 32) * 136 + cc0) = *(const uint4*)(Zr + (size_t)(rr0 + 32) * GLA_N + 512 + hd * 128 + cc0);
    }
#pragma unroll
    for (int i = 0; i < 4; ++i) {
      const int cidx = tid + i * NT, rr = cidx >> 5, cc = (cidx & 31) * 8;
      const u16x8 v = *(const u16x8*)(Zr + (size_t)rr * GLA_N + 1024 + hd * 256 + cc);
#pragma unroll
      for (int j = 0; j < 8; ++j) vt[(cc + j) * 72 + rr] = v[j];
    }
    if (tid < 256) {
      const int rr = tid >> 2, cc = (tid & 3) * 8;
      const u16x8 v = *(const u16x8*)(Zr + (size_t)rr * GLA_N + 3072 + cc);
#pragma unroll
      for (int j = 0; j < 8; ++j) rs[((cc + j) >> 4) * 1024 + rr * 16 + ((cc + j) & 15)] = bf2f(v[j]);
    }
    __syncthreads();
#pragma unroll 1
    for (int dir = 0; dir < 2; ++dir) {
      const int dk = tid & 127, seg = tid >> 7;
      float vv[16];
      {
        const float* w2p = P.gla_gk_w2 + (size_t)(dir * 16) * 512 + hd * 128 + dk;
        float wq[16];
#pragma unroll
        for (int q = 0; q < 16; ++q) wq[q] = w2p[q * 512];
        const float gb = P.gla_gk_b[dir * 512 + hd * 128 + dk];
#pragma unroll
        for (int m = 0; m < 16; ++m) {
          const float4* rp = (const float4*)(rs + dir * 1024 + (seg * 16 + m) * 16);
          const float4 r0 = rp[0], r1 = rp[1], r2 = rp[2], r3 = rp[3];
          float a = gb;
          a += r0.x * wq[0] + r0.y * wq[1] + r0.z * wq[2] + r0.w * wq[3];
          a += r1.x * wq[4] + r1.y * wq[5] + r1.z * wq[6] + r1.w * wq[7];
          a += r2.x * wq[8] + r2.y * wq[9] + r2.z * wq[10] + r2.w * wq[11];
          a += r3.x * wq[12] + r3.y * wq[13] + r3.z * wq[14] + r3.w * wq[15];
          vv[m] = logsigmoid(a) * (1.f / 16.f);
        }
      }
      if (dir == 0) {
#pragma unroll
        for (int i = 1; i < 16; ++i) vv[i] += vv[i - 1];
        segt[seg * 128 + dk] = vv[15];
      } else {
#pragma unroll
        for (int i = 14; i >= 0; --i) vv[i] += vv[i + 1];
        segt[seg * 128 + dk] = vv[0];
      }
      __syncthreads();
      const float t0 = segt[dk], t1 = segt[128 + dk], t2 = segt[256 + dk], t3 = segt[384 + dk];
      float off;
      if (dir == 0) off = (seg > 0 ? t0 : 0.f) + (seg > 1 ? t1 : 0.f) + (seg > 2 ? t2 : 0.f);
      else off = (seg < 3 ? t3 : 0.f) + (seg < 2 ? t2 : 0.f) + (seg < 1 ? t1 : 0.f);
      const float tot = (t0 + t1) + (t2 + t3);
      if (seg == 0) DEC[((size_t)(c * 4 + hd) * 2 + dir) * 128 + dk] = __expf(tot);
      unsigned kw[8];
#pragma unroll
      for (int m = 0; m < 16; m += 2) {
        const int i0 = seg * 16 + m;
        const float b0 = vv[m] + off, b1 = vv[m + 1] + off;
        const float q0 = bf2f(qraw[i0 * 136 + dk]), q1 = bf2f(qraw[(i0 + 1) * 136 + dk]);
        const float k0 = bf2f(kraw[i0 * 136 + dk]), k1 = bf2f(kraw[(i0 + 1) * 136 + dk]);
        const unsigned qp = pk2(q0 * __expf(b0) * 0.08838834764831845f, q1 * __expf(b1) * 0.08838834764831845f);
        const unsigned kp = pk2(k0 * __expf(-b0), k1 * __expf(-b1));
        qt[i0 * 136 + dk] = (u16)(qp & 0xffffu); qt[(i0 + 1) * 136 + dk] = (u16)(qp >> 16);
        kt[i0 * 136 + dk] = (u16)(kp & 0xffffu); kt[(i0 + 1) * 136 + dk] = (u16)(kp >> 16);
        kw[m >> 1] = pk2(k0 * __expf(tot - b0), k1 * __expf(tot - b1));
      }
      {
        u16* slot = (dir == 0 ? Zr + 512 + hd * 128 : G2 + (size_t)row0 * 1024 + 512 + hd * 128);
        const size_t rstride = dir == 0 ? GLA_N : 1024;
        uint4* dp = (uint4*)(slot + (size_t)(dk >> 1) * rstride + (dk & 1) * 64 + seg * 16);
        dp[0] = make_uint4(kw[0], kw[1], kw[2], kw[3]); dp[1] = make_uint4(kw[4], kw[5], kw[6], kw[7]);
      }
      __syncthreads();
      if (wv < 4) {
        const int ti = wv & 1, tj = wv >> 1;
        f32x16 at;
#pragma unroll
        for (int i = 0; i < 16; ++i) at[i] = 0.f;
#pragma unroll
        for (int kk = 0; kk < 8; ++kk) {
          const bf16x8 a = *(const bf16x8*)(qt + (ti * 32 + r) * 136 + kk * 16 + h * 8);
          const bf16x8 bv = *(const bf16x8*)(kt + (tj * 32 + r) * 136 + kk * 16 + h * 8);
          at = MFMA32(a, bv, at);
        }
#pragma unroll
        for (int i = 0; i < 16; ++i) {
          const int ii = ti * 32 + crow(i, h), sj = tj * 32 + r;
          const bool keep = dir == 0 ? (sj <= ii) : (sj >= ii);
          ps[ii * 72 + sj] = f2bf(keep ? at[i] : 0.f);
        }
      } else {
        u16* slot = (dir == 0 ? Zr + hd * 128 : G2 + (size_t)row0 * 1024 + hd * 128);
        const size_t rstride = dir == 0 ? GLA_N : 1024;
        const int t4 = tid - 256;
#pragma unroll
        for (int i = 0; i < 4; ++i) {
          const int cidx = t4 + i * 256, rr = cidx >> 4, cc = (cidx & 15) * 8;
          *(uint4*)(slot + (size_t)rr * rstride + cc) = *(const uint4*)(qt + rr * 136 + cc);
        }
      }
      __syncthreads();
      {
        u16* O = dir == 0 ? (u16*)(lws(P) + OFF_A) : (u16*)(lws(P) + OFF_BIG + B_GOB);
        f32x16 o0, o1;
#pragma unroll
        for (int i = 0; i < 16; ++i) { o0[i] = 0.f; o1[i] = 0.f; }
#pragma unroll
        for (int ss = 0; ss < 4; ++ss) {
          const bf16x8 bv = *(const bf16x8*)(vt + (wv * 32 + r) * 72 + ss * 16 + h * 8);
          const bf16x8 a0 = *(const bf16x8*)(ps + r * 72 + ss * 16 + h * 8);
          const bf16x8 a1 = *(const bf16x8*)(ps + (32 + r) * 72 + ss * 16 + h * 8);
          o0 = MFMA32(a0, bv, o0); o1 = MFMA32(a1, bv, o1);
        }
        u16* ob = O + (size_t)row0 * 1024 + hd * 256 + wv * 32 + r;
#pragma unroll
        for (int i = 0; i < 16; ++i) {
          const int ii = crow(i, h);
          ob[(size_t)ii * 1024] = f2bf(o0[i]);
          ob[(size_t)(32 + ii) * 1024] = f2bf(o1[i]);
        }
      }
      __syncthreads();
    }
  }
}

DI void gla_scan_phase(const Params& P, unsigned char* smem, int bid, int nblk) {
  u16* qs = (u16*)smem;
  u16* ket = qs + 64 * 136;
  u16* vt = ket + 128 * 72;
  u16* sb = vt + 32 * 72;
  float* decs = (float*)(sb + 32 * 136);
  const int tid = ltid(), lane = tid & 63, wv = tid >> 6;
  const int r = lane & 31, h = lane >> 5;
  const u16* Z = (const u16*)(lws(P) + OFF_BIG + B_GZ);
  const u16* G2 = (const u16*)(lws(P) + OFF_BIG + B_G2);
  const float* DEC = (const float*)(lws(P) + OFF_BIG + B_DEC);
  for (int u0 = bid; u0 < 256; u0 += nblk) {
    int u = u0;
    if (nblk == 256) { const int xc = u0 & 7, sl = u0 >> 3; u = ((xc + 8 * (sl >> 3)) << 3) + (sl & 7); }
    const int vs = u & 7, dir = (u >> 3) & 1, hd = (u >> 4) & 3, b = u >> 6;
    u16* O = dir == 0 ? (u16*)(lws(P) + OFF_A) : (u16*)(lws(P) + OFF_BIG + B_GOB);
    const u16* TB = dir == 0 ? Z : G2;
    const size_t rst = dir == 0 ? GLA_N : 1024;
    __syncthreads();
    for (int e = tid; e < 32 * 136; e += NT) sb[e] = 0;
    f32x16 S;
#pragma unroll
    for (int i = 0; i < 16; ++i) S[i] = 0.f;
    uint4 pq0, pq1, pk0, pk1; u16x8 pv; float pd = 0.f;
#define GLA_ROW0(ci_) ((ci_) < 4 ? NL + b * 256 + (dir == 0 ? (ci_) : 3 - (ci_)) * 64 : b * SEQ + (dir == 0 ? (ci_) - 4 : 131 - (ci_)) * 64)
#define GLA_PREFETCH(ci_)                                                                                         \
    { const int rw = GLA_ROW0(ci_);                                                                               \
      const u16* Tq = TB + (size_t)rw * rst + hd * 128;                                                           \
      const u16* Tk = Tq + 512;                                                                                   \
      pq0 = *(const uint4*)(Tq + (size_t)(tid >> 4) * rst + (tid & 15) * 8);                                      \
      pq1 = *(const uint4*)(Tq + (size_t)((tid >> 4) + 32) * rst + (tid & 15) * 8);                               \
      pk0 = *(const uint4*)(Tk + (size_t)(tid >> 4) * rst + (tid & 15) * 8);             \
      pk1 = *(const uint4*)(Tk + (size_t)((tid >> 4) + 32) * rst + (tid & 15) * 8);                               \
      if (tid < 256) pv = *(const u16x8*)(Z + (size_t)(rw + (tid >> 2)) * GLA_N + 1024 + hd * 256 + vs * 32 + (tid & 3) * 8); \
      else if (tid < 384) { const int cidx = rw < NL ? (rw >> 6) : 512 + ((rw - NL) >> 6);                         \
        pd = DEC[((size_t)(cidx * 4 + hd) * 2 + dir) * 128 + (tid - 256)]; } }
    GLA_PREFETCH(0)
    __syncthreads();
    for (int ci = 0; ci < 132; ++ci) {
      const int row0 = GLA_ROW0(ci);
      {
        const int rr0 = tid >> 4, cc0 = (tid & 15) * 8;
        *(uint4*)(qs + rr0 * 136 + cc0) = pq0; *(uint4*)(qs + (rr0 + 32) * 136 + cc0) = pq1;
        const int d0 = 2 * rr0 + (cc0 >> 6), s0 = cc0 & 63;
        *(uint4*)(ket + d0 * 72 + s0) = pk0; *(uint4*)(ket + (d0 + 64) * 72 + s0) = pk1;
      }
      if (tid < 256) {
        const int rr = tid >> 2, cc = (tid & 3) * 8;
#pragma unroll
        for (int j = 0; j < 8; ++j) vt[(cc + j) * 72 + rr] = pv[j];
      } else if (tid < 384) decs[tid - 256] = pd;
      if (ci + 1 < 132) GLA_PREFETCH(ci + 1)
      __syncthreads();
      f32x16 Sn;
      if (wv < 4) {
#pragma unroll
        for (int i = 0; i < 16; ++i) Sn[i] = S[i] * decs[wv * 32 + crow(i, h)];
#pragma unroll
        for (int ss = 0; ss < 4; ++ss) {
          const bf16x8 a = *(const bf16x8*)(ket + (wv * 32 + r) * 72 + ss * 16 + h * 8);
          const bf16x8 bv = *(const bf16x8*)(vt + r * 72 + ss * 16 + h * 8);
          Sn = MFMA32(a, bv, Sn);
        }
      } else if (wv < 6) {
        const int ti = wv - 4;
        u16* ob = O + (size_t)(row0 + ti * 32) * 1024 + hd * 256 + vs * 32 + r;
        float oin[16];
#pragma unroll
        for (int i = 0; i < 16; ++i) oin[i] = bf2f(ob[(size_t)crow(i, h) * 1024]);
        f32x16 o;
#pragma unroll
        for (int i = 0; i < 16; ++i) o[i] = 0.f;
#pragma unroll
        for (int kk = 0; kk < 8; ++kk) {
          const bf16x8 a = *(const bf16x8*)(qs + (ti * 32 + r) * 136 + kk * 16 + h * 8);
          const bf16x8 bv = *(const bf16x8*)(sb + r * 136 + kk * 16 + h * 8);
          o = MFMA32(a, bv, o);
        }
#pragma unroll
        for (int i = 0; i < 16; ++i) ob[(size_t)crow(i, h) * 1024] = f2bf(o[i] + oin[i]);
      }
      __syncthreads();
      if (wv < 4) {
        S = Sn;
#pragma unroll
        for (int g = 0; g < 4; ++g) {
          u16x4 o;
#pragma unroll
          for (int q = 0; q < 4; ++q) o[q] = f2bf(S[4 * g + q]);
          *(u16x4*)(sb + r * 136 + wv * 32 + 8 * g + 4 * h) = o;
        }
      }
    }
  }
}

DI void gla_out_phase(const Params& P, int bid, int nblk) {
  const int lane = ltid() & 63, wv = ltid() >> 6;
  u16* A = (u16*)(lws(P) + OFF_A);
  const u16* Ob = (const u16*)(lws(P) + OFF_BIG + B_GOB);
  const u16* Z = (const u16*)(lws(P) + OFF_BIG + B_GZ);
  const float4 on4 = *(const float4*)(P.gla_onorm + lane * 4);
  for (int row = bid * 8 + wv; row < NTOK; row += nblk * 8) {
    u16x4 a[4], bq[4], og[4];
#pragma unroll
    for (int hd = 0; hd < 4; ++hd) {
      const size_t o = (size_t)row * 1024 + hd * 256 + lane * 4;
      a[hd] = *(const u16x4*)(A + o); bq[hd] = *(const u16x4*)(Ob + o);
      og[hd] = *(const u16x4*)(Z + (size_t)row * GLA_N + 2048 + hd * 256 + lane * 4);
    }
#pragma unroll
    for (int hd = 0; hd < 4; ++hd) {
      float v[4];
      float ss = 0.f;
#pragma unroll
      for (int j = 0; j < 4; ++j) { v[j] = bf2f(a[hd][j]) + bf2f(bq[hd][j]); ss += v[j] * v[j]; }
      ss = wave_sum(ss, lane);
      const float rstd = rsqrtf(ss * (1.f / 256.f) + EPS);
      uint2 res;
      res.x = pk2(v[0] * rstd * on4.x * silu(bf2f(og[hd][0])), v[1] * rstd * on4.y * silu(bf2f(og[hd][1])));
      res.y = pk2(v[2] * rstd * on4.z * silu(bf2f(og[hd][2])), v[3] * rstd * on4.w * silu(bf2f(og[hd][3])));
      *(uint2*)(A + (size_t)row * 1024 + hd * 256 + lane * 4) = res;
    }
  }
}

DI void mla_prep_phase(const Params& P, int bid, int nblk) {
  const int lane = ltid() & 63, wv = ltid() >> 6;
  const u16* Cd = (const u16*)(lws(P) + OFF_BIG + B_CD);
  u16* CQN = (u16*)(lws(P) + OFF_A + A_CQN);
  u16* CKVN = (u16*)(lws(P) + OFF_A + A_CKVN);
  u16* KR = (u16*)(lws(P) + OFF_BIG + B_KR);
  for (int row = bid * 8 + wv; row < NTOK; row += nblk * 8) {
    const u16* cr = Cd + (size_t)row * MLA_DNP;
    if (row < NL) {
      float v[6], ss = 0.f;
#pragma unroll
      for (int j = 0; j < 6; ++j) { v[j] = bf2f(cr[lane + 64 * j]); ss += v[j] * v[j]; }
      ss = wave_sum(ss, lane);
      const float rstd = rsqrtf(ss * (1.f / 384.f) + EPS);
#pragma unroll
      for (int j = 0; j < 6; ++j) CQN[(size_t)row * 384 + lane + 64 * j] = f2bf(v[j] * rstd * P.mla_qnorm[lane + 64 * j]);
    }
    {
      float v[4], ss = 0.f;
#pragma unroll
      for (int j = 0; j < 4; ++j) { v[j] = bf2f(cr[384 + lane + 64 * j]); ss += v[j] * v[j]; }
      ss = wave_sum(ss, lane);
      const float rstd = rsqrtf(ss * (1.f / 256.f) + EPS);
#pragma unroll
      for (int j = 0; j < 4; ++j) CKVN[(size_t)row * 256 + lane + 64 * j] = f2bf(v[j] * rstd * P.mla_kvnorm[lane + 64 * j]);
    }
    {
      float x = bf2f(cr[640 + lane]);
      const float px = shx(x, 16, lane);
      int b, key;
      if (row < NL) {
        b = row >> 13; const int l = row & 8191; key = NCTX + l;
        const int jj = lane & 15;
        const bool first = (lane & 31) < 16;
        const float invf = __expf(-(float)jj * (9.210340371976184f / 16.f));
        const float pos = (float)(lane < 32 ? (l >> 6) : (l & 63));
        float sn, cs;
        __sincosf(pos * invf, &sn, &cs);
        x = first ? (x * cs - px * sn) : (px * sn + x * cs);
      } else { b = (row - NL) >> 8; key = (row - NL) & 255; }
      KR[((size_t)b * NKEY + key) * 64 + lane] = f2bf(x);
    }
  }
}

constexpr int KS_STRIDE = 200;
constexpr int VS_STRIDE = 68;
DI void mla_attn_phase(const Params& P, unsigned char* smem, int bid, int nblk) {
  u16* Ks = (u16*)smem;
  u16* Vs = Ks + 2 * 64 * KS_STRIDE;
  const int tid = ltid(), lane = tid & 63, wv = tid >> 6;
  const int r = lane & 31, h = lane >> 5;
  const u16* Qg = (const u16*)(lws(P) + OFF_BIG + B_Q);
  const u16* Kn = (const u16*)(lws(P) + OFF_BIG + B_KN);
  const u16* VT = (const u16*)(lws(P) + OFF_BIG + B_VT);
  const u16* KR = (const u16*)(lws(P) + OFF_BIG + B_KR);
  u16* O = (u16*)(lws(P) + OFF_A);
  for (int u0 = bid; u0 < 1024; u0 += nblk) {
    int u = u0;
    if (nblk == 256) { const int rnd = u0 >> 8, c = u0 & 255; u = ((rnd * 8 + (c & 7)) << 5) + (c >> 3); }
    const int bh = u >> 5, qb = u & 31, b = bh >> 3, hd = bh & 7;
    const int l = qb * 256 + wv * 32 + r;
    bf16x8 qf[12];
    {
      const u16* qp = Qg + (size_t)(b * SEQ + l) * 1536 + hd * 192 + h * 8;
#pragma unroll
      for (int s = 0; s < 12; ++s) qf[s] = *(const bf16x8*)(qp + s * 16);
#pragma unroll
      for (int j = 0; j < 8; ++j) {
        const float invf = __expf(-(float)(8 * h + j) * (9.210340371976184f / 16.f));
        float sn, cs;
        __sincosf((float)(l >> 6) * invf, &sn, &cs);
        float x1 = bf2f((u16)qf[8][j]), x2 = bf2f((u16)qf[9][j]);
        qf[8][j] = (short)f2bf(x1 * cs - x2 * sn); qf[9][j] = (short)f2bf(x1 * sn + x2 * cs);
        __sincosf((float)(l & 63) * invf, &sn, &cs);
        x1 = bf2f((u16)qf[10][j]); x2 = bf2f((u16)qf[11][j]);
        qf[10][j] = (short)f2bf(x1 * cs - x2 * sn); qf[11][j] = (short)f2bf(x1 * sn + x2 * cs);
      }
    }
    f32x16 oacc[4];
#pragma unroll
    for (int d = 0; d < 4; ++d)
#pragma unroll
      for (int i = 0; i < 16; ++i) oacc[d][i] = 0.f;
    float mrun = -1e30f, lrun = 0.f;
    const u16* Kb = Kn + (size_t)bh * NKEY * 128;
    const u16* Rb = KR + (size_t)b * NKEY * 64;
    const u16* Vb = VT + (size_t)bh * 128 * NKEY;
    uint4 rk0, rk1, rk2, rv0, rv1;
#define ATT_GLOAD(kt_)                                                                                      \
    { const int key0 = (kt_) * 64;                                                                          \
      rk0 = *(const uint4*)(Kb + (size_t)(key0 + (tid >> 4)) * 128 + (tid & 15) * 8);                       \
      rk1 = *(const uint4*)(Kb + (size_t)(key0 + 32 + (tid >> 4)) * 128 + (tid & 15) * 8);                  \
      rk2 = *(const uint4*)(Rb + (size_t)(key0 + (tid >> 3)) * 64 + (tid & 7) * 8);                         \
      rv0 = *(const uint4*)(Vb + (size_t)(tid >> 3) * NKEY + key0 + (tid & 7) * 8);                         \
      rv1 = *(const uint4*)(Vb + (size_t)(64 + (tid >> 3)) * NKEY + key0 + (tid & 7) * 8); }
#define ATT_STV(src_, row_, buf_)                                                                           \
    { uint2* dp = (uint2*)(Vs + (buf_) * 128 * VS_STRIDE + (row_) * VS_STRIDE + (tid & 7) * 8);                \
      dp[0] = make_uint2(src_.x, src_.y); dp[1] = make_uint2(src_.z, src_.w); }
#define ATT_SSTORE(buf_)                                                                                    \
    { *(uint4*)(Ks + (buf_) * 64 * KS_STRIDE + (tid >> 4) * KS_STRIDE + (tid & 15) * 8) = rk0;                \
      *(uint4*)(Ks + (buf_) * 64 * KS_STRIDE + (32 + (tid >> 4)) * KS_STRIDE + (tid & 15) * 8) = rk1;         \
      *(uint4*)(Ks + (buf_) * 64 * KS_STRIDE + (tid >> 3) * KS_STRIDE + 128 + (tid & 7) * 8) = rk2;           \
      ATT_STV(rv0, (tid >> 3), buf_) ATT_STV(rv1, (64 + (tid >> 3)), buf_) }
    ATT_GLOAD(0);
    __syncthreads();
    ATT_SSTORE(0);
    __syncthreads();
    for (int kt = 0; kt < 132; ++kt) {
      const int cur = kt & 1;
      if (kt + 1 < 132) ATT_GLOAD(kt + 1);
      const u16* kc = Ks + cur * 64 * KS_STRIDE;
      const u16* vc = Vs + cur * 128 * VS_STRIDE;
#pragma unroll
      for (int t2 = 0; t2 < 2; ++t2) {
        f32x16 st;
#pragma unroll
        for (int i = 0; i < 16; ++i) st[i] = 0.f;
#pragma unroll
        for (int s = 0; s < 12; ++s) {
          const bf16x8 a = *(const bf16x8*)(kc + (t2 * 32 + r) * KS_STRIDE + s * 16 + h * 8);
          st = MFMA32(a, qf[s], st);
        }
        float mx = st[0];
#pragma unroll
        for (int i = 1; i < 16; ++i) mx = fmaxf(mx, st[i]);
        mx = fmaxf(mx, shx(mx, 32, lane));
        if (__builtin_amdgcn_ballot_w64(mx > mrun + 8.f) != 0ull) {
          const float mnew = fmaxf(mrun, mx);
          const float alpha = __builtin_amdgcn_exp2f(mrun - mnew);
          lrun *= alpha;
#pragma unroll
          for (int d = 0; d < 4; ++d)
#pragma unroll
            for (int i = 0; i < 16; ++i) oacc[d][i] *= alpha;
          mrun = mnew;
        }
        float ls = 0.f;
#pragma unroll
        for (int i = 0; i < 16; ++i) { const float p = __builtin_amdgcn_exp2f(st[i] - mrun); st[i] = p; ls += p; }
        lrun += ls;
        if (t2 == 0 && kt + 1 < 132) ATT_SSTORE(cur ^ 1);
#pragma unroll
        for (int s2 = 0; s2 < 2; ++s2) {
          uint4 pw;
          pw.x = pk2(st[8 * s2 + 0], st[8 * s2 + 1]); pw.y = pk2(st[8 * s2 + 2], st[8 * s2 + 3]);
          pw.z = pk2(st[8 * s2 + 4], st[8 * s2 + 5]); pw.w = pk2(st[8 * s2 + 6], st[8 * s2 + 7]);
          const bf16x8 pf = __builtin_bit_cast(bf16x8, pw);
#pragma unroll
          for (int d = 0; d < 4; ++d) {
            const u16* vp = vc + (d * 32 + r) * VS_STRIDE + t2 * 32 + 16 * s2 + 4 * h;
            const uint2 lo = *(const uint2*)vp, hi = *(const uint2*)(vp + 8);
            uint4 av = make_uint4(lo.x, lo.y, hi.x, hi.y);
            oacc[d] = MFMA32(__builtin_bit_cast(bf16x8, av), pf, oacc[d]);
          }
        }
      }
      __syncthreads();
    }
    lrun += shx(lrun, 32, lane);
    const float inv = 1.f / lrun;
    u16* op = O + (size_t)(b * SEQ + l) * 1024 + hd * 128;
#pragma unroll
    for (int d = 0; d < 4; ++d)
#pragma unroll
      for (int g = 0; g < 4; ++g) {
        u16x4 o;
#pragma unroll
        for (int q = 0; q < 4; ++q) o[q] = f2bf(oacc[d][4 * g + q] * inv);
        *(u16x4*)(op + d * 32 + 8 * g + 4 * h) = o;
      }
  }
}

constexpr int NPHASE = 36;

DI void run_phase(const Params& P, int ph, unsigned char* smem, int bid, int nblk) {
  u16* WT = (u16*)(lws(P) + OFF_WT);
  u16* A = (u16*)(lws(P) + OFF_A);
  unsigned char* BIG = lws(P) + OFF_BIG;
  float* XC = (float*)(lws(P) + OFF_XC);
  const float* MOD = (const float*)(lws(P) + OFF_MOD);
  EpiArgs ea{};
  if (ph == 0) {
    pro_weights(P, smem, bid, nblk);
    __syncthreads();
    pro_adaln(P, smem, bid, nblk);
    pro_filter_mlp(P, bid, nblk);
    return;
  }
  if (ph == 35) { final_norm_phase(P, bid, nblk); return; }
  int li, sub;
  if (ph <= 8) { li = 0; sub = ph - 1; }
  else if (ph <= 17) { li = 1; sub = ph - 9; }
  else if (ph <= 26) { li = 2; sub = ph - 18; }
  else { li = 3; sub = ph - 27; }
  const bool ctx_on = li <= 1;
  const int rows_all = ctx_on ? NTOK : NL;
  const int mt_all = rows_all / 256;
  const float* xl = li == 0 ? P.x : P.out;
  const float* xc = li == 0 ? P.ctx : XC;
  const int nsub = (li == 1 || li == 2) ? 9 : 8;
  if (sub == nsub - 3) { normmod_phase(P, li, 1, rows_all, P.out, XC, bid, nblk); return; }
  if (sub == nsub - 2) {
    EBf16<1> e{(u16*)(BIG + B_HID), HID, HID};
    gemm8(A, WT + W_MLP1(li), rows_all, HID, 1024, e, smem, bid, nblk);
    return;
  }
  if (sub == nsub - 1) {
    ea.gate = MOD + (size_t)li * 5 * 6144; ea.gofs = 5 * 1024;
    ea.xsl = P.out; ea.xsc = XC; ea.xdl = P.out; ea.xdc = XC;
    ERes e{nullptr, ea.gate, ea.gofs, ea.xsl, ea.xsc, ea.xdl, ea.xdc};
    gemm8((const u16*)(BIG + B_HID), WT + W_MLP2(li), NL, 1024, HID, e, smem, bid, nblk);
    if (ctx_on) {
      EResAtomic e2{ea.gate + 4 * 6144 + ea.gofs, XC};
      gemm8_splitk((const u16*)(BIG + B_HID) + (size_t)NL * HID, WT + W_MLP2(li), NTOK - NL, 1024, HID, 4, e2, smem, bid, nblk);
    }
    return;
  }
  ea.gate = MOD + (size_t)li * 5 * 6144; ea.gofs = 2 * 1024;
  ea.xsl = xl; ea.xsc = xc; ea.xdl = P.out; ea.xdc = XC;
  if (li == 0 || li == 3) {
    const int jl = li == 0 ? 0 : 1;
    switch (sub) {
      case 0: normmod_phase(P, li, 0, rows_all, xl, xc, bid, nblk); break;
      case 1: {
        EHyIn e1{(u16*)(BIG + B_ZT), P.hy_b_in + jl * 3072};
        gemm8(WT + W_HYIN(jl), A, 3072, rows_all, 1024, e1, smem, bid, nblk);
        EpiArgs e2{};
        e2.o0 = (u16*)(BIG + B_KT); e2.mrow0 = 0; e2.L = SEQ;
        const u16* h3 = (const u16*)(lws(P) + OFF_H3) + (size_t)jl * KTL * 64;
        gemm_phase<EPI_FILT>(h3, 64, WT + W_HYF4(jl), 64, 32, 16, e2, smem, bid, nblk);
        if (ctx_on) {
          e2.mrow0 = SEQ; e2.L = NCTX;
          gemm_phase<EPI_FILT>(h3 + (size_t)SEQ * 64, 64, WT + W_HYF4(jl), 64, 1, 16, e2, smem, bid, nblk);
        }
      } break;
      case 2: hyena_conv_phase(P, jl, ctx_on, smem, bid, nblk); break;
      case 3: transpose_phase(P, rows_all, smem, bid, nblk); break;
      case 4:
        { ERes e{P.hy_b_out + jl * 1024, ea.gate, ea.gofs, ea.xsl, ea.xsc, ea.xdl, ea.xdc};
          gemm8(A, WT + W_HYOUT(jl), rows_all, 1024, 1024, e, smem, bid, nblk); }
        break;
    }
    return;
  }
  if (li == 1) {
    switch (sub) {
      case 0: normmod_phase(P, li, 0, NTOK, xl, xc, bid, nblk); break;
      case 1: {
        EBf16<0> e1{(u16*)(BIG + B_GZ), GLA_N, GLA_N};
        gemm8(A, WT + W_GLAIN, NTOK, GLA_NP, 1024, e1, smem, bid, nblk);
      } break;
      case 2: gla_prep_phase(P, smem, bid, nblk); break;
      case 3: gla_scan_phase(P, smem, bid, nblk); break;
      case 4: gla_out_phase(P, bid, nblk); break;
      case 5: { ERes e{nullptr, ea.gate, ea.gofs, ea.xsl, ea.xsc, ea.xdl, ea.xdc};
        gemm8(A, WT + W_GLAWO, NL, 1024, 1024, e, smem, bid, nblk);
        EResAtomic e2{ea.gate + 4 * 6144 + ea.gofs, XC};
        gemm8_splitk(A + (size_t)NL * 1024, WT + W_GLAWO, NTOK - NL, 1024, 1024, 4, e2, smem, bid, nblk); } break;
    }
    return;
  }
  switch (sub) {
    case 0: normmod_phase(P, li, 0, NTOK, xl, xc, bid, nblk); break;
    case 1: {
      EBf16<0> e1{(u16*)(BIG + B_CD), MLA_DNP, MLA_DNP};
      gemm8(A, WT + W_MLADN, NTOK, MLA_DNP, 1024, e1, smem, bid, nblk);
    } break;
    case 2: mla_prep_phase(P, bid, nblk); break;
    case 3: {
      EBf16<2> e1{(u16*)(BIG + B_Q), 1536, 1536};
      gemm8((const u16*)(lws(P) + OFF_A + A_CQN), WT + W_MLAUQ, NL, 1536, 384, e1, smem, bid, nblk);
      EMlaK e2{(u16*)(BIG + B_KN)};
      gemm8((const u16*)(lws(P) + OFF_A + A_CKVN), WT + W_MLAUKV, NTOK, 1024, 256, e2, smem, bid, nblk);
      EMlaVT e3{(u16*)(BIG + B_VT)};
      gemm8(WT + W_MLAUKV + (size_t)1024 * 256, (const u16*)(lws(P) + OFF_A + A_CKVN), 1024, NTOK, 256, e3, smem, bid, nblk);
    } break;
    case 4: mla_attn_phase(P, smem, bid, nblk); break;
    case 5: { ERes e{nullptr, ea.gate, ea.gofs, ea.xsl, ea.xsc, ea.xdl, ea.xdc};
      gemm8(A, WT + W_MLAWO, NL, 1024, 1024, e, smem, bid, nblk); } break;
  }
}

#define XB_TMO      128
#define XB_XCNT(j)  (256  + 64 * (j))
#define XB_XSUB(j)  (1280 + 64 * (j))
#define XB_XGEN(j)  (2304 + 64 * (j))
#define XB_TOP      3328
#define XB_TOPGEN   3392
#define XCD_BAR_WORDS 3456
#define XB_SPIN_CAP (1u << 18)
#define LAS __attribute__((address_space(3)))

__device__ __forceinline__ unsigned xb_ld(unsigned* p)              { return __hip_atomic_load(p, __ATOMIC_RELAXED, __HIP_MEMORY_SCOPE_AGENT); }
__device__ __forceinline__ unsigned xb_add(unsigned* p, unsigned v) { return __hip_atomic_fetch_add(p, v, __ATOMIC_RELAXED, __HIP_MEMORY_SCOPE_AGENT); }
__device__ __forceinline__ unsigned xb_xcc_id() { return (unsigned)__builtin_amdgcn_s_getreg((3 << 11) | 20) & 0xFu; }
#define XB_SPIN(cond, bar) do { unsigned _sp = 0; while (cond) { __builtin_amdgcn_s_sleep(1); \
    if ((++_sp & 255u) == 0u) { if (xb_ld(&(bar)[XB_TMO])) break; if (_sp > XB_SPIN_CAP) { atomicAdd(&(bar)[XB_TMO], 1u); break; } } } } while (0)

struct XcdBarrier {
    unsigned* bar; unsigned x;
    volatile LAS unsigned* st;
};

__device__ __forceinline__ XcdBarrier xcd_barrier_post(unsigned* bar, volatile LAS unsigned* st) {
    XcdBarrier b; b.bar = bar; b.x = xb_xcc_id(); b.st = st;
    if (threadIdx.x == 0) (void)xb_add(&bar[XB_XCNT(b.x)], 1u);
    return b;
}
__device__ __forceinline__ void xcd_barrier_complete(unsigned* bar, unsigned x, unsigned& nloc, unsigned& nx) {
    const unsigned G = gridDim.x * gridDim.y * gridDim.z;
    unsigned sum, cnt, mine, sp = 0u;
    for (;;) {
        sum = 0u; cnt = 0u; mine = 0u;
#pragma unroll
        for (unsigned j = 0; j < 16; ++j) { const unsigned c = xb_ld(&bar[XB_XCNT(j)]); sum += c; cnt += (c > 0u) ? 1u : 0u; mine = (j == x) ? c : mine; }
        if (sum == G) break;
        __builtin_amdgcn_s_sleep(1);
        if ((++sp & 255u) == 0u) { if (xb_ld(&bar[XB_TMO])) break; if (sp > XB_SPIN_CAP) { atomicAdd(&bar[XB_TMO], 1u); break; } }
    }
    nloc = mine > 0u ? mine : 1u; nx = cnt > 0u ? cnt : 1u;
}

__device__ __forceinline__ void xcd_barrier(const XcdBarrier& b) {
    asm volatile("s_waitcnt vmcnt(0)" ::: "memory");
    __syncthreads();
    if (threadIdx.x == 0) {
        unsigned* bar = b.bar;
        __builtin_amdgcn_s_waitcnt(0);
        unsigned nloc = b.st[0], nx = b.st[1];
        if (nloc == 0u) { xcd_barrier_complete(bar, b.x, nloc, nx); b.st[0] = nloc; b.st[1] = nx; }
        const unsigned old = xb_add(&bar[XB_XSUB(b.x)], 1u);
        const unsigned gen = old / nloc;
        if (old + 1u == (gen + 1u) * nloc) {
            __builtin_amdgcn_fence(__ATOMIC_RELEASE, "agent");
            asm volatile("s_waitcnt vmcnt(0)" ::: "memory");
            const unsigned og = xb_add(&bar[XB_TOP], 1u);
            const unsigned tg = og / nx;
            if (og + 1u == (tg + 1u) * nx) xb_add(&bar[XB_TOPGEN], 1u);
            else XB_SPIN(xb_ld(&bar[XB_TOPGEN]) == tg, bar);
            __builtin_amdgcn_fence(__ATOMIC_ACQUIRE, "agent");
            xb_add(&bar[XB_XGEN(b.x)], 1u);
            asm volatile("s_waitcnt vmcnt(0)" ::: "memory");
        } else {
            XB_SPIN(xb_ld(&bar[XB_XGEN(b.x)]) == gen, bar);
            __builtin_amdgcn_fence(__ATOMIC_ACQUIRE, "agent");
            asm volatile("s_waitcnt vmcnt(0)" ::: "memory");
        }
    }
    __syncthreads();
}

DI void gbar(unsigned* ctr, unsigned nblk) {
  __syncthreads();
  if (threadIdx.x == 0) {
    __hip_atomic_fetch_add(ctr, 1u, __ATOMIC_RELEASE, __HIP_MEMORY_SCOPE_AGENT);
    while (__hip_atomic_load(ctr, __ATOMIC_RELAXED, __HIP_MEMORY_SCOPE_AGENT) < nblk) __builtin_amdgcn_s_sleep(1);
    __builtin_amdgcn_fence(__ATOMIC_ACQUIRE, "agent");
  }
  __syncthreads();
}

__global__ void __launch_bounds__(NT) mega(Params P) {
  extern __shared__ __attribute__((aligned(16))) unsigned char smem[];
  const int bid = blockIdx.x, nblk = gridDim.x;
  volatile LAS unsigned* xst = (volatile LAS unsigned*)(LAS unsigned char*)(smem + LDS_BYTES - 16);
  if (threadIdx.x == 0) { xst[0] = 0u; xst[1] = 0u; }
  __syncthreads();
  const XcdBarrier xb = xcd_barrier_post((unsigned*)(P.ws + OFF_ERR), xst);
  for (int ph = P.ph_lo; ph < P.ph_hi; ++ph) {
    int lb = bid, ln = nblk;
    asm volatile("" : "+s"(lb), "+s"(ln));
#ifdef PROBE_PH
    if (ph == PROBE_PH) { run_phase(P, ph, smem, lb, ln); cg::this_grid().sync(); }
#endif
    run_phase(P, ph, smem, lb, ln);
    if (ph + 1 < P.ph_hi) {
      if (P.ph_hi < 0) cg::this_grid().sync();
      xcd_barrier(xb);
    }
  }
}

extern "C" void kernel_launch(void* const* d_in, const int* in_sizes, int n_in, void* d_out, int out_size, void* d_ws, size_t ws_size,
                              hipStream_t stream) {
  static int grid = 0;
  if (grid == 0) {
    if (n_in != 37 || ws_size < WS_NEED) { fprintf(stderr, "kernel_launch: bad n_in %d / ws %zu\n", n_in, ws_size); grid = -1; return; }
    int dev = 0, cus = 0, per_cu = 0;
    hipGetDevice(&dev);
    hipDeviceGetAttribute(&cus, hipDeviceAttributeMultiprocessorCount, dev);
    if (hipFuncSetAttribute((const void*)mega, hipFuncAttributeMaxDynamicSharedMemorySize, LDS_BYTES) != hipSuccess) { fprintf(stderr, "hipFuncSetAttribute failed\n"); grid = -1; return; }
    hipOccupancyMaxActiveBlocksPerMultiprocessor(&per_cu, (const void*)mega, NT, LDS_BYTES);
    (void)hipGetLastError();
    if (per_cu < 1) per_cu = 1;
    grid = cus * per_cu;
  }
  if (grid < 0) return;
  Params p{};
  const float** fp = (const float**)&p;
  for (int i = 0; i < 37; ++i) fp[i] = (const float*)d_in[i];
  p.out = (float*)d_out;
  p.ws = (unsigned char*)d_ws;
  {
    int m = 0, tot = 0;
    auto add = [&](const float* src, size_t dst, int K, int N, int Np) {
      p.mats[m].src = src; p.mats[m].dst = dst; p.mats[m].K = K; p.mats[m].N = N; p.mats[m].Np = Np; p.mats[m].perm = (src == p.mla_w_ukv) ? 1 : 0;
      p.mats[m].tiles = (K / 64) * (Np / 256); tot += p.mats[m].tiles; ++m;
    };
    for (int i = 0; i < 4; ++i) {
      add(p.mlp_w1 + (size_t)i * 1024 * 4096, W_MLP1(i), 1024, 4096, 4096);
      add(p.mlp_w2 + (size_t)i * 4096 * 1024, W_MLP2(i), 4096, 1024, 1024);
    }
    for (int j = 0; j < 2; ++j) {
      add(p.hy_w_in + (size_t)j * 1024 * 3072, W_HYIN(j), 1024, 3072, 3072);
      add(p.hy_w_out + (size_t)j * 1024 * 1024, W_HYOUT(j), 1024, 1024, 1024);
      add(p.hy_f_w4 + (size_t)j * 64 * 4096, W_HYF4(j), 64, 4096, 4096);
    }
    add(p.gla_w_in, W_GLAIN, 1024, GLA_N, GLA_NP);
    add(p.gla_wo, W_GLAWO, 1024, 1024, 1024);
    add(p.mla_w_down, W_MLADN, 1024, MLA_DN, MLA_DNP);
    add(p.mla_w_uq, W_MLAUQ, 384, 1536, 1536);
    add(p.mla_w_ukv, W_MLAUKV, 256, 2048, 2048);
    add(p.mla_wo, W_MLAWO, 1024, 1024, 1024);
    for (; m < NMAT; ++m) { p.mats[m].tiles = 0; }
    p.total_mat_tiles = tot;
  }
  (void)hipMemsetAsync((unsigned char*)d_ws + OFF_ERR, 0, 16384, stream);
#if MULTI
  for (int ph = 0; ph < NPHASE; ++ph) {
    p.ph_lo = ph; p.ph_hi = ph + 1;
    hipLaunchKernelGGL(mega, dim3(grid), dim3(NT), LDS_BYTES, stream, p);
  }
#else
  p.ph_lo = 0; p.ph_hi = NPHASE;
  void* args[] = {&p};
  hipError_t e = hipLaunchCooperativeKernel((const void*)mega, dim3(grid), dim3(NT), args, LDS_BYTES, stream);
  if (e != hipSuccess) fprintf(stderr, "cooperative launch failed: %s (grid %d)\n", hipGetErrorString(e), grid);
#endif
}
```
